# Optimizing an MI355X kernel written in HIP

```python
import jax, jax.numpy as jnp
from jax import lax
import numpy as np

D_MODEL = 1024
BATCH = 8
SEQ = 2048
DEPTH = 4

MEM_LEN = 256
EPS = 1e-6
CONV_W = 4

MLSTM_HEADS = 4
MLSTM_DH = 128
MLSTM_W = MLSTM_HEADS * MLSTM_DH
MLSTM_CHUNK = 128
MLSTM_INIT_M = -1e30

LRU_W = 512
LRU_BLOCKS = 8
LRU_BD = LRU_W // LRU_BLOCKS
LRU_C = 8.0

SWA_HEADS = 8
SWA_KV_HEADS = 2
SWA_DH = 64
SWA_W = SWA_HEADS * SWA_DH
SWA_KV_W = SWA_KV_HEADS * SWA_DH
SWA_WINDOW = 128
SWA_BLOCK = 128

HGRN_HEADS = 4
HGRN_DK = 128
HGRN_DV = 128
HGRN_W = HGRN_HEADS * HGRN_DK
HGRN_CHUNK = 64

XA_HEADS = 4
XA_DH = 64
XA_W = XA_HEADS * XA_DH

BRANCH_W = (MLSTM_W, LRU_W, SWA_W, HGRN_HEADS * HGRN_DV, XA_W)
N_BRANCH = len(BRANCH_W)
MIX_W = sum(BRANCH_W)
IN_SIZES = (MLSTM_W, MLSTM_W, MLSTM_W, MLSTM_W, MLSTM_W, MLSTM_HEADS, MLSTM_HEADS,
            LRU_W, LRU_W,
            SWA_W, SWA_KV_W, SWA_KV_W, SWA_W,
            HGRN_W, HGRN_W, HGRN_HEADS * HGRN_DV, HGRN_HEADS * HGRN_DV,
            XA_W, XA_W,
            N_BRANCH * D_MODEL)
N_IN = sum(IN_SIZES)

kernel_name = "hybrid_gated_mlstm_rglru_swa_hgrn2"


def _split_points(sizes):
    pts, acc = [], 0
    for s in sizes[:-1]:
        acc += s
        pts.append(acc)
    return pts


def rmsnorm(x, g):
    xf = x.astype(jnp.float32)
    y = xf * lax.rsqrt(jnp.mean(xf * xf, axis=-1, keepdims=True) + EPS)
    return (y * g.astype(jnp.float32)).astype(x.dtype)


def head_rmsnorm(x, g, n_heads):
    B, S, W = x.shape
    xh = x.astype(jnp.float32).reshape(B, S, n_heads, W // n_heads)
    xh = xh * lax.rsqrt(jnp.mean(xh * xh, axis=-1, keepdims=True) + EPS)
    return xh.reshape(B, S, W) * g.astype(jnp.float32)


def causal_conv(x, w):
    K = w.shape[0]
    S = x.shape[1]
    xp = jnp.pad(x, ((0, 0), (K - 1, 0), (0, 0)))
    y = xp[:, 0:S] * w[0]
    for k in range(1, K):
        y = y + xp[:, k:k + S] * w[k]
    return y


def alibi_slopes(n):
    return 2.0 ** (-8.0 * jnp.arange(1, n + 1, dtype=jnp.float32) / n)


def mlstm_chunkwise(q, k, v, ig, fg):
    B, S, H, d = q.shape
    L = MLSTM_CHUNK
    nc = S // L
    f32 = jnp.float32

    def chunk(t):
        return t.reshape(B, nc, L, H, -1).transpose(0, 3, 1, 2, 4)

    qc, kc, vc = chunk(q * d ** -0.5), chunk(k), chunk(v)
    logf = jax.nn.log_sigmoid(fg).reshape(B, nc, L, H).transpose(0, 3, 1, 2)
    ic = ig.reshape(B, nc, L, H).transpose(0, 3, 1, 2)
    g = jnp.cumsum(logf, axis=-1)
    G = g[..., -1]
    causal = jnp.tril(jnp.ones((L, L), dtype=bool))
    Dm = jnp.where(causal, g[..., :, None] - g[..., None, :] + ic[..., None, :], -jnp.inf)
    w_end = G[..., None] - g + ic
    m_loc = jnp.max(w_end, axis=-1)
    e = jnp.exp(w_end - m_loc[..., None])
    C_loc = jnp.einsum('bhcl,bhcld,bhcle->bhcde', e, kc, vc)
    n_loc = jnp.einsum('bhcl,bhcld->bhcd', e, kc)

    def step(carry, inp):
        C, n, m = carry
        Gc, Cl, nl, ml = inp
        m_new = jnp.maximum(Gc + m, ml)
        a = jnp.exp(Gc + m - m_new)
        bco = jnp.exp(ml - m_new)
        C_new = a[..., None, None] * C + bco[..., None, None] * Cl
        n_new = a[..., None] * n + bco[..., None] * nl
        return (C_new, n_new, m_new), (C, n, m)

    init = (jnp.zeros((B, H, d, d), f32), jnp.zeros((B, H, d), f32), jnp.full((B, H), MLSTM_INIT_M, f32))
    xs = (G.transpose(2, 0, 1), C_loc.transpose(2, 0, 1, 3, 4), n_loc.transpose(2, 0, 1, 3), m_loc.transpose(2, 0, 1))
    _, (C_prev, n_prev, m_prev) = lax.scan(step, init, xs)
    C_prev = C_prev.transpose(1, 2, 0, 3, 4)
    n_prev = n_prev.transpose(1, 2, 0, 3)
    m_prev = m_prev.transpose(1, 2, 0)

    a_inter = g + m_prev[..., None]
    m_j = jnp.maximum(a_inter, jnp.max(Dm, axis=-1))
    P = jnp.exp(Dm - m_j[..., None]) * jnp.einsum('bhcjd,bhcrd->bhcjr', qc, kc)
    w_inter = jnp.exp(a_inter - m_j)
    num = jnp.einsum('bhcjr,bhcre->bhcje', P, vc) + w_inter[..., None] * jnp.einsum('bhcjd,bhcde->bhcje', qc, C_prev)
    den = jnp.sum(P, axis=-1) + w_inter * jnp.einsum('bhcjd,bhcd->bhcj', qc, n_prev)
    h = num / jnp.maximum(jnp.abs(den), jnp.exp(-m_j))[..., None]
    return h.transpose(0, 2, 3, 1, 4).reshape(B, S, H, d)


def rglru(x, conv_w, conv_b, wa, ba, wx, bx, lam):
    B, S, W = x.shape
    xc = causal_conv(x, conv_w) + conv_b
    xb = xc.reshape(B, S, LRU_BLOCKS, LRU_BD)
    r = jax.nn.sigmoid(jnp.einsum('bsnd,nde->bsne', xb, wa).reshape(B, S, W) + ba)
    i = jax.nn.sigmoid(jnp.einsum('bsnd,nde->bsne', xb, wx).reshape(B, S, W) + bx)
    log_a = -LRU_C * r * jax.nn.softplus(-lam)
    a = jnp.exp(log_a)
    u = jnp.sqrt(-jnp.expm1(2.0 * log_a)) * (i * xc)

    def combine(lhs, rhs):
        a1, b1 = lhs
        a2, b2 = rhs
        return a1 * a2, a2 * b1 + b2

    _, h = lax.associative_scan(combine, (a, u), axis=1)
    return h


def _with_prev_block(t):
    prev = jnp.pad(t, [(0, 0), (1, 0)] + [(0, 0)] * (t.ndim - 2))[:, :-1]
    return jnp.concatenate([prev, t], axis=2)


def swa_sink_alibi(q, k, v, pos, sinks):
    B, S, H, d = q.shape
    KV = k.shape[2]
    G = H // KV
    T = SWA_BLOCK
    nb = S // T
    qb = q.reshape(B, nb, T, KV, G, d)
    kb = _with_prev_block(k.reshape(B, nb, T, KV, d))
    vb = _with_prev_block(v.reshape(B, nb, T, KV, d))
    pq = pos.reshape(B, nb, T)
    pk = _with_prev_block(pq)
    s = jnp.einsum('bntkgd,bnskd->bnkgts', qb, kb) * d ** -0.5
    dist = jnp.abs(pq[:, :, :, None] - pk[:, :, None, :]).astype(jnp.float32)
    slopes = alibi_slopes(H).reshape(KV, G)
    s = s - slopes[None, None, :, :, None, None] * dist[:, :, None, None]
    ti = jnp.arange(T)[:, None] + T
    si = jnp.arange(2 * T)[None, :]
    rel = ti - si
    in_window = (rel >= 0) & (rel < SWA_WINDOW)
    blk = jnp.arange(nb)[:, None, None]
    valid = in_window[None] & ((si[None] >= T) | (blk > 0))
    s = jnp.where(valid[None, :, None, None], s, -jnp.inf)
    sink = jnp.broadcast_to(sinks.astype(jnp.float32).reshape(KV, G)[None, None, :, :, None, None], s.shape[:-1] + (1,))
    p = jax.nn.softmax(jnp.concatenate([s, sink], axis=-1), axis=-1)[..., :-1]
    o = jnp.einsum('bnkgts,bnskd->bntkgd', p, vb)
    return o.reshape(B, S, H * d)


def hgrn2_chunkwise(q, f_pre, i, lb):
    B, S, _ = q.shape
    H, dk, dv, L = HGRN_HEADS, HGRN_DK, HGRN_DV, HGRN_CHUNK
    nc = S // L
    f32 = jnp.float32
    lb = lb.astype(f32).reshape(H, dk)
    log_f = jnp.logaddexp(jnp.log(lb), jnp.log1p(-lb) + jax.nn.log_sigmoid(f_pre.reshape(B, S, H, dk)))
    k = -jnp.expm1(log_f)
    qs = jax.nn.silu(q.reshape(B, S, H, dk)) * dk ** -0.5

    def to_chunks(t):
        return t.reshape(B, nc, L, H, t.shape[-1]).transpose(1, 0, 3, 2, 4)

    xs = (to_chunks(qs), to_chunks(k), to_chunks(i.reshape(B, S, H, dv)), to_chunks(log_f))
    causal = jnp.tril(jnp.ones((L, L), dtype=bool))

    def step(state, inp):
        qc, kc, vc, gc = inp
        b = jnp.cumsum(gc, axis=2)
        diff = b[:, :, :, None, :] - b[:, :, None, :, :]
        decay = jnp.exp(jnp.where(causal[:, :, None], diff, -jnp.inf))
        a = jnp.einsum('bhjd,bhjrd,bhrd->bhjr', qc, decay, kc)
        o = jnp.einsum('bhjr,bhre->bhje', a, vc) + jnp.einsum('bhjd,bhde->bhje', qc * jnp.exp(b), state)
        b_end = b[:, :, -1:, :]
        state = jnp.exp(b_end[:, :, 0, :])[..., None] * state + jnp.einsum('bhrd,bhre->bhde', kc * jnp.exp(b_end - b), vc)
        return state, o

    s0 = jnp.zeros((B, H, dk, dv), f32)
    _, o = lax.scan(step, s0, xs)
    return o.transpose(1, 0, 3, 2, 4).reshape(B, S, H * dv)


def memory_cross_attention(q, km, vm):
    B, S, _ = q.shape
    M = km.shape[1]
    qh = q.reshape(B, S, XA_HEADS, XA_DH)
    kh = km.reshape(B, M, XA_HEADS, XA_DH)
    vh = vm.reshape(B, M, XA_HEADS, XA_DH)
    s = jnp.einsum('bshd,bmhd->bhsm', qh, kh) * XA_DH ** -0.5
    p = jax.nn.softmax(s.astype(jnp.float32), axis=-1)
    return jnp.einsum('bhsm,bmhd->bshd', p, vh).reshape(B, S, XA_W)


def setup_inputs(seed: int = 0) -> dict:
    key = jax.random.key(seed)
    ks = jax.random.split(key, 24)
    f32 = jnp.float32

    def nrm(k, shape, scale):
        return jax.random.normal(k, shape, f32) * scale

    x = nrm(ks[0], (BATCH, SEQ, D_MODEL), 1.0)
    mem = nrm(ks[1], (BATCH, MEM_LEN, D_MODEL), 1.0)
    positions = jax.random.randint(ks[2], (BATCH, 1), 0, 4096, jnp.int32) + jnp.arange(SEQ, dtype=jnp.int32)[None, :]
    norm_g = 1.0 + nrm(ks[3], (DEPTH, D_MODEL), 0.02)
    w_in = nrm(ks[4], (DEPTH, D_MODEL, N_IN), D_MODEL ** -0.5)
    mlstm_conv_w = nrm(ks[5], (DEPTH, CONV_W, 2 * MLSTM_W), CONV_W ** -0.5)
    f_bias = jnp.linspace(3.0, 6.0, MLSTM_HEADS, dtype=f32)
    mlstm_b_if = jnp.concatenate([nrm(ks[6], (DEPTH, MLSTM_HEADS), 0.1),
                                  f_bias[None, :] + nrm(ks[7], (DEPTH, MLSTM_HEADS), 0.1)], axis=-1)
    mlstm_norm_g = 1.0 + nrm(ks[8], (DEPTH, MLSTM_W), 0.02)
    lru_conv_w = nrm(ks[9], (DEPTH, CONV_W, LRU_W), CONV_W ** -0.5)
    lru_conv_b = nrm(ks[10], (DEPTH, LRU_W), 0.01)
    lru_wa = nrm(ks[11], (DEPTH, LRU_BLOCKS, LRU_BD, LRU_BD), LRU_BD ** -0.5)
    lru_ba = nrm(ks[12], (DEPTH, LRU_W), 0.01)
    lru_wx = nrm(ks[13], (DEPTH, LRU_BLOCKS, LRU_BD, LRU_BD), LRU_BD ** -0.5)
    lru_bx = nrm(ks[14], (DEPTH, LRU_W), 0.01)
    u = jax.random.uniform(ks[15], (DEPTH, LRU_W), f32, 0.9, 0.999)
    sig = u ** (1.0 / LRU_C)
    lru_lambda = jnp.log(sig) - jnp.log1p(-sig)
    swa_sinks = nrm(ks[16], (DEPTH, SWA_HEADS), 0.5)
    hgrn_lb = nrm(ks[17], (DEPTH, HGRN_W), 1.0)
    hgrn_norm_g = 1.0 + nrm(ks[18], (DEPTH, HGRN_HEADS * HGRN_DV), 0.02)
    mem_norm_g = 1.0 + nrm(ks[19], (DEPTH, D_MODEL), 0.02)
    w_mem_kv = nrm(ks[20], (DEPTH, D_MODEL, 2 * XA_W), D_MODEL ** -0.5)
    w_br = nrm(ks[21], (DEPTH, MIX_W, D_MODEL), MLSTM_W ** -0.5)
    w_out = nrm(ks[22], (DEPTH, D_MODEL, D_MODEL), D_MODEL ** -0.5)
    final_norm_g = 1.0 + nrm(ks[23], (D_MODEL,), 0.02)
    return {"x": x, "mem": mem, "positions": positions, "norm_g": norm_g, "w_in": w_in,
            "mlstm_conv_w": mlstm_conv_w, "mlstm_b_if": mlstm_b_if, "mlstm_norm_g": mlstm_norm_g,
            "lru_conv_w": lru_conv_w, "lru_conv_b": lru_conv_b, "lru_wa": lru_wa, "lru_ba": lru_ba,
            "lru_wx": lru_wx, "lru_bx": lru_bx, "lru_lambda": lru_lambda, "swa_sinks": swa_sinks,
            "hgrn_lb": hgrn_lb, "hgrn_norm_g": hgrn_norm_g, "mem_norm_g": mem_norm_g,
            "w_mem_kv": w_mem_kv, "w_br": w_br, "w_out": w_out, "final_norm_g": final_norm_g}


def reference(x, mem, positions, norm_g, w_in, mlstm_conv_w, mlstm_b_if, mlstm_norm_g,
              lru_conv_w, lru_conv_b, lru_wa, lru_ba, lru_wx, lru_bx, lru_lambda, swa_sinks,
              hgrn_lb, hgrn_norm_g, mem_norm_g, w_mem_kv, w_br, w_out, final_norm_g):
    f32 = jnp.float32
    B, S, _ = x.shape
    lb_all = jnp.cumsum(jax.nn.softmax(hgrn_lb.astype(f32), axis=0), axis=0)
    lb_all = lb_all - lb_all[0:1]
    in_pts = _split_points(IN_SIZES)
    br_pts = _split_points(BRANCH_W)
    for l in range(DEPTH):
        h = rmsnorm(x, norm_g[l])
        u = jnp.einsum('bsd,dn->bsn', h, w_in[l]).astype(f32)
        (qa, ka, va, oa, za, ia, fa, xb, zb, qc, kc, vc, zc,
         qd, fd, idd, zd, qe, ze, gates) = jnp.split(u, in_pts, axis=-1)

        qk = jax.nn.silu(causal_conv(jnp.concatenate([qa, ka], axis=-1), mlstm_conv_w[l].astype(f32)))
        qa2, ka2 = qk[..., :MLSTM_W], qk[..., MLSTM_W:]
        ig = ia + mlstm_b_if[l, :MLSTM_HEADS]
        fg = fa + mlstm_b_if[l, MLSTM_HEADS:]
        hm = mlstm_chunkwise(qa2.reshape(B, S, MLSTM_HEADS, MLSTM_DH), ka2.reshape(B, S, MLSTM_HEADS, MLSTM_DH),
                             va.reshape(B, S, MLSTM_HEADS, MLSTM_DH), ig, fg).reshape(B, S, MLSTM_W)
        ya = head_rmsnorm(hm, mlstm_norm_g[l], MLSTM_HEADS) * jax.nn.sigmoid(oa) * jax.nn.silu(za)

        yb = rglru(xb, lru_conv_w[l], lru_conv_b[l], lru_wa[l], lru_ba[l], lru_wx[l], lru_bx[l],
                   lru_lambda[l]) * jax.nn.silu(zb)

        yc = swa_sink_alibi(qc.reshape(B, S, SWA_HEADS, SWA_DH), kc.reshape(B, S, SWA_KV_HEADS, SWA_DH),
                            vc.reshape(B, S, SWA_KV_HEADS, SWA_DH), positions, swa_sinks[l]) * jax.nn.silu(zc)

        hd = hgrn2_chunkwise(qd, fd, idd, lb_all[l])
        yd = head_rmsnorm(hd, hgrn_norm_g[l], HGRN_HEADS) * jax.nn.silu(zd)

        memn = rmsnorm(mem, mem_norm_g[l])
        kvm = jnp.einsum('bmd,dn->bmn', memn, w_mem_kv[l]).astype(f32)
        ye = memory_cross_attention(qe, kvm[..., :XA_W], kvm[..., XA_W:]) * jax.nn.silu(ze)

        g = jax.nn.sigmoid(gates.reshape(B, S, N_BRANCH, D_MODEL))
        w_parts = jnp.split(w_br[l], br_pts, axis=0)
        ys = (ya, yb, yc, yd, ye)
        y = g[:, :, 0] * jnp.einsum('bsw,wd->bsd', ys[0], w_parts[0])
        for j in range(1, N_BRANCH):
            y = y + g[:, :, j] * jnp.einsum('bsw,wd->bsd', ys[j], w_parts[j])
        out = jnp.einsum('bsd,de->bse', y.astype(x.dtype), w_out[l])
        x = x + out.astype(x.dtype)
    return rmsnorm(x, final_norm_g)
```

```cpp
#include <hip/hip_runtime.h>
#include <hip/hip_cooperative_groups.h>
#include <cstdio>
namespace cg = cooperative_groups;
__device__ __forceinline__ int opaque_tid() { int t = (int)threadIdx.x; asm volatile("" : "+v"(t)); return t; }
namespace pg8 {
#define PG8_LAS __attribute__((address_space(3)))
typedef unsigned short bf16_t;
typedef short bf16x8 __attribute__((ext_vector_type(8)));
typedef float f32x4 __attribute__((ext_vector_type(4)));
typedef unsigned u32x4 __attribute__((ext_vector_type(4)));
constexpr int BM = 256, BK = 64, HALF = 128, HTB = HALF * BK * 2  , STAGE_BYTES = 8 * HTB, NXCD = 8, WGM = 8;

__host__ __device__ __forceinline__ int lds_byte(int r, int c) { const int st = (r >> 4) * 2 + (c >> 5), rr = r & 15, cc = c & 31, ob = rr * 64 + cc * 2; return st * 1024 + (ob ^ (((ob >> 9) & 1) << 5)); }
__host__ __device__ __forceinline__ void stage_rc(int b, int& R, int& C) { const int st = b / 1024, sb = b % 1024, swz = sb ^ (((sb >> 9) & 1) << 5); R = (st >> 1) * 16 + swz / 64; C = (st & 1) * 32 + (swz % 64) / 2; }
__host__ __device__ __forceinline__ int perm32(int rho) { const int n = rho >> 4, i = rho & 15; return 8 * (i >> 2) + 4 * n + (i & 3); }

struct Unit { int pm, pn; };
struct Gemm { const bf16_t* A; const bf16_t* Bt; int M, N, K; };

struct StaticOrder {
    int nM, nN, nwg, G, c;
    __host__ __device__ void init(int M, int N, int G_, int c_) { nM = M / BM; nN = N / BM; nwg = nM * nN; G = G_; c = c_; }
    __host__ __device__ bool next(int i, Unit& u) const {
        const long L = (long)i * G + c; if (L >= nwg) return false;
        int wgid = (int)L; { const int q = nwg / NXCD, r = nwg % NXCD, xcd = wgid % NXCD, off = wgid / NXCD; wgid = (xcd < r ? xcd * (q + 1) : r * (q + 1) + (xcd - r) * q) + off; }
        const int nig = WGM * nN, gid = wgid / nig, fm = gid * WGM, gsz = (nM - fm) < WGM ? (nM - fm) : WGM;
        u.pm = fm + ((wgid % nig) % gsz); u.pn = (wgid % nig) / gsz; return true;
    }
    __device__ __forceinline__ void a_ready(const Unit&) const {}
    __device__ __forceinline__ void done(const Unit&) const {}
};
template <class Epi, class Sched, bool STAMP = false>
__device__ __forceinline__ void gemm_phase(PG8_LAS unsigned char* lds, const Gemm g, const Sched& S, const Epi& E, unsigned long long* stamps) {
    const int tid = opaque_tid(), wid = __builtin_amdgcn_readfirstlane(tid >> 6), lane = tid & 63, wr = wid >> 2, wc = wid & 3, fr = lane & 15, fq = lane >> 4;
    const int K = g.K, nt = K / BK;
    int ts_lo = 0, ts_hi = 0, nts = 0; const unsigned long long rt_entry = STAMP ? (unsigned long long)wall_clock64() : 0ull;
#define PG8_STAMP() do { if (STAMP && wid == 0 && nts < 64) { const unsigned long long _c = (unsigned long long)clock64(); \
        ts_lo = (lane == nts) ? (int)(unsigned)_c : ts_lo; ts_hi = (lane == nts) ? (int)(unsigned)(_c >> 32) : ts_hi; ++nts; } } while (0)
    PG8_STAMP();
    unsigned voffA[2], voffB[2];
#pragma unroll
    for (int i = 0; i < 2; ++i) { int R, C; stage_rc(tid * 16 + i * 8192, R, C); const int Rb = Epi::PERM ? ((R & ~31) + perm32(R & 31)) : R;
        voffA[i] = (unsigned)(R * K + C) * 2u; voffB[i] = (unsigned)(Rb * K + C) * 2u; }
    const size_t kstep = (size_t)(BK * 2);
    const size_t hstep = (size_t)HALF * K * 2;
    const size_t tstep = 2 * hstep;
    const unsigned ldsw = (unsigned)wid * 1024u;
    const int aoff = lds_byte(wr * 64 + fr, fq * 8), boff = lds_byte(wc * 32 + fr, fq * 8);
#define PG8_SA(b, h) (((b) * 2 + (h)) * HTB)
#define PG8_SB(b, h) ((4 + (b) * 2 + (h)) * HTB)
#define PG8_STAGE(bufoff, gbase, voff) do { _Pragma("unroll") for (int _i = 0; _i < 2; ++_i) \
        __builtin_amdgcn_global_load_lds((const unsigned*)((const char*)(gbase) + (voff)[_i]), (PG8_LAS unsigned*)(lds + (bufoff) + ldsw + _i * 8192), 16, 0, 0); } while (0)
#define PG8_LDA(dst, b, h) do { _Pragma("unroll") for (int m = 0; m < 4; ++m) _Pragma("unroll") for (int k = 0; k < 2; ++k) dst[m][k] = *(const PG8_LAS bf16x8*)(lds + PG8_SA(b, h) + aoff + m * 2048 + k * 1024); } while (0)
#define PG8_LDB(dst, b, h) do { _Pragma("unroll") for (int n = 0; n < 2; ++n) _Pragma("unroll") for (int k = 0; k < 2; ++k) dst[n][k] = *(const PG8_LAS bf16x8*)(lds + PG8_SB(b, h) + boff + n * 2048 + k * 1024); } while (0)
#define PG8_MMA(ai, bj, At, Bt) do { __builtin_amdgcn_s_setprio(1); _Pragma("unroll") for (int m = 0; m < 4; ++m) _Pragma("unroll") for (int n = 0; n < 2; ++n) _Pragma("unroll") for (int k = 0; k < 2; ++k) \
        acc[ai][bj][m][n] = __builtin_amdgcn_mfma_f32_16x16x32_bf16(Bt[n][k], At[m][k], acc[ai][bj][m][n], 0, 0, 0); __builtin_amdgcn_s_setprio(0); } while (0)
#define PG8_WAIT_V(n) asm volatile("s_waitcnt vmcnt(" #n ")" ::: "memory")
#define PG8_WAIT_L(n) asm volatile("s_waitcnt lgkmcnt(" #n ")" ::: "memory")
#define PG8_BAR __builtin_amdgcn_s_barrier()
#define PG8_SCHED __builtin_amdgcn_sched_barrier(0)
    Unit cur, nxt; int ui = 0;
    if (!S.next(0, cur)) return;
    f32x4 acc[2][2][4][2];
#pragma unroll
    for (int a = 0; a < 2; ++a)
#pragma unroll
        for (int b = 0; b < 2; ++b)
#pragma unroll
            for (int m = 0; m < 4; ++m)
#pragma unroll
                for (int n = 0; n < 2; ++n) acc[a][b][m][n] = (f32x4){0.f, 0.f, 0.f, 0.f};
    bf16x8 At[4][2], B0[2][2], B1[2][2];
    const char* cA = (const char*)g.A + (size_t)cur.pm * tstep; const char* cB = (const char*)g.Bt + (size_t)cur.pn * tstep;
    S.a_ready(cur);
    PG8_STAGE(PG8_SB(0, 0), cB, voffB); PG8_STAGE(PG8_SA(0, 0), cA, voffA); PG8_STAGE(PG8_SB(0, 1), cB + hstep, voffB); PG8_STAGE(PG8_SA(0, 1), cA + hstep, voffA);
    if (wr == 1) PG8_BAR;
    PG8_WAIT_V(4); PG8_BAR;
    PG8_STAGE(PG8_SB(1, 0), cB + kstep, voffB); PG8_STAGE(PG8_SA(1, 0), cA + kstep, voffA); PG8_STAGE(PG8_SB(1, 1), cB + hstep + kstep, voffB);
    PG8_WAIT_V(6); PG8_BAR;
    PG8_STAMP();
    for (;;) {
        const bool has_next = S.next(ui + 1, nxt);
        const char* nA = has_next ? (const char*)g.A + (size_t)nxt.pm * tstep : cA; const char* nB = has_next ? (const char*)g.Bt + (size_t)nxt.pn * tstep : cB;
        for (int t = 0; t < nt; t += 2) {
            const bool last = (t == nt - 2);
            const char* a1 = cA + (size_t)(t + 1) * kstep;
            const char* a2 = last ? nA : cA + (size_t)(t + 2) * kstep; const char* b2 = last ? nB : cB + (size_t)(t + 2) * kstep;
            const char* a3 = a2 + kstep; const char* b3 = b2 + kstep;
            if (last && has_next) S.a_ready(nxt);
            PG8_LDB(B0, 0, 0); PG8_SCHED; PG8_LDA(At, 0, 0); PG8_STAGE(PG8_SA(1, 1), a1 + hstep, voffA);
            PG8_WAIT_L(8); PG8_BAR; PG8_WAIT_L(0); PG8_MMA(0, 0, At, B0); PG8_BAR; PG8_SCHED;
            PG8_LDB(B1, 0, 1); PG8_STAGE(PG8_SB(0, 0), b2, voffB);
            PG8_BAR; PG8_WAIT_L(0); PG8_MMA(0, 1, At, B1); PG8_BAR;
            PG8_LDA(At, 0, 1); PG8_STAGE(PG8_SA(0, 0), a2, voffA);
            PG8_BAR; PG8_WAIT_L(0); PG8_MMA(1, 0, At, B0); PG8_BAR; PG8_SCHED;
            PG8_STAGE(PG8_SB(0, 1), b2 + hstep, voffB);
            PG8_WAIT_V(6); PG8_BAR; PG8_MMA(1, 1, At, B1); PG8_BAR;
            PG8_LDB(B0, 1, 0); PG8_SCHED; PG8_LDA(At, 1, 0); PG8_STAGE(PG8_SA(0, 1), a2 + hstep, voffA);
            PG8_WAIT_L(8); PG8_BAR; PG8_WAIT_L(0); PG8_MMA(0, 0, At, B0); PG8_BAR; PG8_SCHED;
            PG8_LDB(B1, 1, 1); PG8_STAGE(PG8_SB(1, 0), b3, voffB);
            PG8_BAR; PG8_WAIT_L(0); PG8_MMA(0, 1, At, B1); PG8_BAR;
            PG8_LDA(At, 1, 1); PG8_STAGE(PG8_SA(1, 0), a3, voffA);
            PG8_BAR; PG8_WAIT_L(0); PG8_MMA(1, 0, At, B0); PG8_BAR; PG8_SCHED;
            PG8_STAGE(PG8_SB(1, 1), b3 + hstep, voffB);
            PG8_WAIT_V(6); PG8_BAR; PG8_MMA(1, 1, At, B1); PG8_BAR;
        }
        PG8_STAMP();
        if constexpr (!Epi::AFTER_DRAIN) { E(acc, cur, wr, wc, fr, fq); S.done(cur); }
        PG8_STAMP();
        if (!has_next) break;
#pragma unroll
        for (int a = 0; a < 2; ++a)
#pragma unroll
            for (int b = 0; b < 2; ++b)
#pragma unroll
                for (int m = 0; m < 4; ++m)
#pragma unroll
                    for (int n = 0; n < 2; ++n) acc[a][b][m][n] = (f32x4){0.f, 0.f, 0.f, 0.f};
        cur = nxt; cA = nA; cB = nB; ++ui;
    }
    PG8_WAIT_V(0);
    if (wr == 0) PG8_BAR;
    PG8_BAR;
    if constexpr (Epi::AFTER_DRAIN) { E.fused(acc, cur, wr, wc, fr, fq, lds, wid, lane); S.done(cur); }
    PG8_STAMP();
    if (STAMP && wid == 0) { stamps[lane] = lane < nts ? (((unsigned long long)(unsigned)ts_hi << 32) | (unsigned)ts_lo) : 0ull;
        if (lane == 62) stamps[62] = rt_entry; if (lane == 63) stamps[63] = (unsigned long long)wall_clock64(); }
#undef PG8_STAMP
#undef PG8_SA
#undef PG8_SB
#undef PG8_STAGE
#undef PG8_LDA
#undef PG8_LDB
#undef PG8_MMA
#undef PG8_WAIT_V
#undef PG8_WAIT_L
#undef PG8_BAR
#undef PG8_SCHED
}
}
using pg8::bf16_t; using pg8::bf16x8; using pg8::f32x4; using pg8::u32x4;
#define DI __device__ __forceinline__
typedef float f32x16 __attribute__((ext_vector_type(16)));
typedef float f32x2 __attribute__((ext_vector_type(2)));
typedef short s16x4 __attribute__((ext_vector_type(4)));
typedef unsigned u32x2 __attribute__((ext_vector_type(2)));
typedef __bf16 bfv2 __attribute__((ext_vector_type(2)));

constexpr int T = 16384, SEQ = 2048, DM = 1024, NIN = 12552, NU = 12544;
constexpr float EPS = 1e-6f, LOG2E = 1.4426950408889634f;
constexpr int U_QA = 0, U_KA = 512, U_VA = 1024, U_OA = 1536, U_ZA = 2048, U_XB = 2560, U_ZB = 3072, U_QC = 3584, U_KC = 4096, U_VC = 4224, U_ZC = 4352,
              U_QD = 4864, U_FD = 5376, U_ID = 5888, U_ZD = 6400, U_QE = 6912, U_ZE = 7168, U_G = 7424;
constexpr size_t WS_WIN = 0, SZ_WIN = (size_t)NU * 1024 * 2;
constexpr size_t WS_WBR = WS_WIN + SZ_WIN, SZ_WBR = (size_t)4 * 2304 * 1024 * 2;
constexpr size_t WS_WOUT = WS_WBR + SZ_WBR, SZ_WOUT = (size_t)4 * 1024 * 1024 * 2;
constexpr size_t WS_KVM = WS_WOUT + SZ_WOUT, SZ_KVM = (size_t)2048 * 2048 * 2;
constexpr size_t WS_H = WS_KVM + SZ_KVM, SZ_H = (size_t)T * 1024 * 2;
constexpr size_t WS_IF = WS_H + SZ_H, SZ_IF = (size_t)T * 8 * 4;
constexpr size_t WS_LB = WS_IF + SZ_IF, SZ_LB = 4 * 512 * 4;
constexpr size_t WS_NA = WS_LB + SZ_LB, SZ_NA = 512 * 128 * 4;
constexpr size_t WS_GA = WS_NA + SZ_NA, SZ_GA = 512 * 4;
constexpr size_t WS_DECD = WS_GA + SZ_GA, SZ_DECD = 1024 * 128 * 4;
constexpr size_t WS_CARB = WS_DECD + SZ_DECD, SZ_CARB = 256 * 512 * 4;
constexpr size_t WS_U = WS_CARB + SZ_CARB, SZ_U = (size_t)T * NU * 2;
constexpr size_t WS_MEMN = WS_U, WS_WMEM = WS_U + (size_t)2048 * 1024 * 2;
constexpr size_t WS_YS = WS_U + SZ_U;
constexpr size_t WS_YA = WS_YS, WS_YB = WS_YA + (size_t)T * 512 * 2, WS_YC = WS_YB + (size_t)T * 512 * 2, WS_YD = WS_YC + (size_t)T * 512 * 2, WS_YE = WS_YD + (size_t)T * 512 * 2;
constexpr size_t WS_ST = WS_YE + (size_t)T * 256 * 2;
constexpr size_t WS_STA = WS_ST, WS_STD = WS_STA + (size_t)512 * 16384 * 4, WS_LRUH = WS_STD + (size_t)1024 * 16384 * 4, WS_LRUA = WS_LRUH + (size_t)T * 512 * 4;
constexpr size_t WS_YF = WS_ST;
constexpr size_t WS_END = WS_LRUA + (size_t)T * 512 * 4;
constexpr int LDS_BYTES = 155648;

struct Params {
    const float* x; const float* mem; const int* pos; const float* norm_g; const float* w_in; const float* mconv_w; const float* b_if; const float* mnorm_g;
    const float* lconv_w; const float* lconv_b; const float* wa; const float* ba; const float* wx; const float* bx; const float* lam; const float* sinks;
    const float* hlb; const float* hnorm_g; const float* mem_g; const float* w_mem; const float* w_br; const float* w_out; const float* fin_g;
    float* out; unsigned char* ws;
};

DI float bf2f(bf16_t b) { return __uint_as_float(((unsigned)b) << 16); }
DI float bflo(unsigned v) { return __uint_as_float(v << 16); }
DI float bfhi(unsigned v) { return __uint_as_float(v & 0xffff0000u); }
DI unsigned pack2(float lo, float hi) { f32x2 v = {lo, hi}; bfv2 b = __builtin_convertvector(v, bfv2); return __builtin_bit_cast(unsigned, b); }
DI bf16_t f2bf(float f) { return (bf16_t)(pack2(f, 0.f) & 0xffffu); }
DI float sigmoidf_(float x) { return 1.0f / (1.0f + __expf(-x)); }
DI float siluf_(float x) { return x * sigmoidf_(x); }
DI float logsigf_(float x) { return fminf(x, 0.f) - log1pf(__expf(-fabsf(x))); }
DI float wave_sum(float v) {
#pragma unroll
    for (int o = 32; o > 0; o >>= 1) v += __shfl_xor(v, o);
    return v;
}
DI int crow(int i, int h) { return (i & 3) + 8 * (i >> 2) + 4 * h; }

template <int MT, int NT> DI void mma_lds(f32x16 (&acc)[MT][NT], const bf16_t* A, int lda, const bf16_t* B, int ldb, int K, int lane) {
    const int r = lane & 31, h = lane >> 5;
    for (int k0 = 0; k0 < K; k0 += 16) {
        bf16x8 a[MT], b[NT];
#pragma unroll
        for (int mt = 0; mt < MT; ++mt) a[mt] = *(const bf16x8*)(A + (32 * mt + r) * lda + k0 + 8 * h);
#pragma unroll
        for (int nt = 0; nt < NT; ++nt) b[nt] = *(const bf16x8*)(B + (32 * nt + r) * ldb + k0 + 8 * h);
#pragma unroll
        for (int mt = 0; mt < MT; ++mt)
#pragma unroll
            for (int nt = 0; nt < NT; ++nt) acc[mt][nt] = __builtin_amdgcn_mfma_f32_32x32x16_bf16(a[mt], b[nt], acc[mt][nt], 0, 0, 0);
    }
}
template <int MT, int NT> DI void zero_acc(f32x16 (&acc)[MT][NT]) {
#pragma unroll
    for (int mt = 0; mt < MT; ++mt)
#pragma unroll
        for (int nt = 0; nt < NT; ++nt)
#pragma unroll
            for (int i = 0; i < 16; ++i) acc[mt][nt][i] = 0.f;
}

struct EpiStoreBf16 {
    static constexpr bool PERM = true, AFTER_DRAIN = false;
    bf16_t* O; int ldc;
    DI void operator()(const f32x4 (&acc)[2][2][4][2], const pg8::Unit& u, int wr, int wc, int fr, int fq) const {
        const int row0 = u.pm * 256 + wr * 64 + fr, col0 = u.pn * 256 + wc * 32 + 8 * fq;
#pragma unroll
        for (int ai = 0; ai < 2; ++ai)
#pragma unroll
            for (int m = 0; m < 4; ++m) { bf16_t* rowp = O + (size_t)(row0 + ai * 128 + m * 16) * ldc + col0;
#pragma unroll
                for (int bj = 0; bj < 2; ++bj) { const f32x4 v0 = acc[ai][bj][m][0], v1 = acc[ai][bj][m][1];
                    u32x4 w; w.x = pack2(v0[0], v0[1]); w.y = pack2(v0[2], v0[3]); w.z = pack2(v1[0], v1[1]); w.w = pack2(v1[2], v1[3]);
                    *(u32x4*)(rowp + bj * 128) = w; } }
    }
};
struct EpiGate {
    static constexpr bool PERM = false, AFTER_DRAIN = false;
    const bf16_t* gates; float* YF; bf16_t* Y16; int mode;
    DI void operator()(const f32x4 (&acc)[2][2][4][2], const pg8::Unit& u, int wr, int wc, int fr, int fq) const {
        const int row0 = u.pm * 256 + wr * 64 + fr, col0 = u.pn * 256 + wc * 32 + 4 * fq;
#pragma unroll
        for (int ai = 0; ai < 2; ++ai)
#pragma unroll
            for (int m = 0; m < 4; ++m) { const size_t r = (size_t)(row0 + ai * 128 + m * 16);
#pragma unroll
                for (int bj = 0; bj < 2; ++bj)
#pragma unroll
                    for (int n = 0; n < 2; ++n) { const int c = col0 + bj * 128 + n * 16;
                        const u32x2 gv = *(const u32x2*)(gates + r * NU + c);
                        f32x4 v = acc[ai][bj][m][n];
                        v[0] *= sigmoidf_(bflo(gv.x)); v[1] *= sigmoidf_(bfhi(gv.x)); v[2] *= sigmoidf_(bflo(gv.y)); v[3] *= sigmoidf_(bfhi(gv.y));
                        float* yp = YF + r * 1024 + c;
                        if (mode == 0) { *(f32x4*)yp = v; }
                        else { const f32x4 o = *(const f32x4*)yp; v += o;
                            if (mode == 1) *(f32x4*)yp = v;
                            else { u32x2 w; w.x = pack2(v[0], v[1]); w.y = pack2(v[2], v[3]); *(u32x2*)(Y16 + r * 1024 + c) = w; } } } }
    }
};
struct EpiRes {
    static constexpr bool PERM = false, AFTER_DRAIN = false;
    const float* xres; float* out;
    DI void operator()(const f32x4 (&acc)[2][2][4][2], const pg8::Unit& u, int wr, int wc, int fr, int fq) const {
        const int row0 = u.pm * 256 + wr * 64 + fr, col0 = u.pn * 256 + wc * 32 + 4 * fq;
#pragma unroll
        for (int ai = 0; ai < 2; ++ai)
#pragma unroll
            for (int m = 0; m < 4; ++m) { const size_t r = (size_t)(row0 + ai * 128 + m * 16);
#pragma unroll
                for (int bj = 0; bj < 2; ++bj)
#pragma unroll
                    for (int n = 0; n < 2; ++n) { const int c = col0 + bj * 128 + n * 16;
                        const f32x4 xv = *(const f32x4*)(xres + r * 1024 + c);
                        *(f32x4*)(out + r * 1024 + c) = xv + acc[ai][bj][m][n]; } }
    }
};
DI void conv_tile(const float* src, int ld_src, int gap_at, int gap_len, const float* scale, bf16_t* dst, int K, int n0, int k0, unsigned char* sm) {
    bf16_t* tl = (bf16_t*)sm;
    const int tid = opaque_tid();
#pragma unroll 4
    for (int i = 0; i < 16; ++i) { const int idx = i * 512 + tid, kk = idx >> 7, nn = idx & 127, n = n0 + nn, col = n + (n >= gap_at ? gap_len : 0);
        float v = src[(size_t)(k0 + kk) * ld_src + col]; if (scale) v *= scale[k0 + kk];
        tl[nn * 72 + kk] = f2bf(v); }
    __syncthreads();
#pragma unroll
    for (int i = 0; i < 2; ++i) { const int idx = i * 512 + tid, nn = idx >> 3, kc = idx & 7;
        *(u32x4*)(dst + (size_t)(n0 + nn) * K + k0 + kc * 8) = *(const u32x4*)(tl + nn * 72 + kc * 8); }
    __syncthreads();
}
DI void phase_prologue(const Params& p, unsigned char* sm) {
    const int tid = opaque_tid(), wid = tid >> 6, lane = tid & 63;
    bf16_t* WBR = (bf16_t*)(p.ws + WS_WBR); bf16_t* WOUT = (bf16_t*)(p.ws + WS_WOUT); bf16_t* WMEM = (bf16_t*)(p.ws + WS_WMEM); bf16_t* MEMN = (bf16_t*)(p.ws + WS_MEMN);
    for (int t = blockIdx.x; t < 4 * 480; t += gridDim.x) {
        const int l = t / 480, r = t % 480;
        if (r < 288) { int j, tt, Kj; if (r < 256) { j = r >> 6; tt = r & 63; Kj = 512; } else { j = 4; tt = r - 256; Kj = 256; }
            const int nkt = Kj / 64, nt = tt / nkt, kt = tt % nkt; const size_t off = (size_t)l * 2304 * 1024 + (size_t)j * 512 * 1024;
            conv_tile(p.w_br + off, 1024, 1 << 30, 0, nullptr, WBR + off, Kj, nt * 128, kt * 64, sm); }
        else if (r < 416) { const int tt = r - 288, nt = tt >> 4, kt = tt & 15; const size_t off = (size_t)l * 1024 * 1024;
            conv_tile(p.w_out + off, 1024, 1 << 30, 0, nullptr, WOUT + off, 1024, nt * 128, kt * 64, sm); }
        else { const int tt = r - 416, nt = tt >> 4, kt = tt & 15;
            conv_tile(p.w_mem + (size_t)l * 1024 * 512, 512, 1 << 30, 0, p.mem_g + l * 1024, WMEM + (size_t)l * 512 * 1024, 1024, nt * 128, kt * 64, sm); }
    }
    for (int row = blockIdx.x * 8 + wid; row < 2048; row += gridDim.x * 8) {
        const float* xr = p.mem + (size_t)row * 1024; f32x4 v[4]; float ss = 0.f;
#pragma unroll
        for (int i = 0; i < 4; ++i) { v[i] = *(const f32x4*)(xr + i * 256 + lane * 4); ss += v[i][0] * v[i][0] + v[i][1] * v[i][1] + v[i][2] * v[i][2] + v[i][3] * v[i][3]; }
        ss = wave_sum(ss); const float rs = rsqrtf(ss * (1.0f / 1024.0f) + EPS);
#pragma unroll
        for (int i = 0; i < 4; ++i) { u32x2 w; w.x = pack2(v[i][0] * rs, v[i][1] * rs); w.y = pack2(v[i][2] * rs, v[i][3] * rs); *(u32x2*)(MEMN + (size_t)row * 1024 + i * 256 + lane * 4) = w; }
    }
    if (blockIdx.x == 0) { float* LB = (float*)(p.ws + WS_LB); const int ch = tid;
        const float v0 = p.hlb[ch], v1 = p.hlb[512 + ch], v2 = p.hlb[1024 + ch], v3 = p.hlb[1536 + ch];
        const float mx = fmaxf(fmaxf(v0, v1), fmaxf(v2, v3)); const float e0 = expf(v0 - mx), e1 = expf(v1 - mx), e2 = expf(v2 - mx), e3 = expf(v3 - mx); const float inv = 1.0f / (e0 + e1 + e2 + e3);
        LB[ch] = 0.f; LB[512 + ch] = e1 * inv; LB[1024 + ch] = (e1 + e2) * inv; LB[1536 + ch] = (e1 + e2 + e3) * inv; }
}
DI void phase_norm(const Params& p, int l, const float* xin, unsigned char* sm) {
    const int tid = opaque_tid(), wid = tid >> 6, lane = tid & 63;
    bf16_t* WIN = (bf16_t*)(p.ws + WS_WIN); const float* wl = p.w_in + (size_t)l * 1024 * NIN;
    for (int t = blockIdx.x; t < 98 * 16; t += gridDim.x) conv_tile(wl, NIN, 2560, 8, nullptr, WIN, 1024, (t >> 4) * 128, (t & 15) * 64, sm);
    float* wif = (float*)sm;
    for (int i = tid; i < 8192; i += 512) wif[i] = wl[(size_t)(i >> 3) * NIN + 2560 + (i & 7)];
    __syncthreads();
    bf16_t* H = (bf16_t*)(p.ws + WS_H); float* IFp = (float*)(p.ws + WS_IF); const float* g = p.norm_g + l * 1024;
    for (int tok = blockIdx.x * 8 + wid; tok < T; tok += gridDim.x * 8) {
        const float* xr = xin + (size_t)tok * 1024; f32x4 v[4]; float ss = 0.f;
#pragma unroll
        for (int i = 0; i < 4; ++i) { v[i] = *(const f32x4*)(xr + i * 256 + lane * 4); ss += v[i][0] * v[i][0] + v[i][1] * v[i][1] + v[i][2] * v[i][2] + v[i][3] * v[i][3]; }
        ss = wave_sum(ss); const float rs = rsqrtf(ss * (1.0f / 1024.0f) + EPS);
        float d0 = 0.f, d1 = 0.f, d2 = 0.f, d3 = 0.f, d4 = 0.f, d5 = 0.f, d6 = 0.f, d7 = 0.f;
#pragma unroll
        for (int i = 0; i < 4; ++i) { const int c0 = i * 256 + lane * 4; const f32x4 gv = *(const f32x4*)(g + c0); f32x4 hv;
#pragma unroll
            for (int j = 0; j < 4; ++j) { hv[j] = v[i][j] * rs * gv[j]; const f32x4 wa_ = *(const f32x4*)(wif + (c0 + j) * 8), wb_ = *(const f32x4*)(wif + (c0 + j) * 8 + 4);
                d0 += hv[j] * wa_[0]; d1 += hv[j] * wa_[1]; d2 += hv[j] * wa_[2]; d3 += hv[j] * wa_[3]; d4 += hv[j] * wb_[0]; d5 += hv[j] * wb_[1]; d6 += hv[j] * wb_[2]; d7 += hv[j] * wb_[3]; }
            u32x2 w; w.x = pack2(hv[0], hv[1]); w.y = pack2(hv[2], hv[3]); *(u32x2*)(H + (size_t)tok * 1024 + c0) = w; }
        d0 = wave_sum(d0); d1 = wave_sum(d1); d2 = wave_sum(d2); d3 = wave_sum(d3); d4 = wave_sum(d4); d5 = wave_sum(d5); d6 = wave_sum(d6); d7 = wave_sum(d7);
        if (lane == 0) { f32x4 a = {d0, d1, d2, d3}, b = {d4, d5, d6, d7}; *(f32x4*)(IFp + (size_t)tok * 8) = a; *(f32x4*)(IFp + (size_t)tok * 8 + 4) = b; }
    }
    __syncthreads();
}
DI void phase_final_norm(const Params& p) {
    const int tid = opaque_tid(), wid = tid >> 6, lane = tid & 63;
    for (int tok = blockIdx.x * 8 + wid; tok < T; tok += gridDim.x * 8) {
        float* xr = p.out + (size_t)tok * 1024; f32x4 v[4]; float ss = 0.f;
#pragma unroll
        for (int i = 0; i < 4; ++i) { v[i] = *(const f32x4*)(xr + i * 256 + lane * 4); ss += v[i][0] * v[i][0] + v[i][1] * v[i][1] + v[i][2] * v[i][2] + v[i][3] * v[i][3]; }
        ss = wave_sum(ss); const float rs = rsqrtf(ss * (1.0f / 1024.0f) + EPS);
#pragma unroll
        for (int i = 0; i < 4; ++i) { const f32x4 gv = *(const f32x4*)(p.fin_g + i * 256 + lane * 4); f32x4 o = v[i] * rs * gv; *(f32x4*)(xr + i * 256 + lane * 4) = o; }
    }
}
DI void mlstm_gates(const Params& p, int l, int h, int tok0, float* sg, float* sig, float* stmp) {
    const int tid = opaque_tid(); const float* IFp = (const float*)(p.ws + WS_IF);
    if (tid < 128) { const size_t tok = (size_t)(tok0 + tid);
        sig[tid] = IFp[tok * 8 + h] + p.b_if[l * 8 + h];
        stmp[tid] = logsigf_(IFp[tok * 8 + 4 + h] + p.b_if[l * 8 + 4 + h]); }
    __syncthreads();
    if (tid < 128) { float s = 0.f; for (int r = 0; r <= tid; ++r) s += stmp[r]; sg[tid] = s; }
    __syncthreads();
}
DI void conv4_silu_pair(const bf16_t* U, int b, int tseq, int ch, const float (&w0)[4], const float (&w1)[4], float& y0, float& y1) {
    float a0 = 0.f, a1 = 0.f;
#pragma unroll
    for (int k = 0; k < 4; ++k) { const int ts = tseq - 3 + k;
        if (ts >= 0) { const unsigned v = *(const unsigned*)(U + (size_t)(b * SEQ + ts) * NU + ch); a0 += w0[k] * bflo(v); a1 += w1[k] * bfhi(v); } }
    y0 = siluf_(a0); y1 = siluf_(a1);
}
DI void mlstm_local_unit(const Params& p, int l, int ua, unsigned char* sm) {
    const int tid = opaque_tid(), wid = tid >> 6, lane = tid & 63;
    const int bh = ua >> 4, c = ua & 15, b = bh >> 2, h = bh & 3, tok0 = b * SEQ + c * 128;
    float* sg = (float*)sm; float* sig = sg + 128; float* stmp = sg + 256;
    bf16_t* KwT = (bf16_t*)(sm + 2048); bf16_t* VT = (bf16_t*)(sm + 2048 + 34816);
    const bf16_t* U = (const bf16_t*)(p.ws + WS_U);
    mlstm_gates(p, l, h, tok0, sg, sig, stmp);
    const float G = sg[127];
    { const int dp = tid & 63, d = 2 * dp, ch = 512 + h * 128 + d; float w0[4], w1[4];
#pragma unroll
      for (int k = 0; k < 4; ++k) { w0[k] = p.mconv_w[(size_t)l * 4096 + k * 1024 + ch]; w1[k] = p.mconv_w[(size_t)l * 4096 + k * 1024 + ch + 1]; }
      for (int i = 0; i < 16; ++i) { const int r = i * 8 + (tid >> 6); float y0, y1; conv4_silu_pair(U, b, c * 128 + r, ch, w0, w1, y0, y1);
          const float wr_ = __expf(G - sg[r] + sig[r]);
          KwT[d * 136 + r] = f2bf(y0 * wr_); KwT[(d + 1) * 136 + r] = f2bf(y1 * wr_);
          const unsigned vv = *(const unsigned*)(U + (size_t)(tok0 + r) * NU + U_VA + h * 128 + d);
          VT[d * 136 + r] = (bf16_t)(vv & 0xffffu); VT[(d + 1) * 136 + r] = (bf16_t)(vv >> 16); } }
    __syncthreads();
    f32x16 acc[1][2]; zero_acc<1, 2>(acc);
    const int dt = wid & 3, eh = wid >> 2;
    mma_lds<1, 2>(acc, KwT + 32 * dt * 136, 136, VT + 64 * eh * 136, 136, 128, lane);
    float* ST = (float*)(p.ws + WS_STA) + (size_t)ua * 16384;
    { const int r31 = lane & 31, hh = lane >> 5;
#pragma unroll
      for (int nt = 0; nt < 2; ++nt) { const int e = 64 * eh + 32 * nt + r31;
#pragma unroll
          for (int q4 = 0; q4 < 4; ++q4) { const int d0 = 32 * dt + 8 * q4 + 4 * hh; f32x4 v = {acc[0][nt][4 * q4], acc[0][nt][4 * q4 + 1], acc[0][nt][4 * q4 + 2], acc[0][nt][4 * q4 + 3]};
              *(f32x4*)(ST + e * 128 + d0) = v; } } }
    if (tid < 128) { float s = 0.f; for (int r = 0; r < 128; ++r) s += bf2f(KwT[tid * 136 + r]); ((float*)(p.ws + WS_NA))[ua * 128 + tid] = s; }
    if (tid == 0) ((float*)(p.ws + WS_GA))[ua] = G;
    __syncthreads();
}
DI void mlstm_scan(const Params& p) {
    const int gt = blockIdx.x * 512 + opaque_tid(), nth = gridDim.x * 512; const float* GA = (const float*)(p.ws + WS_GA);
    for (int it = gt; it < 32 * 4096; it += nth) { const int bh = it >> 12, v = it & 4095; f32x4 S = {0.f, 0.f, 0.f, 0.f};
        for (int c = 0; c < 16; ++c) { const int ua = bh * 16 + c; f32x4* ptr = (f32x4*)((float*)(p.ws + WS_STA) + (size_t)ua * 16384) + v; const f32x4 tmp = *ptr; *ptr = S; const float eg = __expf(GA[ua]); S = S * eg + tmp; } }
    for (int it = gt; it < 32 * 32; it += nth) { const int bh = it >> 5, v = it & 31; f32x4 S = {0.f, 0.f, 0.f, 0.f};
        for (int c = 0; c < 16; ++c) { const int ua = bh * 16 + c; f32x4* ptr = (f32x4*)((float*)(p.ws + WS_NA) + (size_t)ua * 128) + v; const f32x4 tmp = *ptr; *ptr = S; const float eg = __expf(GA[ua]); S = S * eg + tmp; } }
}
DI void mlstm_out_unit(const Params& p, int l, int ua, unsigned char* sm) {
    const int tid = opaque_tid(), wid = tid >> 6, lane = tid & 63, r31 = lane & 31, hh = lane >> 5;
    const int bh = ua >> 4, c = ua & 15, b = bh >> 2, h = bh & 3, tok0 = b * SEQ + c * 128;
    float* sg = (float*)sm; float* sig = sg + 128; float* sden = sg + 256; float* snp = sg + 384;
    bf16_t* Q = (bf16_t*)(sm + 2048); bf16_t* KP = (bf16_t*)(sm + 36864); bf16_t* VT = (bf16_t*)(sm + 71680); bf16_t* STs = (bf16_t*)(sm + 106496);
    float* Hs = (float*)(sm + 2048);
    const bf16_t* U = (const bf16_t*)(p.ws + WS_U);
    mlstm_gates(p, l, h, tok0, sg, sig, sden);
    { const int dp = tid & 63, d = 2 * dp, chq = h * 128 + d, chk = 512 + chq; float wq0[4], wq1[4], wk0[4], wk1[4];
#pragma unroll
      for (int k = 0; k < 4; ++k) { wq0[k] = p.mconv_w[(size_t)l * 4096 + k * 1024 + chq]; wq1[k] = p.mconv_w[(size_t)l * 4096 + k * 1024 + chq + 1];
                                    wk0[k] = p.mconv_w[(size_t)l * 4096 + k * 1024 + chk]; wk1[k] = p.mconv_w[(size_t)l * 4096 + k * 1024 + chk + 1]; }
      for (int i = 0; i < 16; ++i) { const int r = i * 8 + (tid >> 6); float y0, y1;
          conv4_silu_pair(U, b, c * 128 + r, chq, wq0, wq1, y0, y1); *(unsigned*)(Q + r * 136 + d) = pack2(y0 * 0.08838834764831845f, y1 * 0.08838834764831845f);
          conv4_silu_pair(U, b, c * 128 + r, chk, wk0, wk1, y0, y1); *(unsigned*)(KP + r * 136 + d) = pack2(y0, y1);
          const unsigned vv = *(const unsigned*)(U + (size_t)(tok0 + r) * NU + U_VA + h * 128 + d);
          VT[d * 136 + r] = (bf16_t)(vv & 0xffffu); VT[(d + 1) * 136 + r] = (bf16_t)(vv >> 16); } }
    { const float* ST = (const float*)(p.ws + WS_STA) + (size_t)ua * 16384;
#pragma unroll
      for (int i = 0; i < 8; ++i) { const int idx = i * 512 + tid, e = idx >> 5, d4 = (idx & 31) * 4; const f32x4 v = *(const f32x4*)(ST + e * 128 + d4);
          u32x2 w; w.x = pack2(v[0], v[1]); w.y = pack2(v[2], v[3]); *(u32x2*)(STs + e * 136 + d4) = w; } }
    if (tid < 128) snp[tid] = ((const float*)(p.ws + WS_NA))[ua * 128 + tid];
    __syncthreads();
    const int jt = wid & 3, ch2 = wid >> 2;
    f32x16 acc[1][2]; zero_acc<1, 2>(acc);
    mma_lds<1, 2>(acc, Q + 32 * jt * 136, 136, KP + 64 * ch2 * 136, 136, 128, lane);
    __syncthreads();
#pragma unroll
    for (int nt = 0; nt < 2; ++nt) { const int r = 64 * ch2 + 32 * nt + r31; const float gr = sg[r], ir = sig[r];
#pragma unroll
        for (int i = 0; i < 16; ++i) { const int j = 32 * jt + crow(i, hh); const float val = (r <= j) ? acc[0][nt][i] * __expf(sg[j] - gr + ir) : 0.f; KP[j * 136 + r] = f2bf(val); } }
    __syncthreads();
    f32x16 apv[1][2], aqs[1][2]; zero_acc<1, 2>(apv); zero_acc<1, 2>(aqs);
    mma_lds<1, 2>(apv, KP + 32 * jt * 136, 136, VT + 64 * ch2 * 136, 136, 128, lane);
    mma_lds<1, 2>(aqs, Q + 32 * jt * 136, 136, STs + 64 * ch2 * 136, 136, 128, lane);
    if (tid < 128) { float s1 = 0.f, s2 = 0.f; for (int r = 0; r < 128; ++r) { s1 += bf2f(KP[tid * 136 + r]); s2 += bf2f(Q[tid * 136 + r]) * snp[r]; } sden[tid] = s1 + __expf(sg[tid]) * s2; }
    __syncthreads();
#pragma unroll
    for (int nt = 0; nt < 2; ++nt) { const int e = 64 * ch2 + 32 * nt + r31;
#pragma unroll
        for (int i = 0; i < 16; ++i) { const int j = 32 * jt + crow(i, hh); const float num = apv[0][nt][i] + __expf(sg[j]) * aqs[0][nt][i]; Hs[j * 132 + e] = num / fmaxf(fabsf(sden[j]), 1.0f); } }
    __syncthreads();
    { bf16_t* YA = (bf16_t*)(p.ws + WS_YA); const int e = 2 * lane; const float g0 = p.mnorm_g[l * 512 + h * 128 + e], g1 = p.mnorm_g[l * 512 + h * 128 + e + 1];
      for (int jj = 0; jj < 16; ++jj) { const int j = wid * 16 + jj; const f32x2 v = *(const f32x2*)(Hs + j * 132 + e); const float ss = wave_sum(v[0] * v[0] + v[1] * v[1]); const float rs = rsqrtf(ss * (1.0f / 128.0f) + EPS);
          const size_t tok = (size_t)(tok0 + j); const unsigned ov = *(const unsigned*)(U + tok * NU + U_OA + h * 128 + e), zv = *(const unsigned*)(U + tok * NU + U_ZA + h * 128 + e);
          *(unsigned*)(YA + tok * 512 + h * 128 + e) = pack2(v[0] * rs * g0 * sigmoidf_(bflo(ov)) * siluf_(bflo(zv)), v[1] * rs * g1 * sigmoidf_(bfhi(ov)) * siluf_(bfhi(zv))); } }
    __syncthreads();
}
DI void hgrn_stage_fk(const Params& p, int l, int h, int tok0, float* bT, float* kT) {
    const int tid = opaque_tid(); const bf16_t* U = (const bf16_t*)(p.ws + WS_U); const float* LB = (const float*)(p.ws + WS_LB);
    const int dp = tid & 63, d = 2 * dp; const float lb0 = LB[l * 512 + h * 128 + d], lb1 = LB[l * 512 + h * 128 + d + 1];
#pragma unroll
    for (int i = 0; i < 8; ++i) { const int r = i * 8 + (tid >> 6); const unsigned fv = *(const unsigned*)(U + (size_t)(tok0 + r) * NU + U_FD + h * 128 + d);
        const float f0 = bflo(fv), f1 = bfhi(fv); const float s0 = sigmoidf_(f0), s1 = sigmoidf_(f1);
        bT[d * 68 + r] = __logf(lb0 + (1.0f - lb0) * s0) * LOG2E; bT[(d + 1) * 68 + r] = __logf(lb1 + (1.0f - lb1) * s1) * LOG2E;
        kT[d * 68 + r] = (1.0f - lb0) * sigmoidf_(-f0); kT[(d + 1) * 68 + r] = (1.0f - lb1) * sigmoidf_(-f1); }
}
DI void hgrn_stage_v(const Params& p, int h, int tok0, bf16_t* VT) {
    const int tid = opaque_tid(); const bf16_t* U = (const bf16_t*)(p.ws + WS_U); const int dp = tid & 63, e = 2 * dp;
#pragma unroll
    for (int i = 0; i < 8; ++i) { const int r = i * 8 + (tid >> 6); const unsigned vv = *(const unsigned*)(U + (size_t)(tok0 + r) * NU + U_ID + h * 128 + e);
        VT[e * 72 + r] = (bf16_t)(vv & 0xffffu); VT[(e + 1) * 72 + r] = (bf16_t)(vv >> 16); }
}
DI void hgrn_cumsum(float* bT) {
    const int tid = opaque_tid();
    if (tid < 128) { float s = 0.f; f32x4* row = (f32x4*)(bT + tid * 68);
#pragma unroll
        for (int q = 0; q < 16; ++q) { f32x4 v = row[q]; v[0] += s; v[1] += v[0]; v[2] += v[1]; v[3] += v[2]; s = v[3]; row[q] = v; } }
}
DI void hgrn_local_unit(const Params& p, int l, int ud, unsigned char* sm) {
    const int tid = opaque_tid(), wid = tid >> 6, lane = tid & 63;
    const int bh = ud >> 5, c = ud & 31, b = bh >> 2, h = bh & 3, tok0 = b * SEQ + c * 64;
    float* bT = (float*)sm; bf16_t* KwT = (bf16_t*)(sm + 34816); bf16_t* VT = (bf16_t*)(sm + 53248); float* kT = (float*)(sm + 71680);
    hgrn_stage_fk(p, l, h, tok0, bT, kT); hgrn_stage_v(p, h, tok0, VT);
    __syncthreads();
    hgrn_cumsum(bT);
    __syncthreads();
#pragma unroll
    for (int i = 0; i < 16; ++i) { const int idx = i * 512 + tid, d = idx >> 6, r = idx & 63; const float bend = bT[d * 68 + 63];
        KwT[d * 72 + r] = f2bf(kT[d * 68 + r] * __builtin_amdgcn_exp2f(bend - bT[d * 68 + r])); }
    if (tid < 128) ((float*)(p.ws + WS_DECD))[ud * 128 + tid] = __builtin_amdgcn_exp2f(bT[tid * 68 + 63]);
    __syncthreads();
    f32x16 acc[1][2]; zero_acc<1, 2>(acc);
    const int dt = wid & 3, eh = wid >> 2;
    mma_lds<1, 2>(acc, KwT + 32 * dt * 72, 72, VT + 64 * eh * 72, 72, 64, lane);
    float* ST = (float*)(p.ws + WS_STD) + (size_t)ud * 16384;
    { const int r31 = lane & 31, hh = lane >> 5;
#pragma unroll
      for (int nt = 0; nt < 2; ++nt) { const int e = 64 * eh + 32 * nt + r31;
#pragma unroll
          for (int q4 = 0; q4 < 4; ++q4) { const int d0 = 32 * dt + 8 * q4 + 4 * hh; f32x4 v = {acc[0][nt][4 * q4], acc[0][nt][4 * q4 + 1], acc[0][nt][4 * q4 + 2], acc[0][nt][4 * q4 + 3]};
              *(f32x4*)(ST + e * 128 + d0) = v; } } }
    __syncthreads();
}
DI void hgrn_scan(const Params& p) {
    const int gt = blockIdx.x * 512 + opaque_tid(), nth = gridDim.x * 512; const float* DEC = (const float*)(p.ws + WS_DECD);
    for (int it = gt; it < 32 * 4096; it += nth) { const int bh = it >> 12, v = it & 4095, d4 = (v & 31) * 4; f32x4 S = {0.f, 0.f, 0.f, 0.f};
        for (int c = 0; c < 32; ++c) { const int ud = bh * 32 + c; f32x4* ptr = (f32x4*)((float*)(p.ws + WS_STD) + (size_t)ud * 16384) + v; const f32x4 tmp = *ptr; *ptr = S;
            const f32x4 dec = *(const f32x4*)(DEC + ud * 128 + d4); S = S * dec + tmp; } }
}
DI void hgrn_out_unit(const Params& p, int l, int ud, unsigned char* sm) {
    const int tid = opaque_tid(), wid = tid >> 6, lane = tid & 63, r31 = lane & 31, hh = lane >> 5;
    const int bh = ud >> 5, c = ud & 31, b = bh >> 2, h = bh & 3, tok0 = b * SEQ + c * 64;
    float* bT = (float*)sm; float* kT = (float*)(sm + 34816); float* qT = (float*)(sm + 69632);
    bf16_t* aS = (bf16_t*)(sm + 104448); bf16_t* VT = (bf16_t*)(sm + 113664); bf16_t* Qb = (bf16_t*)(sm + 132096);
    bf16_t* STs = (bf16_t*)(sm + 34816); float* Hs = (float*)(sm + 69632);
    const bf16_t* U = (const bf16_t*)(p.ws + WS_U);
    hgrn_stage_fk(p, l, h, tok0, bT, kT); hgrn_stage_v(p, h, tok0, VT);
    { const int dp = tid & 63, d = 2 * dp;
#pragma unroll
      for (int i = 0; i < 8; ++i) { const int r = i * 8 + (tid >> 6); const unsigned qv = *(const unsigned*)(U + (size_t)(tok0 + r) * NU + U_QD + h * 128 + d);
          qT[d * 68 + r] = siluf_(bflo(qv)) * 0.08838834764831845f; qT[(d + 1) * 68 + r] = siluf_(bfhi(qv)) * 0.08838834764831845f; } }
    __syncthreads();
    hgrn_cumsum(bT);
    __syncthreads();
#pragma unroll
    for (int i = 0; i < 16; ++i) { const int idx = i * 512 + tid, j = idx >> 7, d = idx & 127; Qb[j * 136 + d] = f2bf(qT[d * 68 + j] * __builtin_amdgcn_exp2f(bT[d * 68 + j])); }
    { const int j = tid & 63, rg = tid >> 6; float a0 = 0.f, a1 = 0.f, a2 = 0.f, a3 = 0.f, a4 = 0.f, a5 = 0.f, a6 = 0.f, a7 = 0.f;
      for (int d = 0; d < 128; ++d) { const float qv = qT[d * 68 + j], bj = bT[d * 68 + j];
          const f32x4 k0 = *(const f32x4*)(kT + d * 68 + 8 * rg), k1 = *(const f32x4*)(kT + d * 68 + 8 * rg + 4), b0 = *(const f32x4*)(bT + d * 68 + 8 * rg), b1 = *(const f32x4*)(bT + d * 68 + 8 * rg + 4);
          a0 += qv * k0[0] * __builtin_amdgcn_exp2f(bj - b0[0]); a1 += qv * k0[1] * __builtin_amdgcn_exp2f(bj - b0[1]); a2 += qv * k0[2] * __builtin_amdgcn_exp2f(bj - b0[2]); a3 += qv * k0[3] * __builtin_amdgcn_exp2f(bj - b0[3]);
          a4 += qv * k1[0] * __builtin_amdgcn_exp2f(bj - b1[0]); a5 += qv * k1[1] * __builtin_amdgcn_exp2f(bj - b1[1]); a6 += qv * k1[2] * __builtin_amdgcn_exp2f(bj - b1[2]); a7 += qv * k1[3] * __builtin_amdgcn_exp2f(bj - b1[3]); }
      const int r0 = 8 * rg; u32x4 w;
      w.x = pack2(r0 + 0 <= j ? a0 : 0.f, r0 + 1 <= j ? a1 : 0.f); w.y = pack2(r0 + 2 <= j ? a2 : 0.f, r0 + 3 <= j ? a3 : 0.f);
      w.z = pack2(r0 + 4 <= j ? a4 : 0.f, r0 + 5 <= j ? a5 : 0.f); w.w = pack2(r0 + 6 <= j ? a6 : 0.f, r0 + 7 <= j ? a7 : 0.f);
      *(u32x4*)(aS + j * 72 + r0) = w; }
    __syncthreads();
    { const float* ST = (const float*)(p.ws + WS_STD) + (size_t)ud * 16384;
#pragma unroll
      for (int i = 0; i < 8; ++i) { const int idx = i * 512 + tid, e = idx >> 5, d4 = (idx & 31) * 4; const f32x4 v = *(const f32x4*)(ST + e * 128 + d4);
          u32x2 w; w.x = pack2(v[0], v[1]); w.y = pack2(v[2], v[3]); *(u32x2*)(STs + e * 136 + d4) = w; } }
    __syncthreads();
    const int jt = wid & 1, et = wid >> 1;
    f32x16 acc[1][1]; zero_acc<1, 1>(acc);
    mma_lds<1, 1>(acc, aS + 32 * jt * 72, 72, VT + 32 * et * 72, 72, 64, lane);
    mma_lds<1, 1>(acc, Qb + 32 * jt * 136, 136, STs + 32 * et * 136, 136, 128, lane);
#pragma unroll
    for (int i = 0; i < 16; ++i) Hs[(32 * jt + crow(i, hh)) * 132 + 32 * et + r31] = acc[0][0][i];
    __syncthreads();
    { bf16_t* YD = (bf16_t*)(p.ws + WS_YD); const int e = 2 * lane; const float g0 = p.hnorm_g[l * 512 + h * 128 + e], g1 = p.hnorm_g[l * 512 + h * 128 + e + 1];
      for (int jj = 0; jj < 8; ++jj) { const int j = wid * 8 + jj; const f32x2 v = *(const f32x2*)(Hs + j * 132 + e); const float ss = wave_sum(v[0] * v[0] + v[1] * v[1]); const float rs = rsqrtf(ss * (1.0f / 128.0f) + EPS);
          const size_t tok = (size_t)(tok0 + j); const unsigned zv = *(const unsigned*)(U + tok * NU + U_ZD + h * 128 + e);
          *(unsigned*)(YD + tok * 512 + h * 128 + e) = pack2(v[0] * rs * g0 * siluf_(bflo(zv)), v[1] * rs * g1 * siluf_(bfhi(zv))); } }
    __syncthreads();
}
DI void lru_local_unit(const Params& p, int l, int ub, unsigned char* sm) {
    const int tid = opaque_tid(), wid = tid >> 6, lane = tid & 63, c15 = lane & 15, q = lane >> 4;
    const int b = ub >> 5, c = ub & 31, tseq0 = c * 64, tok0 = b * SEQ + tseq0;
    float* xcf = (float*)sm; bf16_t* xcb = (bf16_t*)(sm + 32768); float* aS = (float*)(sm + 49408); float* uS = (float*)(sm + 82176);
    const bf16_t* U = (const bf16_t*)(p.ws + WS_U);
    float* LH = (float*)(p.ws + WS_LRUH); float* LA = (float*)(p.ws + WS_LRUA);
    bf16x8 waf[4][2], wxf[4][2];
    { const float* wa = p.wa + ((size_t)l * 8 + wid) * 4096; const float* wx = p.wx + ((size_t)l * 8 + wid) * 4096;
#pragma unroll
      for (int nt = 0; nt < 4; ++nt)
#pragma unroll
          for (int ks = 0; ks < 2; ++ks) { u32x4 ta, tx;
#pragma unroll
              for (int jp = 0; jp < 4; ++jp) { const int d = 32 * ks + 8 * q + 2 * jp, e = 16 * nt + c15;
                  ta[jp] = pack2(wa[d * 64 + e], wa[(d + 1) * 64 + e]); tx[jp] = pack2(wx[d * 64 + e], wx[(d + 1) * 64 + e]); }
              waf[nt][ks] = __builtin_bit_cast(bf16x8, ta); wxf[nt][ks] = __builtin_bit_cast(bf16x8, tx); } }
    float gba[4], gbx[4], gsp[4];
#pragma unroll
    for (int nt = 0; nt < 4; ++nt) { const int ch = wid * 64 + 16 * nt + c15; gba[nt] = p.ba[l * 512 + ch]; gbx[nt] = p.bx[l * 512 + ch]; gsp[nt] = 8.0f * log1pf(expf(-p.lam[l * 512 + ch])); }
    const int ch = tid; float cw0 = p.lconv_w[l * 2048 + ch], cw1 = p.lconv_w[l * 2048 + 512 + ch], cw2 = p.lconv_w[l * 2048 + 1024 + ch], cw3 = p.lconv_w[l * 2048 + 1536 + ch], cb = p.lconv_b[l * 512 + ch];
    float x0 = 0.f, x1 = 0.f, x2 = 0.f;
    if (tseq0 > 0) { x0 = bf2f(U[(size_t)(tok0 - 3) * NU + U_XB + ch]); x1 = bf2f(U[(size_t)(tok0 - 2) * NU + U_XB + ch]); x2 = bf2f(U[(size_t)(tok0 - 1) * NU + U_XB + ch]); }
    float hst = 0.f, Ac = 1.f;
    for (int sc = 0; sc < 4; ++sc) {
#pragma unroll 4
        for (int tt = 0; tt < 16; ++tt) { const float x3 = bf2f(U[(size_t)(tok0 + sc * 16 + tt) * NU + U_XB + ch]); const float xc = cb + cw0 * x0 + cw1 * x1 + cw2 * x2 + cw3 * x3;
            xcf[tt * 512 + ch] = xc; xcb[tt * 520 + ch] = f2bf(xc); x0 = x1; x1 = x2; x2 = x3; }
        __syncthreads();
        { f32x4 accA[4], accX[4];
#pragma unroll
          for (int nt = 0; nt < 4; ++nt) { accA[nt] = (f32x4){0.f, 0.f, 0.f, 0.f}; accX[nt] = (f32x4){0.f, 0.f, 0.f, 0.f}; }
#pragma unroll
          for (int ks = 0; ks < 2; ++ks) { const bf16x8 af = *(const bf16x8*)(xcb + c15 * 520 + wid * 64 + 32 * ks + 8 * q);
#pragma unroll
              for (int nt = 0; nt < 4; ++nt) { accA[nt] = __builtin_amdgcn_mfma_f32_16x16x32_bf16(af, waf[nt][ks], accA[nt], 0, 0, 0); accX[nt] = __builtin_amdgcn_mfma_f32_16x16x32_bf16(af, wxf[nt][ks], accX[nt], 0, 0, 0); } }
#pragma unroll
          for (int nt = 0; nt < 4; ++nt) { const int che = wid * 64 + 16 * nt + c15;
#pragma unroll
              for (int i = 0; i < 4; ++i) { const int t = 4 * q + i; const float rg = sigmoidf_(accA[nt][i] + gba[nt]), ig = sigmoidf_(accX[nt][i] + gbx[nt]);
                  const float la = -rg * gsp[nt]; const float a = __expf(la); const float mult = sqrtf(fmaxf(-expm1f(2.0f * la), 0.f));
                  aS[t * 512 + che] = a; uS[t * 512 + che] = mult * ig * xcf[t * 512 + che]; } } }
        __syncthreads();
#pragma unroll 4
        for (int tt = 0; tt < 16; ++tt) { const float a = aS[tt * 512 + ch], u = uS[tt * 512 + ch]; hst = a * hst + u; Ac *= a; const size_t o = (size_t)(tok0 + sc * 16 + tt) * 512 + ch; LH[o] = hst; LA[o] = Ac; }
    }
    __syncthreads();
}
DI void lru_scan(const Params& p) {
    const int gt = blockIdx.x * 512 + opaque_tid(), nth = gridDim.x * 512; const float* LH = (const float*)(p.ws + WS_LRUH); const float* LA = (const float*)(p.ws + WS_LRUA); float* CB = (float*)(p.ws + WS_CARB);
    for (int it = gt; it < 8 * 512; it += nth) { const int b = it >> 9, ch = it & 511; float H = 0.f;
        for (int c = 0; c < 32; ++c) { const size_t last = (size_t)(b * SEQ + c * 64 + 63) * 512 + ch; CB[(b * 32 + c) * 512 + ch] = H; H = LA[last] * H + LH[last]; } }
}
DI void lru_out(const Params& p) {
    const int gt = blockIdx.x * 512 + opaque_tid(), nth = gridDim.x * 512; const float* LH = (const float*)(p.ws + WS_LRUH); const float* LA = (const float*)(p.ws + WS_LRUA); const float* CB = (const float*)(p.ws + WS_CARB);
    const bf16_t* U = (const bf16_t*)(p.ws + WS_U); bf16_t* YB = (bf16_t*)(p.ws + WS_YB);
    for (int it = gt; it < T * 128; it += nth) { const int tok = it >> 7, c4 = (it & 127) * 4; const size_t o = (size_t)tok * 512 + c4;
        const f32x4 hl = *(const f32x4*)(LH + o), ac = *(const f32x4*)(LA + o), cr = *(const f32x4*)(CB + (size_t)(tok >> 6) * 512 + c4); const f32x4 hv = hl + ac * cr;
        const u32x2 zv = *(const u32x2*)(U + (size_t)tok * NU + U_ZB + c4);
        u32x2 w; w.x = pack2(hv[0] * siluf_(bflo(zv.x)), hv[1] * siluf_(bfhi(zv.x))); w.y = pack2(hv[2] * siluf_(bflo(zv.y)), hv[3] * siluf_(bfhi(zv.y))); *(u32x2*)(YB + o) = w; }
}
#define MFMA32(a, b, c) __builtin_amdgcn_mfma_f32_32x32x16_bf16((a), (b), (c), 0, 0, 0)
DI bf16x8 pack_p(const f32x16& x, int s) {
    u32x4 w; w.x = pack2(x[8 * s], x[8 * s + 1]); w.y = pack2(x[8 * s + 2], x[8 * s + 3]); w.z = pack2(x[8 * s + 4], x[8 * s + 5]); w.w = pack2(x[8 * s + 6], x[8 * s + 7]);
    return __builtin_bit_cast(bf16x8, w);
}
DI bf16x8 vt_frag(const bf16_t* VT, int e, int key0, int hh) {
    const s16x4 lo = *(const s16x4*)(VT + e * 264 + key0 + 4 * hh), hi = *(const s16x4*)(VT + e * 264 + key0 + 8 + 4 * hh);
    return __builtin_shufflevector(lo, hi, 0, 1, 2, 3, 4, 5, 6, 7);
}
DI void swa_unit(const Params& p, int l, int uc, unsigned char* sm) {
    const int tid = opaque_tid(), wid = tid >> 6, lane = tid & 63, r31 = lane & 31, hh = lane >> 5;
    const int b = uc >> 5, nb = (uc >> 1) & 15, kv = uc & 1;
    bf16_t* Ks = (bf16_t*)sm; bf16_t* VT = (bf16_t*)(sm + 36864); int* posk = (int*)(sm + 70656);
    const bf16_t* U = (const bf16_t*)(p.ws + WS_U); bf16_t* YC = (bf16_t*)(p.ws + WS_YC);
#pragma unroll
    for (int i = 0; i < 4; ++i) { const int idx = i * 512 + tid, s = idx >> 3, c8 = idx & 7, tseq = nb * 128 - 128 + s; u32x4 v = {0u, 0u, 0u, 0u};
        if (tseq >= 0) v = *(const u32x4*)(U + (size_t)(b * SEQ + tseq) * NU + U_KC + kv * 64 + c8 * 8);
        *(u32x4*)(Ks + s * 72 + c8 * 8) = v; }
#pragma unroll 4
    for (int i = 0; i < 16; ++i) { const int idx = i * 512 + tid, s = idx >> 5, ep = idx & 31, tseq = nb * 128 - 128 + s; unsigned v = 0u;
        if (tseq >= 0) v = *(const unsigned*)(U + (size_t)(b * SEQ + tseq) * NU + U_VC + kv * 64 + 2 * ep);
        VT[(2 * ep) * 264 + s] = (bf16_t)(v & 0xffffu); VT[(2 * ep + 1) * 264 + s] = (bf16_t)(v >> 16); }
    if (tid < 256) { const int tseq = nb * 128 - 128 + tid; posk[tid] = tseq >= 0 ? p.pos[b * SEQ + tseq] : 0; }
    __syncthreads();
    const int g = wid >> 1, th = wid & 1, head = kv * 4 + g; const float slope = exp2f(-(float)(head + 1)), sink = p.sinks[l * 8 + head];
    for (int pass = 0; pass < 2; ++pass) {
        const int t0 = 64 * th + 32 * pass, t = t0 + r31; const size_t tok = (size_t)(b * SEQ + nb * 128 + t);
        bf16x8 qf[4];
#pragma unroll
        for (int ks = 0; ks < 4; ++ks) qf[ks] = *(const bf16x8*)(U + tok * NU + U_QC + head * 64 + 16 * ks + 8 * hh);
        f32x16 acc[5];
#pragma unroll
        for (int mt = 0; mt < 5; ++mt) {
#pragma unroll
            for (int i = 0; i < 16; ++i) acc[mt][i] = 0.f;
#pragma unroll
            for (int ks = 0; ks < 4; ++ks) { const bf16x8 kf = *(const bf16x8*)(Ks + (t0 + 32 * mt + r31) * 72 + 16 * ks + 8 * hh); acc[mt] = MFMA32(kf, qf[ks], acc[mt]); } }
        const int pq = posk[128 + t]; float m = -INFINITY;
#pragma unroll
        for (int mt = 0; mt < 5; ++mt)
#pragma unroll
            for (int i = 0; i < 16; ++i) { const int s = t0 + 32 * mt + crow(i, hh); const bool valid = (s > t) && (s <= t + 128) && (s >= 128 || nb > 0);
                const float dist = fabsf((float)(pq - posk[s])); const float sc = valid ? acc[mt][i] * 0.125f - slope * dist : -INFINITY; acc[mt][i] = sc; m = fmaxf(m, sc); }
        m = fmaxf(m, __shfl_xor(m, 32)); m = fmaxf(m, sink);
        float sum = 0.f;
#pragma unroll
        for (int mt = 0; mt < 5; ++mt)
#pragma unroll
            for (int i = 0; i < 16; ++i) { const float pv = __expf(acc[mt][i] - m); acc[mt][i] = pv; sum += pv; }
        sum += __shfl_xor(sum, 32); sum += __expf(sink - m); const float inv = 1.0f / sum;
        f32x16 o[2];
#pragma unroll
        for (int i = 0; i < 16; ++i) { o[0][i] = 0.f; o[1][i] = 0.f; }
#pragma unroll
        for (int mt = 0; mt < 5; ++mt) {
#pragma unroll
            for (int i = 0; i < 16; ++i) acc[mt][i] *= inv;
#pragma unroll
            for (int s2 = 0; s2 < 2; ++s2) { const bf16x8 pf = pack_p(acc[mt], s2);
#pragma unroll
                for (int et = 0; et < 2; ++et) o[et] = MFMA32(vt_frag(VT, 32 * et + r31, t0 + 32 * mt + 16 * s2, hh), pf, o[et]); } }
#pragma unroll
        for (int et = 0; et < 2; ++et)
#pragma unroll
            for (int q4 = 0; q4 < 4; ++q4) { const int e0 = 32 * et + 8 * q4 + 4 * hh; const u32x2 zv = *(const u32x2*)(U + tok * NU + U_ZC + head * 64 + e0);
                u32x2 w; w.x = pack2(o[et][4 * q4] * siluf_(bflo(zv.x)), o[et][4 * q4 + 1] * siluf_(bfhi(zv.x))); w.y = pack2(o[et][4 * q4 + 2] * siluf_(bflo(zv.y)), o[et][4 * q4 + 3] * siluf_(bfhi(zv.y)));
                *(u32x2*)(YC + tok * 512 + head * 64 + e0) = w; }
    }
    __syncthreads();
}
DI void xattn_unit(const Params& p, int l, int ue, unsigned char* sm) {
    const int tid = opaque_tid(), wid = tid >> 6, lane = tid & 63, r31 = lane & 31, hh = lane >> 5;
    const int b = ue >> 5, hd = (ue >> 3) & 3, qt = ue & 7;
    bf16_t* Ks = (bf16_t*)sm; bf16_t* VT = (bf16_t*)(sm + 36864);
    const bf16_t* U = (const bf16_t*)(p.ws + WS_U); const bf16_t* KVM = (const bf16_t*)(p.ws + WS_KVM); bf16_t* YE = (bf16_t*)(p.ws + WS_YE);
#pragma unroll
    for (int i = 0; i < 4; ++i) { const int idx = i * 512 + tid, s = idx >> 3, c8 = idx & 7;
        *(u32x4*)(Ks + s * 72 + c8 * 8) = *(const u32x4*)(KVM + (size_t)(b * 256 + s) * 2048 + l * 512 + hd * 64 + c8 * 8); }
#pragma unroll 4
    for (int i = 0; i < 16; ++i) { const int idx = i * 512 + tid, s = idx >> 5, ep = idx & 31;
        const unsigned v = *(const unsigned*)(KVM + (size_t)(b * 256 + s) * 2048 + l * 512 + 256 + hd * 64 + 2 * ep);
        VT[(2 * ep) * 264 + s] = (bf16_t)(v & 0xffffu); VT[(2 * ep + 1) * 264 + s] = (bf16_t)(v >> 16); }
    __syncthreads();
    const int t = qt * 256 + 32 * wid + r31; const size_t tok = (size_t)(b * SEQ + t);
    bf16x8 qf[4];
#pragma unroll
    for (int ks = 0; ks < 4; ++ks) qf[ks] = *(const bf16x8*)(U + tok * NU + U_QE + hd * 64 + 16 * ks + 8 * hh);
    float m = -INFINITY;
#pragma unroll 1
    for (int half = 0; half < 2; ++half) { f32x16 acc[4];
#pragma unroll
        for (int mt = 0; mt < 4; ++mt) {
#pragma unroll
            for (int i = 0; i < 16; ++i) acc[mt][i] = 0.f;
#pragma unroll
            for (int ks = 0; ks < 4; ++ks) { const bf16x8 kf = *(const bf16x8*)(Ks + (128 * half + 32 * mt + r31) * 72 + 16 * ks + 8 * hh); acc[mt] = MFMA32(kf, qf[ks], acc[mt]); }
#pragma unroll
            for (int i = 0; i < 16; ++i) m = fmaxf(m, acc[mt][i]); } }
    m = fmaxf(m, __shfl_xor(m, 32)) * 0.125f;
    float sum = 0.f; f32x16 o[2];
#pragma unroll
    for (int i = 0; i < 16; ++i) { o[0][i] = 0.f; o[1][i] = 0.f; }
#pragma unroll 1
    for (int half = 0; half < 2; ++half) { f32x16 acc[4];
#pragma unroll
        for (int mt = 0; mt < 4; ++mt) {
#pragma unroll
            for (int i = 0; i < 16; ++i) acc[mt][i] = 0.f;
#pragma unroll
            for (int ks = 0; ks < 4; ++ks) { const bf16x8 kf = *(const bf16x8*)(Ks + (128 * half + 32 * mt + r31) * 72 + 16 * ks + 8 * hh); acc[mt] = MFMA32(kf, qf[ks], acc[mt]); }
#pragma unroll
            for (int i = 0; i < 16; ++i) { const float pv = __expf(acc[mt][i] * 0.125f - m); acc[mt][i] = pv; sum += pv; }
#pragma unroll
            for (int s2 = 0; s2 < 2; ++s2) { const bf16x8 pf = pack_p(acc[mt], s2);
#pragma unroll
                for (int et = 0; et < 2; ++et) o[et] = MFMA32(vt_frag(VT, 32 * et + r31, 128 * half + 32 * mt + 16 * s2, hh), pf, o[et]); } } }
    sum += __shfl_xor(sum, 32); const float inv = 1.0f / sum;
#pragma unroll
    for (int et = 0; et < 2; ++et)
#pragma unroll
        for (int q4 = 0; q4 < 4; ++q4) { const int e0 = 32 * et + 8 * q4 + 4 * hh; const u32x2 zv = *(const u32x2*)(U + tok * NU + U_ZE + hd * 64 + e0);
            u32x2 w; w.x = pack2(o[et][4 * q4] * inv * siluf_(bflo(zv.x)), o[et][4 * q4 + 1] * inv * siluf_(bfhi(zv.x))); w.y = pack2(o[et][4 * q4 + 2] * inv * siluf_(bflo(zv.y)), o[et][4 * q4 + 3] * inv * siluf_(bfhi(zv.y)));
            *(u32x2*)(YE + tok * 256 + hd * 64 + e0) = w; }
    __syncthreads();
}
__global__ void __launch_bounds__(512, 2) hybrid_fwd(Params p) {
    extern __shared__ __attribute__((aligned(16))) unsigned char shm[];
    cg::grid_group grid = cg::this_grid();
    PG8_LAS unsigned char* lds = (PG8_LAS unsigned char*)shm;
    const int G = (int)gridDim.x, bid = (int)blockIdx.x;
    bf16_t* Ub = (bf16_t*)(p.ws + WS_U); bf16_t* Hb = (bf16_t*)(p.ws + WS_H);
    phase_prologue(p, shm);
    grid.sync();
    { pg8::StaticOrder S; S.init(2048, 2048, G, bid); pg8::Gemm g{(const bf16_t*)(p.ws + WS_MEMN), (const bf16_t*)(p.ws + WS_WMEM), 2048, 2048, 1024};
      EpiStoreBf16 E{(bf16_t*)(p.ws + WS_KVM), 2048}; pg8::gemm_phase<EpiStoreBf16, pg8::StaticOrder, false>(lds, g, S, E, nullptr); }
    grid.sync();
#pragma unroll 1
    for (int l = 0; l < 4; ++l) {
        const float* xin = (l == 0) ? p.x : p.out;
        phase_norm(p, l, xin, shm);
        grid.sync();
        { pg8::StaticOrder S; S.init(T, NU, G, bid); pg8::Gemm g{Hb, (const bf16_t*)(p.ws + WS_WIN), T, NU, 1024};
          EpiStoreBf16 E{Ub, NU}; pg8::gemm_phase<EpiStoreBf16, pg8::StaticOrder, false>(lds, g, S, E, nullptr); }
        grid.sync();
        for (int u = bid; u < 256; u += G) swa_unit(p, l, u, shm);
        for (int u = bid; u < 256; u += G) xattn_unit(p, l, u, shm);
        for (int u = bid; u < 256; u += G) lru_local_unit(p, l, u, shm);
        for (int u = bid; u < 512; u += G) mlstm_local_unit(p, l, u, shm);
        for (int u = bid; u < 1024; u += G) hgrn_local_unit(p, l, u, shm);
        grid.sync();
        mlstm_scan(p); hgrn_scan(p); lru_scan(p);
        grid.sync();
        for (int u = bid; u < 512; u += G) mlstm_out_unit(p, l, u, shm);
        for (int u = bid; u < 1024; u += G) hgrn_out_unit(p, l, u, shm);
        lru_out(p);
        grid.sync();
#pragma unroll 1
        for (int j = 0; j < 5; ++j) { const int Kj = (j < 4) ? 512 : 256;
            pg8::StaticOrder S; S.init(T, 1024, G, bid);
            pg8::Gemm g{(const bf16_t*)(p.ws + WS_YS) + (size_t)j * T * 512, (const bf16_t*)(p.ws + WS_WBR) + (size_t)l * 2304 * 1024 + (size_t)j * 512 * 1024, T, 1024, Kj};
            EpiGate E{Ub + U_G + j * 1024, (float*)(p.ws + WS_YF), Hb, j == 0 ? 0 : (j == 4 ? 2 : 1)};
            pg8::gemm_phase<EpiGate, pg8::StaticOrder, false>(lds, g, S, E, nullptr); }
        grid.sync();
        { pg8::StaticOrder S; S.init(T, 1024, G, bid); pg8::Gemm g{Hb, (const bf16_t*)(p.ws + WS_WOUT) + (size_t)l * 1024 * 1024, T, 1024, 1024};
          EpiRes E{xin, p.out}; pg8::gemm_phase<EpiRes, pg8::StaticOrder, false>(lds, g, S, E, nullptr); }
        grid.sync();
    }
    phase_final_norm(p);
}

extern "C" void kernel_launch(void* const* d_in, const int* in_sizes, int n_in, void* d_out, int out_size, void* d_ws, size_t ws_size, hipStream_t stream) {
    static int grid_blocks = 0;
    if (grid_blocks == 0) {
        if (n_in != 23 || ws_size < WS_END) { fprintf(stderr, "kernel_launch: unexpected n_in %d or ws_size %zu (< %zu)\n", n_in, ws_size, (size_t)WS_END); grid_blocks = -1; return; }
        int dev = 0, cus = 0, per_cu = 0;
        hipGetDevice(&dev); hipDeviceGetAttribute(&cus, hipDeviceAttributeMultiprocessorCount, dev);
        if (hipFuncSetAttribute((const void*)hybrid_fwd, hipFuncAttributeMaxDynamicSharedMemorySize, LDS_BYTES) != hipSuccess) { fprintf(stderr, "kernel_launch: hipFuncSetAttribute failed\n"); grid_blocks = -1; return; }
        if (hipOccupancyMaxActiveBlocksPerMultiprocessor(&per_cu, (const void*)hybrid_fwd, 512, LDS_BYTES) != hipSuccess || per_cu < 1) { fprintf(stderr, "kernel_launch: occupancy query failed (%d)\n", per_cu); (void)hipGetLastError(); per_cu = 1; }
        grid_blocks = cus * per_cu;
    }
    if (grid_blocks < 0) return;
    Params p{};
    p.x = (const float*)d_in[0]; p.mem = (const float*)d_in[1]; p.pos = (const int*)d_in[2]; p.norm_g = (const float*)d_in[3]; p.w_in = (const float*)d_in[4];
    p.mconv_w = (const float*)d_in[5]; p.b_if = (const float*)d_in[6]; p.mnorm_g = (const float*)d_in[7]; p.lconv_w = (const float*)d_in[8]; p.lconv_b = (const float*)d_in[9];
    p.wa = (const float*)d_in[10]; p.ba = (const float*)d_in[11]; p.wx = (const float*)d_in[12]; p.bx = (const float*)d_in[13]; p.lam = (const float*)d_in[14];
    p.sinks = (const float*)d_in[15]; p.hlb = (const float*)d_in[16]; p.hnorm_g = (const float*)d_in[17]; p.mem_g = (const float*)d_in[18]; p.w_mem = (const float*)d_in[19];
    p.w_br = (const float*)d_in[20]; p.w_out = (const float*)d_in[21]; p.fin_g = (const float*)d_in[22];
    p.out = (float*)d_out; p.ws = (unsigned char*)d_ws;
    void* args[] = {&p};
    hipError_t e = hipLaunchCooperativeKernel((const void*)hybrid_fwd, dim3(grid_blocks), dim3(512), args, LDS_BYTES, stream);
    if (e != hipSuccess) fprintf(stderr, "cooperative launch failed: %s (grid %d)\n", hipGetErrorString(e), grid_blocks);
}
```

```cpp
#include <hip/hip_runtime.h>
#include <hip/hip_cooperative_groups.h>
#include <cstdio>
#define PROBE_DUP_P3 0
#define PROBE_DUP_P5 0
#define PROBE_DUP_P6 0
#define PROBE_DUP_P2 0
#define PROBE_SYNCS 0
#define PROBE_UNIT 0
#define PREP(k) for (int rep_ = 0; rep_ < (PROBE_UNIT == (k) ? 2 : 1); ++rep_)
namespace cg = cooperative_groups;
__device__ __forceinline__ int opaque_tid() { int t = (int)threadIdx.x; asm volatile("" : "+v"(t)); return t; }
namespace pg8 {
#define PG8_LAS __attribute__((address_space(3)))
typedef unsigned short bf16_t;
typedef short bf16x8 __attribute__((ext_vector_type(8)));
typedef float f32x4 __attribute__((ext_vector_type(4)));
typedef unsigned u32x4 __attribute__((ext_vector_type(4)));
constexpr int BM = 256, BK = 64, HALF = 128, HTB = HALF * BK * 2  , STAGE_BYTES = 8 * HTB, NXCD = 8, WGM = 8;

__host__ __device__ __forceinline__ int lds_byte(int r, int c) { const int st = (r >> 4) * 2 + (c >> 5), rr = r & 15, cc = c & 31, ob = rr * 64 + cc * 2; return st * 1024 + (ob ^ (((ob >> 9) & 1) << 5)); }
__host__ __device__ __forceinline__ void stage_rc(int b, int& R, int& C) { const int st = b / 1024, sb = b % 1024, swz = sb ^ (((sb >> 9) & 1) << 5); R = (st >> 1) * 16 + swz / 64; C = (st & 1) * 32 + (swz % 64) / 2; }
__host__ __device__ __forceinline__ int perm32(int rho) { const int n = rho >> 4, i = rho & 15; return 8 * (i >> 2) + 4 * n + (i & 3); }

struct Unit { int pm, pn, g; };
struct Gemm { const bf16_t* A; const bf16_t* Bt; int M, N, K; size_t gsA, gsB; };

struct StaticOrder {
    int nM, nN, nwg, G, c;
    __host__ __device__ void init(int M, int N, int G_, int c_) { nM = M / BM; nN = N / BM; nwg = nM * nN; G = G_; c = c_; }
    __host__ __device__ bool next(int i, Unit& u) const {
        const long L = (long)i * G + c; if (L >= nwg) return false;
        int wgid = (int)L; { const int q = nwg / NXCD, r = nwg % NXCD, xcd = wgid % NXCD, off = wgid / NXCD; wgid = (xcd < r ? xcd * (q + 1) : r * (q + 1) + (xcd - r) * q) + off; }
        const int nig = WGM * nN, gid = wgid / nig, fm = gid * WGM, gsz = (nM - fm) < WGM ? (nM - fm) : WGM;
        u.pm = fm + ((wgid % nig) % gsz); u.pn = (wgid % nig) / gsz; u.g = 0; return true;
    }
    __device__ __forceinline__ void a_ready(const Unit&) const {}
    __device__ __forceinline__ void done(const Unit&) const {}
};
template <class Epi, class Sched, bool STAMP = false>
__device__ __forceinline__ void gemm_phase(PG8_LAS unsigned char* lds, const Gemm g_in, const Sched& S, const Epi& E, unsigned long long* stamps) {
    Gemm g = g_in;
    { unsigned long long v = (unsigned long long)g.A; g.A = (const bf16_t*)(((unsigned long long)(unsigned)__builtin_amdgcn_readfirstlane((int)(v >> 32)) << 32) | (unsigned)__builtin_amdgcn_readfirstlane((int)v));
      v = (unsigned long long)g.Bt; g.Bt = (const bf16_t*)(((unsigned long long)(unsigned)__builtin_amdgcn_readfirstlane((int)(v >> 32)) << 32) | (unsigned)__builtin_amdgcn_readfirstlane((int)v)); }
    const int tid = opaque_tid(), wid = __builtin_amdgcn_readfirstlane(tid >> 6), lane = tid & 63, wr = wid >> 2, wc = wid & 3, fr = lane & 15, fq = lane >> 4;
    int K = g.K; asm volatile("" : "+s"(K));
    const int nt = K / BK;
    int ts_lo = 0, ts_hi = 0, nts = 0; const unsigned long long rt_entry = STAMP ? (unsigned long long)wall_clock64() : 0ull;
#define PG8_STAMP() do { if (STAMP && wid == 0 && nts < 64) { const unsigned long long _c = (unsigned long long)clock64(); \
        ts_lo = (lane == nts) ? (int)(unsigned)_c : ts_lo; ts_hi = (lane == nts) ? (int)(unsigned)(_c >> 32) : ts_hi; ++nts; } } while (0)
    PG8_STAMP();
    unsigned voffA[2], voffB[2];
#pragma unroll
    for (int i = 0; i < 2; ++i) { int R, C; stage_rc(tid * 16 + i * 8192, R, C); const int Rb = Epi::PERM ? ((R & ~31) + perm32(R & 31)) : R;
        voffA[i] = (unsigned)(R * K + C) * 2u; voffB[i] = (unsigned)(Rb * K + C) * 2u; }
    const size_t kstep = (size_t)(BK * 2);
    const size_t hstep = (size_t)HALF * K * 2;
    const size_t tstep = 2 * hstep;
    const unsigned ldsw = (unsigned)wid * 1024u;
    const int aoff = lds_byte(wr * 64 + fr, fq * 8), boff = lds_byte(wc * 32 + fr, fq * 8);
#define PG8_SA(b, h) (((b) * 2 + (h)) * HTB)
#define PG8_SB(b, h) ((4 + (b) * 2 + (h)) * HTB)
#define PG8_STAGE(bufoff, gbase, voff) do { _Pragma("unroll") for (int _i = 0; _i < 2; ++_i) \
        __builtin_amdgcn_global_load_lds((const unsigned*)((const char*)(gbase) + (voff)[_i]), (PG8_LAS unsigned*)(lds + (bufoff) + ldsw + _i * 8192), 16, 0, 0); } while (0)
#define PG8_LDA(dst, b, h) do { _Pragma("unroll") for (int m = 0; m < 4; ++m) _Pragma("unroll") for (int k = 0; k < 2; ++k) dst[m][k] = *(const PG8_LAS bf16x8*)(lds + PG8_SA(b, h) + aoff + m * 2048 + k * 1024); } while (0)
#define PG8_LDB(dst, b, h) do { _Pragma("unroll") for (int n = 0; n < 2; ++n) _Pragma("unroll") for (int k = 0; k < 2; ++k) dst[n][k] = *(const PG8_LAS bf16x8*)(lds + PG8_SB(b, h) + boff + n * 2048 + k * 1024); } while (0)
#define PG8_MMA(ai, bj, At, Bt) do { __builtin_amdgcn_s_setprio(1); _Pragma("unroll") for (int m = 0; m < 4; ++m) _Pragma("unroll") for (int n = 0; n < 2; ++n) _Pragma("unroll") for (int k = 0; k < 2; ++k) \
        acc[ai][bj][m][n] = __builtin_amdgcn_mfma_f32_16x16x32_bf16(Bt[n][k], At[m][k], acc[ai][bj][m][n], 0, 0, 0); __builtin_amdgcn_s_setprio(0); } while (0)
#define PG8_WAIT_V(n) asm volatile("s_waitcnt vmcnt(" #n ")" ::: "memory")
#define PG8_WAIT_L(n) asm volatile("s_waitcnt lgkmcnt(" #n ")" ::: "memory")
#define PG8_BAR __builtin_amdgcn_s_barrier()
#define PG8_SCHED __builtin_amdgcn_sched_barrier(0)
    Unit cur, nxt; int ui = 0;
    if (!S.next(0, cur)) return;
    f32x4 acc[2][2][4][2];
#pragma unroll
    for (int a = 0; a < 2; ++a)
#pragma unroll
        for (int b = 0; b < 2; ++b)
#pragma unroll
            for (int m = 0; m < 4; ++m)
#pragma unroll
                for (int n = 0; n < 2; ++n) acc[a][b][m][n] = (f32x4){0.f, 0.f, 0.f, 0.f};
    bf16x8 At[4][2], B0[2][2], B1[2][2];
    const char* cA = (const char*)g.A + (size_t)cur.pm * tstep + (size_t)cur.g * g.gsA; const char* cB = (const char*)g.Bt + (size_t)cur.pn * tstep + (size_t)cur.g * g.gsB;
    S.a_ready(cur);
    PG8_STAGE(PG8_SB(0, 0), cB, voffB); PG8_STAGE(PG8_SA(0, 0), cA, voffA); PG8_STAGE(PG8_SB(0, 1), cB + hstep, voffB); PG8_STAGE(PG8_SA(0, 1), cA + hstep, voffA);
    if (wr == 1) PG8_BAR;
    PG8_WAIT_V(4); PG8_BAR;
    PG8_STAGE(PG8_SB(1, 0), cB + kstep, voffB); PG8_STAGE(PG8_SA(1, 0), cA + kstep, voffA); PG8_STAGE(PG8_SB(1, 1), cB + hstep + kstep, voffB);
    PG8_WAIT_V(6); PG8_BAR;
    PG8_STAMP();
    for (;;) {
        const bool has_next = S.next(ui + 1, nxt);
        const char* nA = has_next ? (const char*)g.A + (size_t)nxt.pm * tstep + (size_t)nxt.g * g.gsA : cA; const char* nB = has_next ? (const char*)g.Bt + (size_t)nxt.pn * tstep + (size_t)nxt.g * g.gsB : cB;
        for (int t = 0; t < nt; t += 2) {
            const bool last = (t == nt - 2);
            const char* a1 = cA + (size_t)(t + 1) * kstep;
            const char* a2 = last ? nA : cA + (size_t)(t + 2) * kstep; const char* b2 = last ? nB : cB + (size_t)(t + 2) * kstep;
            const char* a3 = a2 + kstep; const char* b3 = b2 + kstep;
            if (last && has_next) S.a_ready(nxt);
            PG8_LDB(B0, 0, 0); PG8_SCHED; PG8_LDA(At, 0, 0); PG8_STAGE(PG8_SA(1, 1), a1 + hstep, voffA);
            PG8_WAIT_L(8); PG8_BAR; PG8_WAIT_L(0); PG8_MMA(0, 0, At, B0); PG8_BAR; PG8_SCHED;
            PG8_LDB(B1, 0, 1); PG8_STAGE(PG8_SB(0, 0), b2, voffB);
            PG8_BAR; PG8_WAIT_L(0); PG8_MMA(0, 1, At, B1); PG8_BAR;
            PG8_LDA(At, 0, 1); PG8_STAGE(PG8_SA(0, 0), a2, voffA);
            PG8_BAR; PG8_WAIT_L(0); PG8_MMA(1, 0, At, B0); PG8_BAR; PG8_SCHED;
            PG8_STAGE(PG8_SB(0, 1), b2 + hstep, voffB);
            PG8_WAIT_V(6); PG8_BAR; PG8_MMA(1, 1, At, B1); PG8_BAR;
            PG8_LDB(B0, 1, 0); PG8_SCHED; PG8_LDA(At, 1, 0); PG8_STAGE(PG8_SA(0, 1), a2 + hstep, voffA);
            PG8_WAIT_L(8); PG8_BAR; PG8_WAIT_L(0); PG8_MMA(0, 0, At, B0); PG8_BAR; PG8_SCHED;
            PG8_LDB(B1, 1, 1); PG8_STAGE(PG8_SB(1, 0), b3, voffB);
            PG8_BAR; PG8_WAIT_L(0); PG8_MMA(0, 1, At, B1); PG8_BAR;
            PG8_LDA(At, 1, 1); PG8_STAGE(PG8_SA(1, 0), a3, voffA);
            PG8_BAR; PG8_WAIT_L(0); PG8_MMA(1, 0, At, B0); PG8_BAR; PG8_SCHED;
            PG8_STAGE(PG8_SB(1, 1), b3 + hstep, voffB);
            PG8_WAIT_V(6); PG8_BAR; PG8_MMA(1, 1, At, B1); PG8_BAR;
        }
        PG8_STAMP();
        if constexpr (!Epi::AFTER_DRAIN) { E(acc, cur, wr, wc, fr, fq); S.done(cur); }
        PG8_STAMP();
        if (!has_next) break;
#pragma unroll
        for (int a = 0; a < 2; ++a)
#pragma unroll
            for (int b = 0; b < 2; ++b)
#pragma unroll
                for (int m = 0; m < 4; ++m)
#pragma unroll
                    for (int n = 0; n < 2; ++n) acc[a][b][m][n] = (f32x4){0.f, 0.f, 0.f, 0.f};
        cur = nxt; cA = nA; cB = nB; ++ui;
    }
    PG8_WAIT_V(0);
    if (wr == 0) PG8_BAR;
    PG8_BAR;
    if constexpr (Epi::AFTER_DRAIN) { E.fused(acc, cur, wr, wc, fr, fq, lds, wid, lane); S.done(cur); }
    PG8_STAMP();
    if (STAMP && wid == 0) { stamps[lane] = lane < nts ? (((unsigned long long)(unsigned)ts_hi << 32) | (unsigned)ts_lo) : 0ull;
        if (lane == 62) stamps[62] = rt_entry; if (lane == 63) stamps[63] = (unsigned long long)wall_clock64(); }
#undef PG8_STAMP
#undef PG8_SA
#undef PG8_SB
#undef PG8_STAGE
#undef PG8_LDA
#undef PG8_LDB
#undef PG8_MMA
#undef PG8_WAIT_V
#undef PG8_WAIT_L
#undef PG8_BAR
#undef PG8_SCHED
}
}
using pg8::bf16_t; using pg8::bf16x8; using pg8::f32x4; using pg8::u32x4;
#define DI __device__ __forceinline__
typedef float f32x16 __attribute__((ext_vector_type(16)));
typedef float f32x2 __attribute__((ext_vector_type(2)));
typedef short s16x4 __attribute__((ext_vector_type(4)));
typedef unsigned u32x2 __attribute__((ext_vector_type(2)));
typedef __bf16 bfv2 __attribute__((ext_vector_type(2)));

constexpr int T = 16384, SEQ = 2048, DM = 1024, NIN = 12552, NU = 12544;
constexpr float EPS = 1e-6f, LOG2E = 1.4426950408889634f;
constexpr int U_QA = 0, U_KA = 512, U_VA = 1024, U_OA = 1536, U_ZA = 2048, U_XB = 2560, U_ZB = 3072, U_QC = 3584, U_KC = 4096, U_VC = 4224, U_ZC = 4352,
              U_QD = 4864, U_FD = 5376, U_ID = 5888, U_ZD = 6400, U_QE = 6912, U_ZE = 7168, U_G = 7424;
constexpr size_t WS_WIN = 0, SZ_WIN1 = (size_t)NU * 1024 * 2, SZ_WIN = 2 * SZ_WIN1;
constexpr size_t WS_WBR = WS_WIN + SZ_WIN, SZ_WBR = (size_t)4 * 2304 * 1024 * 2;
constexpr size_t WS_WOUT = WS_WBR + SZ_WBR, SZ_WOUT = (size_t)4 * 1024 * 1024 * 2;
constexpr size_t WS_KVM = WS_WOUT + SZ_WOUT, SZ_KVM = (size_t)2048 * 2048 * 2;
constexpr size_t WS_H = WS_KVM + SZ_KVM, SZ_H = (size_t)T * 1024 * 2;
constexpr size_t WS_IF = WS_H + SZ_H, SZ_IF = (size_t)T * 8 * 4;
constexpr size_t WS_LB = WS_IF + SZ_IF, SZ_LB = 4 * 512 * 4;
constexpr size_t WS_NA = WS_LB + SZ_LB, SZ_NA = 512 * 128 * 4;
constexpr size_t WS_GA = WS_NA + SZ_NA, SZ_GA = 512 * 4;
constexpr size_t WS_DECD = WS_GA + SZ_GA, SZ_DECD = 1024 * 128 * 4;
constexpr size_t WS_CARB = WS_DECD + SZ_DECD, SZ_CARB = 256 * 512 * 4;
constexpr size_t WS_U = WS_CARB + SZ_CARB, SZ_U = (size_t)T * NU * 2;
constexpr size_t WS_MEMN = WS_U, WS_WMEM = WS_U + (size_t)2048 * 1024 * 2;
constexpr size_t WS_YS = WS_U + SZ_U;
constexpr size_t WS_YA = WS_YS, WS_YB = WS_YA + (size_t)T * 512 * 2, WS_YC = WS_YB + (size_t)T * 512 * 2, WS_YD = WS_YC + (size_t)T * 512 * 2, WS_YE = WS_YD + (size_t)T * 512 * 2;
constexpr size_t WS_ST = WS_YE + (size_t)T * 256 * 2;
constexpr size_t WS_STA = WS_ST, WS_STD = WS_STA + (size_t)512 * 16384 * 4, WS_LRUH = WS_STD + (size_t)1024 * 16384 * 4, WS_LRUA = WS_LRUH + (size_t)T * 512 * 4;
constexpr size_t WS_YF = WS_ST;
constexpr size_t WS_BAR = WS_LRUA + (size_t)T * 512 * 4;
constexpr size_t WS_END = WS_BAR + 16384;
constexpr int LDS_BYTES = 155648;

struct Params {
    const float* x; const float* mem; const int* pos; const float* norm_g; const float* w_in; const float* mconv_w; const float* b_if; const float* mnorm_g;
    const float* lconv_w; const float* lconv_b; const float* wa; const float* ba; const float* wx; const float* bx; const float* lam; const float* sinks;
    const float* hlb; const float* hnorm_g; const float* mem_g; const float* w_mem; const float* w_br; const float* w_out; const float* fin_g;
    float* out; unsigned char* ws;
};

DI float bf2f(bf16_t b) { return __uint_as_float(((unsigned)b) << 16); }
DI float bflo(unsigned v) { return __uint_as_float(v << 16); }
DI float bfhi(unsigned v) { return __uint_as_float(v & 0xffff0000u); }
DI unsigned pack2(float lo, float hi) { f32x2 v = {lo, hi}; bfv2 b = __builtin_convertvector(v, bfv2); return __builtin_bit_cast(unsigned, b); }
DI bf16_t f2bf(float f) { return (bf16_t)(pack2(f, 0.f) & 0xffffu); }
DI float fexp_(float x) { return __builtin_amdgcn_exp2f(x * LOG2E); }
DI float sigmoidf_(float x) { return __builtin_amdgcn_rcpf(1.0f + fexp_(-x)); }
DI float siluf_(float x) { return x * sigmoidf_(x); }
DI float logsigf_(float x) { return fminf(x, 0.f) - log1pf(fexp_(-fabsf(x))); }
DI float wave_sum(float v) {
    int x = __float_as_int(v);
    x = __float_as_int(__int_as_float(x) + __int_as_float(__builtin_amdgcn_update_dpp(0, x, 0x128, 0xf, 0xf, false)));
    x = __float_as_int(__int_as_float(x) + __int_as_float(__builtin_amdgcn_update_dpp(0, x, 0x124, 0xf, 0xf, false)));
    x = __float_as_int(__int_as_float(x) + __int_as_float(__builtin_amdgcn_update_dpp(0, x, 0x122, 0xf, 0xf, false)));
    x = __float_as_int(__int_as_float(x) + __int_as_float(__builtin_amdgcn_update_dpp(0, x, 0x121, 0xf, 0xf, false)));
    const float r0 = __int_as_float(__builtin_amdgcn_readlane(x, 0)), r1 = __int_as_float(__builtin_amdgcn_readlane(x, 16)), r2 = __int_as_float(__builtin_amdgcn_readlane(x, 32)), r3 = __int_as_float(__builtin_amdgcn_readlane(x, 48));
    return (r0 + r1) + (r2 + r3);
}
DI int crow(int i, int h) { return (i & 3) + 8 * (i >> 2) + 4 * h; }

template <int MT, int NT> DI void mma_lds(f32x16 (&acc)[MT][NT], const bf16_t* A, int lda, const bf16_t* B, int ldb, int K, int lane) {
    const int r = lane & 31, h = lane >> 5;
    for (int k0 = 0; k0 < K; k0 += 16) {
        bf16x8 a[MT], b[NT];
#pragma unroll
        for (int mt = 0; mt < MT; ++mt) a[mt] = *(const bf16x8*)(A + (32 * mt + r) * lda + k0 + 8 * h);
#pragma unroll
        for (int nt = 0; nt < NT; ++nt) b[nt] = *(const bf16x8*)(B + (32 * nt + r) * ldb + k0 + 8 * h);
#pragma unroll
        for (int mt = 0; mt < MT; ++mt)
#pragma unroll
            for (int nt = 0; nt < NT; ++nt) acc[mt][nt] = __builtin_amdgcn_mfma_f32_32x32x16_bf16(a[mt], b[nt], acc[mt][nt], 0, 0, 0);
    }
}
template <int MT, int NT> DI void zero_acc(f32x16 (&acc)[MT][NT]) {
#pragma unroll
    for (int mt = 0; mt < MT; ++mt)
#pragma unroll
        for (int nt = 0; nt < NT; ++nt)
#pragma unroll
            for (int i = 0; i < 16; ++i) acc[mt][nt][i] = 0.f;
}

struct EpiStoreBf16 {
    static constexpr bool PERM = true, AFTER_DRAIN = false;
    bf16_t* O; int ldc;
    DI void operator()(const f32x4 (&acc)[2][2][4][2], const pg8::Unit& u, int wr, int wc, int fr, int fq) const {
        const int row0 = u.pm * 256 + wr * 64 + fr, col0 = u.pn * 256 + wc * 32 + 8 * fq;
#pragma unroll
        for (int ai = 0; ai < 2; ++ai)
#pragma unroll
            for (int m = 0; m < 4; ++m) { bf16_t* rowp = O + (size_t)(row0 + ai * 128 + m * 16) * ldc + col0;
#pragma unroll
                for (int bj = 0; bj < 2; ++bj) { const f32x4 v0 = acc[ai][bj][m][0], v1 = acc[ai][bj][m][1];
                    u32x4 w; w.x = pack2(v0[0], v0[1]); w.y = pack2(v0[2], v0[3]); w.z = pack2(v1[0], v1[1]); w.w = pack2(v1[2], v1[3]);
                    __builtin_nontemporal_store(w, (u32x4*)(rowp + bj * 128)); } }
    }
};
struct EpiRes {
    static constexpr bool PERM = false, AFTER_DRAIN = false;
    const float* xres; float* out;
    DI void operator()(const f32x4 (&acc)[2][2][4][2], const pg8::Unit& u, int wr, int wc, int fr, int fq) const {
        const int row0 = u.pm * 256 + wr * 64 + fr, col0 = u.pn * 256 + wc * 32 + 4 * fq;
#pragma unroll
        for (int am = 0; am < 4; ++am) { const int ai = am >> 1, m0 = (am & 1) * 2; f32x4 xv[2][2][2];
#pragma unroll
            for (int mm = 0; mm < 2; ++mm) { const size_t r = (size_t)(row0 + ai * 128 + (m0 + mm) * 16);
#pragma unroll
                for (int bj = 0; bj < 2; ++bj)
#pragma unroll
                    for (int n = 0; n < 2; ++n) xv[mm][bj][n] = *(const f32x4*)(xres + r * 1024 + col0 + bj * 128 + n * 16); }
            __builtin_amdgcn_sched_barrier(0);
#pragma unroll
            for (int mm = 0; mm < 2; ++mm) { const size_t r = (size_t)(row0 + ai * 128 + (m0 + mm) * 16);
#pragma unroll
                for (int bj = 0; bj < 2; ++bj)
#pragma unroll
                    for (int n = 0; n < 2; ++n) *(f32x4*)(out + r * 1024 + col0 + bj * 128 + n * 16) = xv[mm][bj][n] + acc[ai][bj][m0 + mm][n]; }
            __builtin_amdgcn_sched_barrier(0); }
    }
};
struct GroupOrder {
    int G, c;
    __device__ bool next(int i, pg8::Unit& u) const { const int tile = c + (i >> 2) * G; if (tile >= 256) return false; pg8::StaticOrder t; t.init(T, 1024, 256, tile); t.next(0, u); u.g = i & 3; return true; }
    DI void a_ready(const pg8::Unit&) const {}
    DI void done(const pg8::Unit&) const {}
};
struct EpiGateAcc {
    static constexpr bool PERM = true, AFTER_DRAIN = false;
    const bf16_t* gates; bf16_t* P; bf16_t* Y16; int goff;
    DI void operator()(const f32x4 (&acc)[2][2][4][2], const pg8::Unit& u, int wr, int wc, int fr, int fq) const {
        const int row0 = u.pm * 256 + wr * 64 + fr, col0 = u.pn * 256 + wc * 32 + 8 * fq, j = u.g + goff;
        const bf16_t* gp = gates + j * 1024 + col0; bf16_t* dst = ((j == 4) ? Y16 : P) + col0; const bf16_t* pp = P + col0;
#pragma unroll
        for (int am = 0; am < 4; ++am) { const int ai = am >> 1, m0 = (am & 1) * 2;
            u32x4 gv[4][2], pv[4][2];
#pragma unroll
            for (int m = m0; m < m0 + 2; ++m) { const size_t r = (size_t)(row0 + ai * 128 + m * 16);
#pragma unroll
                for (int bj = 0; bj < 2; ++bj) { gv[m][bj] = *(const u32x4*)(gp + r * NU + bj * 128); pv[m][bj] = (u32x4){0u, 0u, 0u, 0u}; if (j > 0) pv[m][bj] = *(const u32x4*)(pp + r * 1024 + bj * 128); } }
            __builtin_amdgcn_sched_barrier(0);
#pragma unroll
            for (int m = m0; m < m0 + 2; ++m) { const size_t r = (size_t)(row0 + ai * 128 + m * 16);
#pragma unroll
                for (int bj = 0; bj < 2; ++bj) { const u32x4 g4 = gv[m][bj], p4 = pv[m][bj]; const f32x4 a0 = acc[ai][bj][m][0], a1 = acc[ai][bj][m][1]; float o[8];
                    o[0] = a0[0] * sigmoidf_(bflo(g4.x)) + bflo(p4.x); o[1] = a0[1] * sigmoidf_(bfhi(g4.x)) + bfhi(p4.x); o[2] = a0[2] * sigmoidf_(bflo(g4.y)) + bflo(p4.y); o[3] = a0[3] * sigmoidf_(bfhi(g4.y)) + bfhi(p4.y);
                    o[4] = a1[0] * sigmoidf_(bflo(g4.z)) + bflo(p4.z); o[5] = a1[1] * sigmoidf_(bfhi(g4.z)) + bfhi(p4.z); o[6] = a1[2] * sigmoidf_(bflo(g4.w)) + bflo(p4.w); o[7] = a1[3] * sigmoidf_(bfhi(g4.w)) + bfhi(p4.w);
                    u32x4 w; w.x = pack2(o[0], o[1]); w.y = pack2(o[2], o[3]); w.z = pack2(o[4], o[5]); w.w = pack2(o[6], o[7]); *(u32x4*)(dst + r * 1024 + bj * 128) = w; } }
            __builtin_amdgcn_sched_barrier(0);
        }
    }
};
DI void conv_tile(const float* src, int ld_src, int gap_at, int gap_len, const float* scale, bf16_t* dst, int K, int n0, int k0, unsigned char* sm) {
    bf16_t* tl = (bf16_t*)sm;
    const int tid = opaque_tid();
    float vld[16];
#pragma unroll
    for (int i = 0; i < 16; ++i) { const int idx = i * 512 + tid, kk = idx >> 7, nn = idx & 127, n = n0 + nn, col = n + (n >= gap_at ? gap_len : 0);
        vld[i] = src[(size_t)(k0 + kk) * ld_src + col]; }
#pragma unroll
    for (int i = 0; i < 16; ++i) { const int idx = i * 512 + tid, kk = idx >> 7, nn = idx & 127;
        float v = vld[i]; if (scale) v *= scale[k0 + kk];
        tl[nn * 72 + kk] = f2bf(v); }
    __syncthreads();
#pragma unroll
    for (int i = 0; i < 2; ++i) { const int idx = i * 512 + tid, nn = idx >> 3, kc = idx & 7;
        *(u32x4*)(dst + (size_t)(n0 + nn) * K + k0 + kc * 8) = *(const u32x4*)(tl + nn * 72 + kc * 8); }
    __syncthreads();
}
DI void phase_prologue(const Params& p, unsigned char* sm) {
    const int tid = opaque_tid(), wid = tid >> 6, lane = tid & 63;
    bf16_t* WBR = (bf16_t*)(p.ws + WS_WBR); bf16_t* WOUT = (bf16_t*)(p.ws + WS_WOUT); bf16_t* WMEM = (bf16_t*)(p.ws + WS_WMEM); bf16_t* MEMN = (bf16_t*)(p.ws + WS_MEMN);
    for (int t = blockIdx.x; t < 4 * 480; t += gridDim.x) {
        const int l = t / 480, r = t % 480;
        if (r < 288) { int j, tt, Kj; if (r < 256) { j = r >> 6; tt = r & 63; Kj = 512; } else { j = 4; tt = r - 256; Kj = 256; }
            const int nkt = Kj / 64, nt = tt / nkt, kt = tt % nkt; const size_t off = (size_t)l * 2304 * 1024 + (size_t)j * 512 * 1024;
            conv_tile(p.w_br + off, 1024, 1 << 30, 0, nullptr, WBR + off, Kj, nt * 128, kt * 64, sm); }
        else if (r < 416) { const int tt = r - 288, nt = tt >> 4, kt = tt & 15; const size_t off = (size_t)l * 1024 * 1024;
            conv_tile(p.w_out + off, 1024, 1 << 30, 0, nullptr, WOUT + off, 1024, nt * 128, kt * 64, sm); }
        else { const int tt = r - 416, nt = tt >> 4, kt = tt & 15;
            conv_tile(p.w_mem + (size_t)l * 1024 * 512, 512, 1 << 30, 0, p.mem_g + l * 1024, WMEM + (size_t)l * 512 * 1024, 1024, nt * 128, kt * 64, sm); }
    }
    for (int row = blockIdx.x * 8 + wid; row < 2048; row += gridDim.x * 8) {
        const float* xr = p.mem + (size_t)row * 1024; f32x4 v[4]; float ss = 0.f;
#pragma unroll
        for (int i = 0; i < 4; ++i) { v[i] = *(const f32x4*)(xr + i * 256 + lane * 4); ss += v[i][0] * v[i][0] + v[i][1] * v[i][1] + v[i][2] * v[i][2] + v[i][3] * v[i][3]; }
        ss = wave_sum(ss); const float rs = rsqrtf(ss * (1.0f / 1024.0f) + EPS);
#pragma unroll
        for (int i = 0; i < 4; ++i) { u32x2 w; w.x = pack2(v[i][0] * rs, v[i][1] * rs); w.y = pack2(v[i][2] * rs, v[i][3] * rs); *(u32x2*)(MEMN + (size_t)row * 1024 + i * 256 + lane * 4) = w; }
    }
    if (blockIdx.x == 0) { float* LB = (float*)(p.ws + WS_LB); const int ch = tid;
        const float v0 = p.hlb[ch], v1 = p.hlb[512 + ch], v2 = p.hlb[1024 + ch], v3 = p.hlb[1536 + ch];
        const float mx = fmaxf(fmaxf(v0, v1), fmaxf(v2, v3)); const float e0 = expf(v0 - mx), e1 = expf(v1 - mx), e2 = expf(v2 - mx), e3 = expf(v3 - mx); const float inv = 1.0f / (e0 + e1 + e2 + e3);
        LB[ch] = 0.f; LB[512 + ch] = e1 * inv; LB[1024 + ch] = (e1 + e2) * inv; LB[1536 + ch] = (e1 + e2 + e3) * inv; }
}
DI void convert_win(const Params& p, int l, int first, int stride, unsigned char* sm) {
    bf16_t* WIN = (bf16_t*)(p.ws + WS_WIN + (size_t)(l & 1) * SZ_WIN1); const float* wl = p.w_in + (size_t)l * 1024 * NIN;
    for (int t = first; t < 98 * 16; t += stride) conv_tile(wl, NIN, 2560, 8, nullptr, WIN, 1024, (t >> 4) * 128, (t & 15) * 64, sm);
}
DI void phase_norm(const Params& p, int l, const float* xin, unsigned char* sm) {
    const int tid = opaque_tid(), wid = tid >> 6, lane = tid & 63;
    const float* wl = p.w_in + (size_t)l * 1024 * NIN;
    float* wif = (float*)sm;
    for (int i = tid; i < 8192; i += 512) wif[i] = wl[(size_t)(i >> 3) * NIN + 2560 + (i & 7)];
    __syncthreads();
    bf16_t* H = (bf16_t*)(p.ws + WS_H); float* IFp = (float*)(p.ws + WS_IF); const float* g = p.norm_g + l * 1024;
    f32x4 vn[4];
    { const int tok = blockIdx.x * 8 + wid; if (tok < T) {
#pragma unroll
        for (int i = 0; i < 4; ++i) vn[i] = *(const f32x4*)(xin + (size_t)tok * 1024 + i * 256 + lane * 4); } }
    for (int tok = blockIdx.x * 8 + wid; tok < T; tok += gridDim.x * 8) {
        f32x4 v[4]; float ss = 0.f;
#pragma unroll
        for (int i = 0; i < 4; ++i) { v[i] = vn[i]; ss += v[i][0] * v[i][0] + v[i][1] * v[i][1] + v[i][2] * v[i][2] + v[i][3] * v[i][3]; }
        { const int tn = tok + gridDim.x * 8; if (tn < T) {
#pragma unroll
            for (int i = 0; i < 4; ++i) vn[i] = *(const f32x4*)(xin + (size_t)tn * 1024 + i * 256 + lane * 4); } }
        ss = wave_sum(ss); const float rs = rsqrtf(ss * (1.0f / 1024.0f) + EPS);
        float d0 = 0.f, d1 = 0.f, d2 = 0.f, d3 = 0.f, d4 = 0.f, d5 = 0.f, d6 = 0.f, d7 = 0.f;
#pragma unroll
        for (int i = 0; i < 4; ++i) { const int c0 = i * 256 + lane * 4; const f32x4 gv = *(const f32x4*)(g + c0); f32x4 hv;
#pragma unroll
            for (int j = 0; j < 4; ++j) { hv[j] = v[i][j] * rs * gv[j]; const f32x4 wa_ = *(const f32x4*)(wif + (c0 + j) * 8), wb_ = *(const f32x4*)(wif + (c0 + j) * 8 + 4);
                d0 += hv[j] * wa_[0]; d1 += hv[j] * wa_[1]; d2 += hv[j] * wa_[2]; d3 += hv[j] * wa_[3]; d4 += hv[j] * wb_[0]; d5 += hv[j] * wb_[1]; d6 += hv[j] * wb_[2]; d7 += hv[j] * wb_[3]; }
            u32x2 w; w.x = pack2(hv[0], hv[1]); w.y = pack2(hv[2], hv[3]); *(u32x2*)(H + (size_t)tok * 1024 + c0) = w; }
        d0 = wave_sum(d0); d1 = wave_sum(d1); d2 = wave_sum(d2); d3 = wave_sum(d3); d4 = wave_sum(d4); d5 = wave_sum(d5); d6 = wave_sum(d6); d7 = wave_sum(d7);
        if (lane == 0) { f32x4 a = {d0, d1, d2, d3}, b = {d4, d5, d6, d7}; *(f32x4*)(IFp + (size_t)tok * 8) = a; *(f32x4*)(IFp + (size_t)tok * 8 + 4) = b; }
    }
    __syncthreads();
}
DI void phase_final_norm(const Params& p) {
    const int tid = opaque_tid(), wid = tid >> 6, lane = tid & 63;
    for (int tok = blockIdx.x * 8 + wid; tok < T; tok += gridDim.x * 8) {
        float* xr = p.out + (size_t)tok * 1024; f32x4 v[4]; float ss = 0.f;
#pragma unroll
        for (int i = 0; i < 4; ++i) { v[i] = *(const f32x4*)(xr + i * 256 + lane * 4); ss += v[i][0] * v[i][0] + v[i][1] * v[i][1] + v[i][2] * v[i][2] + v[i][3] * v[i][3]; }
        ss = wave_sum(ss); const float rs = rsqrtf(ss * (1.0f / 1024.0f) + EPS);
#pragma unroll
        for (int i = 0; i < 4; ++i) { const f32x4 gv = *(const f32x4*)(p.fin_g + i * 256 + lane * 4); f32x4 o = v[i] * rs * gv; *(f32x4*)(xr + i * 256 + lane * 4) = o; }
    }
}
template <int R> DI void transpose_pairs(const unsigned* N, int ldn, bf16_t* Tt, int ldt, int tid) {
    constexpr int CPT = 64 * R / 512; const int r = tid & (R - 1), cq = tid / R;
#pragma unroll
    for (int i = 0; i < CPT; ++i) { const int c = cq * CPT + i; const unsigned w = N[r * ldn + c]; Tt[(2 * c) * ldt + r] = (bf16_t)(w & 0xffffu); Tt[(2 * c + 1) * ldt + r] = (bf16_t)(w >> 16); }
}
DI void mlstm_gates(const Params& p, int l, int h, int tok0, float* sg, float* sig, float* stmp) {
    const int tid = opaque_tid(); const float* IFp = (const float*)(p.ws + WS_IF);
    float lf = 0.f;
    if (tid < 128) { const size_t tok = (size_t)(tok0 + tid);
        sig[tid] = IFp[tok * 8 + h] + p.b_if[l * 8 + h];
        lf = logsigf_(IFp[tok * 8 + 4 + h] + p.b_if[l * 8 + 4 + h]);
#pragma unroll
        for (int o = 1; o < 64; o <<= 1) { const float n = __shfl_up(lf, o); if ((tid & 63) >= o) lf += n; }
        if (tid == 63) stmp[0] = lf; }
    __syncthreads();
    if (tid < 128) { if (tid >= 64) lf += stmp[0]; sg[tid] = lf; }
    __syncthreads();
}
DI void load_win19(const bf16_t* U, int b, int tseq0, int ch, unsigned (&xs)[19]) {
    const bf16_t* ptr = U + ((size_t)(b * SEQ + tseq0) * NU + ch);
    const bool has_prev = tseq0 >= 3;
    xs[0] = 0u; xs[1] = 0u; xs[2] = 0u;
    if (has_prev) { xs[0] = *(const unsigned*)(ptr - 3 * (size_t)NU); xs[1] = *(const unsigned*)(ptr - 2 * (size_t)NU); xs[2] = *(const unsigned*)(ptr - (size_t)NU); }
#pragma unroll
    for (int m = 3; m < 19; ++m) xs[m] = *(const unsigned*)(ptr + (size_t)(m - 3) * NU);
}
DI void conv_win(const unsigned (&xs)[19], int i, const float (&w0)[4], const float (&w1)[4], float& y0, float& y1) {
    float a0 = 0.f, a1 = 0.f;
#pragma unroll
    for (int k = 0; k < 4; ++k) { a0 += w0[k] * bflo(xs[i + k]); a1 += w1[k] * bfhi(xs[i + k]); }
    y0 = siluf_(a0); y1 = siluf_(a1);
}
DI void mlstm_local_unit(const Params& p, int l, int ua, unsigned char* sm) {
    const int tid = opaque_tid(), wid = tid >> 6, lane = tid & 63;
    const int bh = ua >> 4, c = ua & 15, b = bh >> 2, h = bh & 3, tok0 = b * SEQ + c * 128;
    float* sg = (float*)sm; float* sig = sg + 128; float* stmp = sg + 256;
    bf16_t* KwT = (bf16_t*)(sm + 2048); bf16_t* VT = (bf16_t*)(sm + 2048 + 34816);
    const bf16_t* U = (const bf16_t*)(p.ws + WS_U);
    unsigned* N1 = (unsigned*)(sm + 71680); unsigned* N2 = (unsigned*)(sm + 104960);
    { const int dp = tid & 63, d = 2 * dp, ch = 512 + h * 128 + d; float w0[4], w1[4];
#pragma unroll
      for (int k = 0; k < 4; ++k) { w0[k] = p.mconv_w[(size_t)l * 4096 + k * 1024 + ch]; w1[k] = p.mconv_w[(size_t)l * 4096 + k * 1024 + ch + 1]; }
      unsigned xs[19]; load_win19(U, b, c * 128 + 16 * wid, ch, xs);
      unsigned vv[16];
#pragma unroll
      for (int i = 0; i < 16; ++i) vv[i] = *(const unsigned*)(U + (size_t)(tok0 + 16 * wid + i) * NU + U_VA + h * 128 + d);
      mlstm_gates(p, l, h, tok0, sg, sig, stmp);
      const float G_ = sg[127];
#pragma unroll
      for (int i = 0; i < 16; ++i) { const int r = 16 * wid + i; float y0, y1; conv_win(xs, i, w0, w1, y0, y1);
          const float wr_ = fexp_(G_ - sg[r] + sig[r]);
          N1[r * 65 + dp] = pack2(y0 * wr_, y1 * wr_); N2[r * 65 + dp] = vv[i]; } }
    const float G = sg[127];
    __syncthreads();
    transpose_pairs<128>(N1, 65, KwT, 136, tid); transpose_pairs<128>(N2, 65, VT, 136, tid);
    __syncthreads();
    f32x16 acc[1][2]; zero_acc<1, 2>(acc);
    const int dt = wid & 3, eh = wid >> 2;
    mma_lds<1, 2>(acc, KwT + 32 * dt * 136, 136, VT + 64 * eh * 136, 136, 128, lane);
    bf16_t* ST = (bf16_t*)(p.ws + WS_STA) + (size_t)ua * 16384;
    { const int r31 = lane & 31, hh = lane >> 5;
#pragma unroll
      for (int nt = 0; nt < 2; ++nt) { const int e = 64 * eh + 32 * nt + r31;
#pragma unroll
          for (int q4 = 0; q4 < 4; ++q4) { const int d0 = 32 * dt + 8 * q4 + 4 * hh; f32x4 v = {acc[0][nt][4 * q4], acc[0][nt][4 * q4 + 1], acc[0][nt][4 * q4 + 2], acc[0][nt][4 * q4 + 3]};
              u32x2 w; w.x = pack2(v[0], v[1]); w.y = pack2(v[2], v[3]); *(u32x2*)(ST + e * 128 + d0) = w; } } }
    { const int d = tid >> 2, qd = tid & 3; float s = 0.f;
#pragma unroll
      for (int i = 0; i < 4; ++i) { const u32x4 v = *(const u32x4*)(KwT + d * 136 + 32 * qd + 8 * i); s += bflo(v.x) + bfhi(v.x) + bflo(v.y) + bfhi(v.y) + bflo(v.z) + bfhi(v.z) + bflo(v.w) + bfhi(v.w); }
      s += __shfl_xor(s, 1); s += __shfl_xor(s, 2);
      if (qd == 0) ((float*)(p.ws + WS_NA))[ua * 128 + d] = s; }
    if (tid == 0) ((float*)(p.ws + WS_GA))[ua] = G;
    __syncthreads();
}
DI void mlstm_scan(const Params& p) {
    const int gt = blockIdx.x * 512 + opaque_tid(), nth = gridDim.x * 512; const float* GA = (const float*)(p.ws + WS_GA);
    for (int it = gt; it < 32 * 4096; it += nth) { const int bh = it >> 12, v = it & 4095; u32x2* base = (u32x2*)((bf16_t*)(p.ws + WS_STA) + (size_t)bh * 16 * 16384) + v;
        u32x2 tmp[16]; float eg[16];
#pragma unroll
        for (int c = 0; c < 16; ++c) { tmp[c] = base[(size_t)c * 4096]; eg[c] = fexp_(GA[bh * 16 + c]); }
        f32x4 S = {0.f, 0.f, 0.f, 0.f};
#pragma unroll
        for (int c = 0; c < 16; ++c) { u32x2 w; w.x = pack2(S[0], S[1]); w.y = pack2(S[2], S[3]); base[(size_t)c * 4096] = w;
            const f32x4 t = {bflo(tmp[c].x), bfhi(tmp[c].x), bflo(tmp[c].y), bfhi(tmp[c].y)}; S = S * eg[c] + t; } }
    for (int it = gt; it < 32 * 32; it += nth) { const int bh = it >> 5, v = it & 31; f32x4* base = (f32x4*)((float*)(p.ws + WS_NA) + (size_t)bh * 16 * 128) + v;
        f32x4 tmp[16]; float eg[16];
#pragma unroll
        for (int c = 0; c < 16; ++c) { tmp[c] = base[c * 32]; eg[c] = fexp_(GA[bh * 16 + c]); }
        f32x4 S = {0.f, 0.f, 0.f, 0.f};
#pragma unroll
        for (int c = 0; c < 16; ++c) { base[c * 32] = S; S = S * eg[c] + tmp[c]; } }
}
DI void mlstm_out_unit(const Params& p, int l, int ua, unsigned char* sm) {
    const int tid = opaque_tid(), wid = tid >> 6, lane = tid & 63, r31 = lane & 31, hh = lane >> 5;
    const int bh = ua >> 4, c = ua & 15, b = bh >> 2, h = bh & 3, tok0 = b * SEQ + c * 128;
    float* sg = (float*)sm; float* sig = sg + 128; float* sden = sg + 256; float* snp = sg + 384;
    bf16_t* Q = (bf16_t*)(sm + 2048); bf16_t* KP = (bf16_t*)(sm + 36864); bf16_t* VT = (bf16_t*)(sm + 71680); bf16_t* STs = (bf16_t*)(sm + 106496);
    float* Hs = (float*)(sm + 2048);
    const bf16_t* U = (const bf16_t*)(p.ws + WS_U);
    unsigned* N2 = (unsigned*)(sm + 106496);
    u32x4 stv[4];
    { const bf16_t* ST = (const bf16_t*)(p.ws + WS_STA) + (size_t)ua * 16384;
#pragma unroll
      for (int i = 0; i < 4; ++i) { const int idx = i * 512 + tid, e = idx >> 4, d8 = (idx & 15) * 8; stv[i] = *(const u32x4*)(ST + e * 128 + d8); } }
    { const int dp = tid & 63, d = 2 * dp, chq = h * 128 + d, chk = 512 + chq; float wq0[4], wq1[4], wk0[4], wk1[4];
#pragma unroll
      for (int k = 0; k < 4; ++k) { wq0[k] = p.mconv_w[(size_t)l * 4096 + k * 1024 + chq]; wq1[k] = p.mconv_w[(size_t)l * 4096 + k * 1024 + chq + 1];
                                    wk0[k] = p.mconv_w[(size_t)l * 4096 + k * 1024 + chk]; wk1[k] = p.mconv_w[(size_t)l * 4096 + k * 1024 + chk + 1]; }
      unsigned xq[19], xk[19]; load_win19(U, b, c * 128 + 16 * wid, chq, xq); load_win19(U, b, c * 128 + 16 * wid, chk, xk);
      unsigned vv[16];
#pragma unroll
      for (int i = 0; i < 16; ++i) vv[i] = *(const unsigned*)(U + (size_t)(tok0 + 16 * wid + i) * NU + U_VA + h * 128 + d);
      mlstm_gates(p, l, h, tok0, sg, sig, sden);
      __builtin_amdgcn_sched_barrier(0);
#pragma unroll
      for (int i = 0; i < 16; ++i) { const int r = 16 * wid + i; float y0, y1;
          conv_win(xq, i, wq0, wq1, y0, y1); *(unsigned*)(Q + r * 136 + d) = pack2(y0 * 0.08838834764831845f, y1 * 0.08838834764831845f);
          if ((i & 3) == 3) __builtin_amdgcn_sched_barrier(0); }
#pragma unroll
      for (int i = 0; i < 16; ++i) { const int r = 16 * wid + i; float y0, y1;
          conv_win(xk, i, wk0, wk1, y0, y1); *(unsigned*)(KP + r * 136 + d) = pack2(y0, y1);
          if ((i & 3) == 3) __builtin_amdgcn_sched_barrier(0); }
#pragma unroll
      for (int i = 0; i < 16; ++i) N2[(16 * wid + i) * 65 + dp] = vv[i];
      __builtin_amdgcn_sched_barrier(0); }
    if (tid < 128) snp[tid] = ((const float*)(p.ws + WS_NA))[ua * 128 + tid];
    __syncthreads();
    const int jt = wid & 3, ch2 = wid >> 2;
    f32x16 acc[1][2]; zero_acc<1, 2>(acc);
    mma_lds<1, 2>(acc, Q + 32 * jt * 136, 136, KP + 64 * ch2 * 136, 136, 128, lane);
    transpose_pairs<128>(N2, 65, VT, 136, tid);
    __syncthreads();
#pragma unroll
    for (int i = 0; i < 4; ++i) { const int idx = i * 512 + tid, e = idx >> 4, d8 = (idx & 15) * 8; *(u32x4*)(STs + e * 136 + d8) = stv[i]; }
#pragma unroll
    for (int nt = 0; nt < 2; ++nt) { const int r = 64 * ch2 + 32 * nt + r31; const float gr = sg[r], ir = sig[r];
#pragma unroll
        for (int i = 0; i < 16; ++i) { const int j = 32 * jt + crow(i, hh); const float val = (r <= j) ? acc[0][nt][i] * fexp_(sg[j] - gr + ir) : 0.f; KP[j * 136 + r] = f2bf(val); } }
    __syncthreads();
    f32x16 apv[1][2], aqs[1][2]; zero_acc<1, 2>(apv); zero_acc<1, 2>(aqs);
    mma_lds<1, 2>(apv, KP + 32 * jt * 136, 136, VT + 64 * ch2 * 136, 136, 128, lane);
    mma_lds<1, 2>(aqs, Q + 32 * jt * 136, 136, STs + 64 * ch2 * 136, 136, 128, lane);
    { const int j = tid >> 2, qd = tid & 3; float s1 = 0.f, s2 = 0.f;
#pragma unroll
      for (int i = 0; i < 4; ++i) { const u32x4 pv = *(const u32x4*)(KP + j * 136 + 32 * qd + 8 * i), qv = *(const u32x4*)(Q + j * 136 + 32 * qd + 8 * i);
          const f32x4 n0 = *(const f32x4*)(snp + 32 * qd + 8 * i), n1 = *(const f32x4*)(snp + 32 * qd + 8 * i + 4);
          s1 += bflo(pv.x) + bfhi(pv.x) + bflo(pv.y) + bfhi(pv.y) + bflo(pv.z) + bfhi(pv.z) + bflo(pv.w) + bfhi(pv.w);
          s2 += bflo(qv.x) * n0[0] + bfhi(qv.x) * n0[1] + bflo(qv.y) * n0[2] + bfhi(qv.y) * n0[3] + bflo(qv.z) * n1[0] + bfhi(qv.z) * n1[1] + bflo(qv.w) * n1[2] + bfhi(qv.w) * n1[3]; }
      s1 += __shfl_xor(s1, 1); s1 += __shfl_xor(s1, 2); s2 += __shfl_xor(s2, 1); s2 += __shfl_xor(s2, 2);
      if (qd == 0) sden[j] = s1 + fexp_(sg[j]) * s2; }
    __syncthreads();
#pragma unroll
    for (int nt = 0; nt < 2; ++nt) { const int e = 64 * ch2 + 32 * nt + r31;
#pragma unroll
        for (int i = 0; i < 16; ++i) { const int j = 32 * jt + crow(i, hh); const float num = apv[0][nt][i] + fexp_(sg[j]) * aqs[0][nt][i]; Hs[j * 132 + e] = num * __builtin_amdgcn_rcpf(fmaxf(fabsf(sden[j]), 1.0f)); } }
    __syncthreads();
    { bf16_t* YA = (bf16_t*)(p.ws + WS_YA); const int e = 2 * lane; const float g0 = p.mnorm_g[l * 512 + h * 128 + e], g1 = p.mnorm_g[l * 512 + h * 128 + e + 1];
#pragma unroll 1
      for (int j8 = 0; j8 < 16; j8 += 8) {
      unsigned ov[8], zv[8];
#pragma unroll
      for (int jj = 0; jj < 8; ++jj) { const size_t tok = (size_t)(tok0 + wid * 16 + j8 + jj); ov[jj] = *(const unsigned*)(U + tok * NU + U_OA + h * 128 + e); zv[jj] = *(const unsigned*)(U + tok * NU + U_ZA + h * 128 + e); }
#pragma unroll
      for (int jj = 0; jj < 8; ++jj) { const int j = wid * 16 + j8 + jj; const f32x2 v = *(const f32x2*)(Hs + j * 132 + e); const float ss = wave_sum(v[0] * v[0] + v[1] * v[1]); const float rs = rsqrtf(ss * (1.0f / 128.0f) + EPS);
          const size_t tok = (size_t)(tok0 + j);
          *(unsigned*)(YA + tok * 512 + h * 128 + e) = pack2(v[0] * rs * g0 * sigmoidf_(bflo(ov[jj])) * siluf_(bflo(zv[jj])), v[1] * rs * g1 * sigmoidf_(bfhi(ov[jj])) * siluf_(bfhi(zv[jj]))); } } }
    __syncthreads();
}
struct HgIn { unsigned fv[8], qv[8], vv[8]; float lb0, lb1; };
template <bool WITH_Q> DI void hgrn_issue(const Params& p, int l, int ud, HgIn& in) {
    const int tid = opaque_tid(), wid = tid >> 6; const int bh = ud >> 5, c = ud & 31, b = bh >> 2, h = bh & 3, tok0 = b * SEQ + c * 64, d = 2 * (tid & 63);
    const bf16_t* U = (const bf16_t*)(p.ws + WS_U); const float* LB = (const float*)(p.ws + WS_LB);
    in.lb0 = LB[l * 512 + h * 128 + d]; in.lb1 = LB[l * 512 + h * 128 + d + 1];
#pragma unroll
    for (int i = 0; i < 8; ++i) { const size_t rowb = (size_t)(tok0 + 8 * wid + i) * NU + h * 128 + d; in.fv[i] = *(const unsigned*)(U + rowb + U_FD); in.qv[i] = 0u; if (WITH_Q) in.qv[i] = *(const unsigned*)(U + rowb + U_QD); in.vv[i] = *(const unsigned*)(U + rowb + U_ID); }
}
DI void hgrn_local_unit(const Params& p, int l, int ud, const HgIn& in, unsigned char* sm) {
    const int tid = opaque_tid(), wid = tid >> 6, lane = tid & 63;
    const int bh = ud >> 5, c = ud & 31, b = bh >> 2, h = bh & 3, tok0 = b * SEQ + c * 64;
    float* bS = (float*)sm; float* kS = (float*)(sm + 33024);
    bf16_t* KwT = (bf16_t*)(sm + 66048); bf16_t* VT = (bf16_t*)(sm + 84480); unsigned* N2 = (unsigned*)(sm + 102912);
    const bf16_t* U = (const bf16_t*)(p.ws + WS_U); const float* LB = (const float*)(p.ws + WS_LB);
    { const int dp = tid & 63, d = 2 * dp; const float lb0 = in.lb0, lb1 = in.lb1;
#pragma unroll
      for (int i = 0; i < 8; ++i) { const int r = 8 * wid + i; const float f0 = bflo(in.fv[i]), f1 = bfhi(in.fv[i]);
          bS[r * 129 + d] = __builtin_amdgcn_logf(lb0 + (1.0f - lb0) * sigmoidf_(f0)); bS[r * 129 + d + 1] = __builtin_amdgcn_logf(lb1 + (1.0f - lb1) * sigmoidf_(f1));
          kS[r * 129 + d] = (1.0f - lb0) * sigmoidf_(-f0); kS[r * 129 + d + 1] = (1.0f - lb1) * sigmoidf_(-f1);
          N2[r * 65 + dp] = in.vv[i]; } }
    __syncthreads();
    float* tot = (float*)(sm + 119552);
    { const int dd = tid & 127, J = tid >> 7; float s = 0.f;
#pragma unroll
      for (int rr = 0; rr < 16; ++rr) { s += bS[(16 * J + rr) * 129 + dd]; bS[(16 * J + rr) * 129 + dd] = s; }
      tot[J * 128 + dd] = s; }
    transpose_pairs<64>(N2, 65, VT, 72, tid);
    __syncthreads();
#pragma unroll
    for (int i = 0; i < 16; ++i) { const int idx = i * 512 + tid, r = idx & 63, d = idx >> 6, J = r >> 4;
        const float t0 = tot[d], t1 = tot[128 + d], t2 = tot[256 + d], t3 = tot[384 + d];
        const float rest = J == 0 ? t0 + t1 + t2 + t3 : (J == 1 ? t1 + t2 + t3 : (J == 2 ? t2 + t3 : t3));
        KwT[d * 72 + r] = f2bf(kS[r * 129 + d] * __builtin_amdgcn_exp2f(rest - bS[r * 129 + d])); }
    if (tid < 128) ((float*)(p.ws + WS_DECD))[ud * 128 + tid] = __builtin_amdgcn_exp2f(tot[tid] + tot[128 + tid] + tot[256 + tid] + tot[384 + tid]);
    __syncthreads();
    f32x16 acc[1][2]; zero_acc<1, 2>(acc);
    const int dt = wid & 3, eh = wid >> 2;
    mma_lds<1, 2>(acc, KwT + 32 * dt * 72, 72, VT + 64 * eh * 72, 72, 64, lane);
    bf16_t* ST = (bf16_t*)(p.ws + WS_STD) + (size_t)ud * 16384;
    { const int r31 = lane & 31, hh = lane >> 5;
#pragma unroll
      for (int nt = 0; nt < 2; ++nt) { const int e = 64 * eh + 32 * nt + r31;
#pragma unroll
          for (int q4 = 0; q4 < 4; ++q4) { const int d0 = 32 * dt + 8 * q4 + 4 * hh; f32x4 v = {acc[0][nt][4 * q4], acc[0][nt][4 * q4 + 1], acc[0][nt][4 * q4 + 2], acc[0][nt][4 * q4 + 3]};
              u32x2 w; w.x = pack2(v[0], v[1]); w.y = pack2(v[2], v[3]); *(u32x2*)(ST + e * 128 + d0) = w; } } }
    __syncthreads();
}
DI void hgrn_scan(const Params& p) {
    const int gt = blockIdx.x * 512 + opaque_tid(), nth = gridDim.x * 512; const float* DEC = (const float*)(p.ws + WS_DECD);
    for (int it = gt; it < 32 * 4096; it += nth) { const int bh = it >> 12, v = it & 4095, d4 = (v & 31) * 4; f32x4 S = {0.f, 0.f, 0.f, 0.f};
#pragma unroll 1
        for (int half = 0; half < 2; ++half) { u32x2* base = (u32x2*)((bf16_t*)(p.ws + WS_STD) + (size_t)(bh * 32 + half * 16) * 16384) + v; const float* db = DEC + (bh * 32 + half * 16) * 128 + d4;
            u32x2 tmp[16]; f32x4 dec[16];
#pragma unroll
            for (int c = 0; c < 16; ++c) { tmp[c] = base[(size_t)c * 4096]; dec[c] = *(const f32x4*)(db + c * 128); }
#pragma unroll
            for (int c = 0; c < 16; ++c) { u32x2 w; w.x = pack2(S[0], S[1]); w.y = pack2(S[2], S[3]); base[(size_t)c * 4096] = w;
                const f32x4 t = {bflo(tmp[c].x), bfhi(tmp[c].x), bflo(tmp[c].y), bfhi(tmp[c].y)}; S = S * dec[c] + t; } } }
}
DI void hgrn_out_unit(const Params& p, int l, int ud, const HgIn& in, unsigned char* sm) {
    const int tid = opaque_tid(), wid = tid >> 6, lane = tid & 63, r31 = lane & 31, hh = lane >> 5;
    const int bh = ud >> 5, c = ud & 31, b = bh >> 2, h = bh & 3, tok0 = b * SEQ + c * 64;
    float* bS = (float*)sm; bf16_t* STs = (bf16_t*)sm; float* tot = (float*)(sm + 32768);
    bf16_t* Qh = (bf16_t*)(sm + 34816); bf16_t* Qb = (bf16_t*)(sm + 52224); bf16_t* KK = (bf16_t*)(sm + 69632); float* Hs = (float*)(sm + 69632);
    bf16_t* VT = (bf16_t*)(sm + 113152); bf16_t* aS = (bf16_t*)(sm + 131584); unsigned* N2 = (unsigned*)(sm + 69632);
    const bf16_t* U = (const bf16_t*)(p.ws + WS_U); const float* LB = (const float*)(p.ws + WS_LB);
    const int dp = tid & 63, d = 2 * dp, R = wid >> 1;
    float q0[8], q1[8], k0[8], k1[8];
    { const float lb0 = in.lb0, lb1 = in.lb1;
#pragma unroll
      for (int i = 0; i < 8; ++i) { const int r = 8 * wid + i; const float f0 = bflo(in.fv[i]), f1 = bfhi(in.fv[i]);
          bS[r * 128 + d] = __builtin_amdgcn_logf(lb0 + (1.0f - lb0) * sigmoidf_(f0)); bS[r * 128 + d + 1] = __builtin_amdgcn_logf(lb1 + (1.0f - lb1) * sigmoidf_(f1));
          k0[i] = (1.0f - lb0) * sigmoidf_(-f0); k1[i] = (1.0f - lb1) * sigmoidf_(-f1);
          q0[i] = siluf_(bflo(in.qv[i])) * 0.08838834764831845f; q1[i] = siluf_(bfhi(in.qv[i])) * 0.08838834764831845f;
          N2[r * 65 + dp] = in.vv[i]; } }
    __syncthreads();
    transpose_pairs<64>(N2, 65, VT, 72, tid);
    { const int dd = tid & 127, J = tid >> 7; float s = 0.f;
#pragma unroll
      for (int rr = 0; rr < 16; ++rr) { s += bS[(16 * J + rr) * 128 + dd]; bS[(16 * J + rr) * 128 + dd] = s; }
      tot[J * 128 + dd] = s; }
    __syncthreads();
    { const f32x2 t0 = *(const f32x2*)(tot + d), t1 = *(const f32x2*)(tot + 128 + d), t2 = *(const f32x2*)(tot + 256 + d);
      float offa[4], offb[4]; offa[0] = 0.f; offb[0] = 0.f; offa[1] = t0[0]; offb[1] = t0[1]; offa[2] = t0[0] + t1[0]; offb[2] = t0[1] + t1[1]; offa[3] = offa[2] + t2[0]; offb[3] = offb[2] + t2[1];
      const float oRa = R == 0 ? offa[0] : (R == 1 ? offa[1] : (R == 2 ? offa[2] : offa[3])), oRb = R == 0 ? offb[0] : (R == 1 ? offb[1] : (R == 2 ? offb[2] : offb[3]));
#pragma unroll
      for (int i = 0; i < 8; ++i) { const int r = 8 * wid + i; const f32x2 lc = *(const f32x2*)(bS + r * 128 + d);
          *(unsigned*)(Qh + r * 136 + d) = pack2(q0[i] * __builtin_amdgcn_exp2f(lc[0]), q1[i] * __builtin_amdgcn_exp2f(lc[1]));
          *(unsigned*)(Qb + r * 136 + d) = pack2(q0[i] * __builtin_amdgcn_exp2f(lc[0] + oRa), q1[i] * __builtin_amdgcn_exp2f(lc[1] + oRb));
#pragma unroll
          for (int J = 0; J < 4; ++J) if (J >= R) { const int rowoff = 8 * J * (J + 1);
              *(unsigned*)(KK + (rowoff + r) * 136 + d) = pack2(k0[i] * __builtin_amdgcn_exp2f(fminf(offa[J] - oRa - lc[0], 100.f)), k1[i] * __builtin_amdgcn_exp2f(fminf(offb[J] - oRb - lc[1], 100.f))); } } }
    __syncthreads();
    { const bf16_t* ST = (const bf16_t*)(p.ws + WS_STD) + (size_t)ud * 16384;
#pragma unroll
      for (int i = 0; i < 4; ++i) { const int idx = i * 512 + tid, e = idx >> 4, d8 = (idx & 15) * 8; *(u32x4*)(STs + e * 136 + d8) = *(const u32x4*)(ST + e * 128 + d8); } }
    { const int c15 = lane & 15, q4 = lane >> 4;
#pragma unroll
      for (int sl = 0; sl < 2; ++sl) { const int slot = 2 * wid + sl, J = slot >> 2, Rt = slot & 3; f32x4 acc = {0.f, 0.f, 0.f, 0.f};
          if (Rt <= J) { const int rowoff = 8 * J * (J + 1);
#pragma unroll
              for (int ks = 0; ks < 4; ++ks) { const bf16x8 af = *(const bf16x8*)(Qh + (16 * J + c15) * 136 + 32 * ks + 8 * q4), bfr = *(const bf16x8*)(KK + (rowoff + 16 * Rt + c15) * 136 + 32 * ks + 8 * q4);
                  acc = __builtin_amdgcn_mfma_f32_16x16x32_bf16(af, bfr, acc, 0, 0, 0); } }
#pragma unroll
          for (int i = 0; i < 4; ++i) { const int jj = 16 * J + 4 * q4 + i, rr = 16 * Rt + c15; aS[jj * 72 + rr] = f2bf((Rt <= J && rr <= jj) ? acc[i] : 0.f); } } }
    __syncthreads();
    const int jt = wid & 1, et = wid >> 1;
    f32x16 acc[1][1]; zero_acc<1, 1>(acc);
    mma_lds<1, 1>(acc, aS + 32 * jt * 72, 72, VT + 32 * et * 72, 72, 64, lane);
    mma_lds<1, 1>(acc, Qb + 32 * jt * 136, 136, STs + 32 * et * 136, 136, 128, lane);
#pragma unroll
    for (int i = 0; i < 16; ++i) Hs[(32 * jt + crow(i, hh)) * 132 + 32 * et + r31] = acc[0][0][i];
    __syncthreads();
    { bf16_t* YD = (bf16_t*)(p.ws + WS_YD); const int e = 2 * lane; const float g0 = p.hnorm_g[l * 512 + h * 128 + e], g1 = p.hnorm_g[l * 512 + h * 128 + e + 1];
      unsigned zv[8];
#pragma unroll
      for (int jj = 0; jj < 8; ++jj) zv[jj] = *(const unsigned*)(U + (size_t)(tok0 + wid * 8 + jj) * NU + U_ZD + h * 128 + e);
#pragma unroll
      for (int jj = 0; jj < 8; ++jj) { const int j = wid * 8 + jj; const f32x2 v = *(const f32x2*)(Hs + j * 132 + e); const float ss = wave_sum(v[0] * v[0] + v[1] * v[1]); const float rs = rsqrtf(ss * (1.0f / 128.0f) + EPS);
          const size_t tok = (size_t)(tok0 + j);
          *(unsigned*)(YD + tok * 512 + h * 128 + e) = pack2(v[0] * rs * g0 * siluf_(bflo(zv[jj])), v[1] * rs * g1 * siluf_(bfhi(zv[jj]))); } }
    __syncthreads();
}
DI void lru_local_unit(const Params& p, int l, int ub, unsigned char* sm) {
    const int tid = opaque_tid(), wid = tid >> 6, lane = tid & 63, c15 = lane & 15, q = lane >> 4;
    const int b = ub >> 5, c = ub & 31, tseq0 = c * 64, tok0 = b * SEQ + tseq0;
    float* xcf = (float*)sm; bf16_t* xcb = (bf16_t*)(sm + 32768); float* aS = (float*)(sm + 49408); float* uS = (float*)(sm + 82176);
    const bf16_t* U = (const bf16_t*)(p.ws + WS_U);
    unsigned* LHA = (unsigned*)(p.ws + WS_LRUH);
    bf16x8 waf[4][2], wxf[4][2];
    { const float* wa = p.wa + ((size_t)l * 8 + wid) * 4096; const float* wx = p.wx + ((size_t)l * 8 + wid) * 4096;
#pragma unroll
      for (int nt = 0; nt < 4; ++nt)
#pragma unroll
          for (int ks = 0; ks < 2; ++ks) { u32x4 ta, tx;
#pragma unroll
              for (int jp = 0; jp < 4; ++jp) { const int d = 32 * ks + 8 * q + 2 * jp, e = 16 * nt + c15;
                  ta[jp] = pack2(wa[d * 64 + e], wa[(d + 1) * 64 + e]); tx[jp] = pack2(wx[d * 64 + e], wx[(d + 1) * 64 + e]); }
              waf[nt][ks] = __builtin_bit_cast(bf16x8, ta); wxf[nt][ks] = __builtin_bit_cast(bf16x8, tx); } }
    float gba[4], gbx[4], gsp[4];
#pragma unroll
    for (int nt = 0; nt < 4; ++nt) { const int ch = wid * 64 + 16 * nt + c15; gba[nt] = p.ba[l * 512 + ch]; gbx[nt] = p.bx[l * 512 + ch]; gsp[nt] = 8.0f * log1pf(expf(-p.lam[l * 512 + ch])); }
    const int ch = tid; float cw0 = p.lconv_w[l * 2048 + ch], cw1 = p.lconv_w[l * 2048 + 512 + ch], cw2 = p.lconv_w[l * 2048 + 1024 + ch], cw3 = p.lconv_w[l * 2048 + 1536 + ch], cb = p.lconv_b[l * 512 + ch];
    float x0 = 0.f, x1 = 0.f, x2 = 0.f;
    if (tseq0 > 0) { x0 = bf2f(U[(size_t)(tok0 - 3) * NU + U_XB + ch]); x1 = bf2f(U[(size_t)(tok0 - 2) * NU + U_XB + ch]); x2 = bf2f(U[(size_t)(tok0 - 1) * NU + U_XB + ch]); }
    float hst = 0.f, Ac = 1.f;
    float xr[16];
#pragma unroll
    for (int tt = 0; tt < 16; ++tt) xr[tt] = bf2f(U[(size_t)(tok0 + tt) * NU + U_XB + ch]);
    for (int sc = 0; sc < 4; ++sc) {
#pragma unroll
        for (int tt = 0; tt < 16; ++tt) { const float x3 = xr[tt]; const float xc = cb + cw0 * x0 + cw1 * x1 + cw2 * x2 + cw3 * x3;
            xcf[tt * 512 + ch] = xc; xcb[tt * 520 + ch] = f2bf(xc); x0 = x1; x1 = x2; x2 = x3; }
        if (sc < 3) {
#pragma unroll
            for (int tt = 0; tt < 16; ++tt) xr[tt] = bf2f(U[(size_t)(tok0 + (sc + 1) * 16 + tt) * NU + U_XB + ch]); }
        __syncthreads();
        { f32x4 accA[4], accX[4];
#pragma unroll
          for (int nt = 0; nt < 4; ++nt) { accA[nt] = (f32x4){0.f, 0.f, 0.f, 0.f}; accX[nt] = (f32x4){0.f, 0.f, 0.f, 0.f}; }
#pragma unroll
          for (int ks = 0; ks < 2; ++ks) { const bf16x8 af = *(const bf16x8*)(xcb + c15 * 520 + wid * 64 + 32 * ks + 8 * q);
#pragma unroll
              for (int nt = 0; nt < 4; ++nt) { accA[nt] = __builtin_amdgcn_mfma_f32_16x16x32_bf16(af, waf[nt][ks], accA[nt], 0, 0, 0); accX[nt] = __builtin_amdgcn_mfma_f32_16x16x32_bf16(af, wxf[nt][ks], accX[nt], 0, 0, 0); } }
#pragma unroll
          for (int nt = 0; nt < 4; ++nt) { const int che = wid * 64 + 16 * nt + c15;
#pragma unroll
              for (int i = 0; i < 4; ++i) { const int t = 4 * q + i; const float rg = sigmoidf_(accA[nt][i] + gba[nt]), ig = sigmoidf_(accX[nt][i] + gbx[nt]);
                  const float la = -rg * gsp[nt]; const float a = fexp_(la); const float mult = __builtin_amdgcn_sqrtf(fmaxf(fmaf(-a, a, 1.0f), 0.f));
                  aS[t * 512 + che] = a; uS[t * 512 + che] = mult * ig * xcf[t * 512 + che]; } } }
        __syncthreads();
#pragma unroll 4
        for (int tt = 0; tt < 16; ++tt) { const float a = aS[tt * 512 + ch], u = uS[tt * 512 + ch]; hst = a * hst + u; Ac *= a; const size_t o = (size_t)(tok0 + sc * 16 + tt) * 512 + ch; LHA[o] = pack2(hst, Ac); }
    }
    __syncthreads();
}
DI void lru_scan(const Params& p) {
    const int gt = blockIdx.x * 512 + opaque_tid(), nth = gridDim.x * 512; const unsigned* LHA = (const unsigned*)(p.ws + WS_LRUH); float* CB = (float*)(p.ws + WS_CARB);
    for (int it = gt; it < 8 * 512; it += nth) { const int b = it >> 9, ch = it & 511; unsigned ha[32];
#pragma unroll
        for (int c = 0; c < 32; ++c) ha[c] = LHA[(size_t)(b * SEQ + c * 64 + 63) * 512 + ch];
        float H = 0.f;
#pragma unroll
        for (int c = 0; c < 32; ++c) { CB[(b * 32 + c) * 512 + ch] = H; H = bfhi(ha[c]) * H + bflo(ha[c]); } }
}
DI void lru_out(const Params& p) {
    const int gt = blockIdx.x * 512 + opaque_tid(), nth = gridDim.x * 512; const unsigned* LHA = (const unsigned*)(p.ws + WS_LRUH); const float* CB = (const float*)(p.ws + WS_CARB);
    const bf16_t* U = (const bf16_t*)(p.ws + WS_U); bf16_t* YB = (bf16_t*)(p.ws + WS_YB);
    for (int it0 = gt; it0 < T * 128; it0 += 8 * nth) {
        u32x4 ha[8]; f32x4 cr[8]; u32x2 zv[8];
#pragma unroll
        for (int k = 0; k < 8; ++k) { const int it = it0 + k * nth; if (it < T * 128) { const int tok = it >> 7, c4 = (it & 127) * 4; const size_t o = (size_t)tok * 512 + c4;
            ha[k] = *(const u32x4*)(LHA + o); cr[k] = *(const f32x4*)(CB + (size_t)(tok >> 6) * 512 + c4); zv[k] = *(const u32x2*)(U + (size_t)tok * NU + U_ZB + c4); } }
#pragma unroll
        for (int k = 0; k < 8; ++k) { const int it = it0 + k * nth; if (it < T * 128) { const int tok = it >> 7, c4 = (it & 127) * 4; const size_t o = (size_t)tok * 512 + c4;
            const float h0 = bflo(ha[k].x) + bfhi(ha[k].x) * cr[k][0], h1 = bflo(ha[k].y) + bfhi(ha[k].y) * cr[k][1], h2 = bflo(ha[k].z) + bfhi(ha[k].z) * cr[k][2], h3 = bflo(ha[k].w) + bfhi(ha[k].w) * cr[k][3];
            u32x2 w; w.x = pack2(h0 * siluf_(bflo(zv[k].x)), h1 * siluf_(bfhi(zv[k].x))); w.y = pack2(h2 * siluf_(bflo(zv[k].y)), h3 * siluf_(bfhi(zv[k].y))); *(u32x2*)(YB + o) = w; } } }
}
#define MFMA32(a, b, c) __builtin_amdgcn_mfma_f32_32x32x16_bf16((a), (b), (c), 0, 0, 0)
DI bf16x8 pack_p(const f32x16& x, int s) {
    u32x4 w; w.x = pack2(x[8 * s], x[8 * s + 1]); w.y = pack2(x[8 * s + 2], x[8 * s + 3]); w.z = pack2(x[8 * s + 4], x[8 * s + 5]); w.w = pack2(x[8 * s + 6], x[8 * s + 7]);
    return __builtin_bit_cast(bf16x8, w);
}
DI bf16x8 vt_frag(const bf16_t* VT, int e, int key0, int hh) {
    const s16x4 lo = *(const s16x4*)(VT + e * 260 + key0 + 4 * hh), hi = *(const s16x4*)(VT + e * 260 + key0 + 8 + 4 * hh);
    return __builtin_shufflevector(lo, hi, 0, 1, 2, 3, 4, 5, 6, 7);
}
DI void swa_unit(const Params& p, int l, int uc, unsigned char* sm) {
    const int tid = opaque_tid(), wid = tid >> 6, lane = tid & 63, r31 = lane & 31, hh = lane >> 5;
    const int b = uc >> 5, nb = (uc >> 1) & 15, kv = uc & 1;
    bf16_t* Ks = (bf16_t*)sm; bf16_t* VT = (bf16_t*)(sm + 36864); int* posk = (int*)(sm + 70656); unsigned* N2 = (unsigned*)(sm + 71680);
    const bf16_t* U = (const bf16_t*)(p.ws + WS_U); bf16_t* YC = (bf16_t*)(p.ws + WS_YC);
#pragma unroll
    for (int i = 0; i < 4; ++i) { const int idx = i * 512 + tid, s = idx >> 3, c8 = idx & 7, tseq = nb * 128 - 128 + s; u32x4 v = {0u, 0u, 0u, 0u};
        if (tseq >= 0) v = *(const u32x4*)(U + (size_t)(b * SEQ + tseq) * NU + U_KC + kv * 64 + c8 * 8);
        *(u32x4*)(Ks + s * 72 + c8 * 8) = v; }
    { unsigned vv[16];
#pragma unroll
      for (int i = 0; i < 16; ++i) { const int idx = i * 512 + tid, s = idx >> 5, ep = idx & 31; int tseq = nb * 128 - 128 + s; tseq = tseq < 0 ? 0 : tseq;
          vv[i] = *(const unsigned*)(U + (size_t)(b * SEQ + tseq) * NU + U_VC + kv * 64 + 2 * ep); }
#pragma unroll
      for (int i = 0; i < 16; ++i) { const int idx = i * 512 + tid, s = idx >> 5, ep = idx & 31; N2[s * 33 + ep] = (nb * 128 - 128 + s >= 0) ? vv[i] : 0u; } }
    if (tid < 256) { const int tseq = nb * 128 - 128 + tid; posk[tid] = tseq >= 0 ? p.pos[b * SEQ + tseq] : 0; }
    const int g = wid >> 1, th = wid & 1, head = kv * 4 + g; const float slope = exp2f(-(float)(head + 1)), sink = p.sinks[l * 8 + head];
    bf16x8 qn[4];
#pragma unroll
    for (int ks = 0; ks < 4; ++ks) qn[ks] = *(const bf16x8*)(U + (size_t)(b * SEQ + nb * 128 + 64 * th + r31) * NU + U_QC + head * 64 + 16 * ks + 8 * hh);
    __syncthreads();
    { const int s = tid & 255, eq = tid >> 8;
#pragma unroll
      for (int i = 0; i < 16; ++i) { const int ep = eq * 16 + i; const unsigned w = N2[s * 33 + ep]; VT[(2 * ep) * 260 + s] = (bf16_t)(w & 0xffffu); VT[(2 * ep + 1) * 260 + s] = (bf16_t)(w >> 16); } }
    __syncthreads();
#pragma unroll 1
    for (int pass = 0; pass < 2; ++pass) {
        const int t0 = 64 * th + 32 * pass, t = t0 + r31; const size_t tok = (size_t)(b * SEQ + nb * 128 + t);
        bf16x8 qf[4];
#pragma unroll
        for (int ks = 0; ks < 4; ++ks) { qf[ks] = qn[ks]; qn[ks] = *(const bf16x8*)(U + (tok + 32 * (1 - pass)) * NU + U_QC + head * 64 + 16 * ks + 8 * hh); }
        u32x2 zpre[2][4];
#pragma unroll
        for (int et = 0; et < 2; ++et)
#pragma unroll
            for (int q4 = 0; q4 < 4; ++q4) zpre[et][q4] = *(const u32x2*)(U + tok * NU + U_ZC + head * 64 + 32 * et + 8 * q4 + 4 * hh);
        f32x16 acc[5];
#pragma unroll
        for (int mt = 0; mt < 5; ++mt) {
#pragma unroll
            for (int i = 0; i < 16; ++i) acc[mt][i] = 0.f;
#pragma unroll
            for (int ks = 0; ks < 4; ++ks) { const bf16x8 kf = *(const bf16x8*)(Ks + (t0 + 32 * mt + r31) * 72 + 16 * ks + 8 * hh); acc[mt] = MFMA32(kf, qf[ks], acc[mt]); } }
        const int pq = posk[128 + t]; float m = -INFINITY;
#pragma unroll
        for (int mt = 0; mt < 5; ++mt)
#pragma unroll
            for (int g4 = 0; g4 < 4; ++g4) { const int cr0 = 8 * g4 + 4 * hh, sb = t0 + 32 * mt + cr0; const u32x4 pk = *(const u32x4*)(posk + sb);
#pragma unroll
                for (int k = 0; k < 4; ++k) { const int i = 4 * g4 + k; bool valid = (nb > 0) || (sb + k >= 128);
                    if (mt == 0) valid = valid && (cr0 + k > r31);
                    if (mt == 4) valid = valid && (cr0 + k <= r31);
                    const float dist = fabsf((float)(pq - (int)pk[k])); const float sc = valid ? acc[mt][i] * 0.125f - slope * dist : -INFINITY; acc[mt][i] = sc; m = fmaxf(m, sc); } }
        m = fmaxf(m, __shfl_xor(m, 32)); m = fmaxf(m, sink);
        float sum = 0.f;
#pragma unroll
        for (int mt = 0; mt < 5; ++mt)
#pragma unroll
            for (int i = 0; i < 16; ++i) { const float pv = fexp_(acc[mt][i] - m); acc[mt][i] = pv; sum += pv; }
        sum += __shfl_xor(sum, 32); sum += fexp_(sink - m); const float inv = __builtin_amdgcn_rcpf(sum);
        f32x16 o[2];
#pragma unroll
        for (int i = 0; i < 16; ++i) { o[0][i] = 0.f; o[1][i] = 0.f; }
#pragma unroll
        for (int mt = 0; mt < 5; ++mt) {
#pragma unroll
            for (int i = 0; i < 16; ++i) acc[mt][i] *= inv;
#pragma unroll
            for (int s2 = 0; s2 < 2; ++s2) { const bf16x8 pf = pack_p(acc[mt], s2);
#pragma unroll
                for (int et = 0; et < 2; ++et) o[et] = MFMA32(vt_frag(VT, 32 * et + r31, t0 + 32 * mt + 16 * s2, hh), pf, o[et]); } }
#pragma unroll
        for (int et = 0; et < 2; ++et)
#pragma unroll
            for (int q4 = 0; q4 < 4; ++q4) { const int e0 = 32 * et + 8 * q4 + 4 * hh; const u32x2 zv = zpre[et][q4];
                u32x2 w; w.x = pack2(o[et][4 * q4] * siluf_(bflo(zv.x)), o[et][4 * q4 + 1] * siluf_(bfhi(zv.x))); w.y = pack2(o[et][4 * q4 + 2] * siluf_(bflo(zv.y)), o[et][4 * q4 + 3] * siluf_(bfhi(zv.y)));
                *(u32x2*)(YC + tok * 512 + head * 64 + e0) = w; }
    }
    __syncthreads();
}
DI void xattn_unit(const Params& p, int l, int ue, unsigned char* sm) {
    const int tid = opaque_tid(), wid = tid >> 6, lane = tid & 63, r31 = lane & 31, hh = lane >> 5;
    const int b = ue >> 5, hd = (ue >> 3) & 3, qt = ue & 7;
    bf16_t* Ks = (bf16_t*)sm; bf16_t* VT = (bf16_t*)(sm + 36864); unsigned* N2 = (unsigned*)(sm + 71680);
    const bf16_t* U = (const bf16_t*)(p.ws + WS_U); const bf16_t* KVM = (const bf16_t*)(p.ws + WS_KVM); bf16_t* YE = (bf16_t*)(p.ws + WS_YE);
#pragma unroll
    for (int i = 0; i < 4; ++i) { const int idx = i * 512 + tid, s = idx >> 3, c8 = idx & 7;
        *(u32x4*)(Ks + s * 72 + c8 * 8) = *(const u32x4*)(KVM + (size_t)(b * 256 + s) * 2048 + l * 512 + hd * 64 + c8 * 8); }
    { unsigned vv[16];
#pragma unroll
      for (int i = 0; i < 16; ++i) { const int idx = i * 512 + tid, s = idx >> 5, ep = idx & 31; vv[i] = *(const unsigned*)(KVM + (size_t)(b * 256 + s) * 2048 + l * 512 + 256 + hd * 64 + 2 * ep); }
#pragma unroll
      for (int i = 0; i < 16; ++i) { const int idx = i * 512 + tid, s = idx >> 5, ep = idx & 31; N2[s * 33 + ep] = vv[i]; } }
    const int t = qt * 256 + 32 * wid + r31; const size_t tok = (size_t)(b * SEQ + t);
    bf16x8 qf[4];
#pragma unroll
    for (int ks = 0; ks < 4; ++ks) qf[ks] = *(const bf16x8*)(U + tok * NU + U_QE + hd * 64 + 16 * ks + 8 * hh);
    u32x2 zpre[2][4];
#pragma unroll
    for (int et = 0; et < 2; ++et)
#pragma unroll
        for (int q4 = 0; q4 < 4; ++q4) zpre[et][q4] = *(const u32x2*)(U + tok * NU + U_ZE + hd * 64 + 32 * et + 8 * q4 + 4 * hh);
    __syncthreads();
    { const int s = tid & 255, eq = tid >> 8;
#pragma unroll
      for (int i = 0; i < 16; ++i) { const int ep = eq * 16 + i; const unsigned w = N2[s * 33 + ep]; VT[(2 * ep) * 260 + s] = (bf16_t)(w & 0xffffu); VT[(2 * ep + 1) * 260 + s] = (bf16_t)(w >> 16); } }
    __syncthreads();
    float m = -INFINITY;
#pragma unroll 1
    for (int half = 0; half < 2; ++half) { f32x16 acc[4];
#pragma unroll
        for (int mt = 0; mt < 4; ++mt) {
#pragma unroll
            for (int i = 0; i < 16; ++i) acc[mt][i] = 0.f;
#pragma unroll
            for (int ks = 0; ks < 4; ++ks) { const bf16x8 kf = *(const bf16x8*)(Ks + (128 * half + 32 * mt + r31) * 72 + 16 * ks + 8 * hh); acc[mt] = MFMA32(kf, qf[ks], acc[mt]); }
#pragma unroll
            for (int i = 0; i < 16; ++i) m = fmaxf(m, acc[mt][i]); } }
    m = fmaxf(m, __shfl_xor(m, 32)) * 0.125f;
    float sum = 0.f; f32x16 o[2];
#pragma unroll
    for (int i = 0; i < 16; ++i) { o[0][i] = 0.f; o[1][i] = 0.f; }
#pragma unroll 1
    for (int half = 0; half < 2; ++half) { f32x16 acc[4];
#pragma unroll
        for (int mt = 0; mt < 4; ++mt) {
#pragma unroll
            for (int i = 0; i < 16; ++i) acc[mt][i] = 0.f;
#pragma unroll
            for (int ks = 0; ks < 4; ++ks) { const bf16x8 kf = *(const bf16x8*)(Ks + (128 * half + 32 * mt + r31) * 72 + 16 * ks + 8 * hh); acc[mt] = MFMA32(kf, qf[ks], acc[mt]); }
#pragma unroll
            for (int i = 0; i < 16; ++i) { const float pv = fexp_(acc[mt][i] * 0.125f - m); acc[mt][i] = pv; sum += pv; }
#pragma unroll
            for (int s2 = 0; s2 < 2; ++s2) { const bf16x8 pf = pack_p(acc[mt], s2);
#pragma unroll
                for (int et = 0; et < 2; ++et) o[et] = MFMA32(vt_frag(VT, 32 * et + r31, 128 * half + 32 * mt + 16 * s2, hh), pf, o[et]); } } }
    sum += __shfl_xor(sum, 32); const float inv = __builtin_amdgcn_rcpf(sum);
#pragma unroll
    for (int et = 0; et < 2; ++et)
#pragma unroll
        for (int q4 = 0; q4 < 4; ++q4) { const int e0 = 32 * et + 8 * q4 + 4 * hh; const u32x2 zv = zpre[et][q4];
            u32x2 w; w.x = pack2(o[et][4 * q4] * inv * siluf_(bflo(zv.x)), o[et][4 * q4 + 1] * inv * siluf_(bfhi(zv.x))); w.y = pack2(o[et][4 * q4 + 2] * inv * siluf_(bflo(zv.y)), o[et][4 * q4 + 3] * inv * siluf_(bfhi(zv.y)));
            *(u32x2*)(YE + tok * 256 + hd * 64 + e0) = w; }
    __syncthreads();
}
#define XB_TMO      128
#define XB_XCNT(j)  (256  + 64 * (j))
#define XB_XSUB(j)  (1280 + 64 * (j))
#define XB_XGEN(j)  (2304 + 64 * (j))
#define XB_TOP      3328
#define XB_TOPGEN   3392
#define XCD_BAR_WORDS 3456
#define XB_SPIN_CAP (1u << 18)
#define LAS __attribute__((address_space(3)))
__device__ __forceinline__ unsigned xb_ld(unsigned* p)              { return __hip_atomic_load(p, __ATOMIC_RELAXED, __HIP_MEMORY_SCOPE_AGENT); }
__device__ __forceinline__ unsigned xb_add(unsigned* p, unsigned v) { return __hip_atomic_fetch_add(p, v, __ATOMIC_RELAXED, __HIP_MEMORY_SCOPE_AGENT); }
__device__ __forceinline__ unsigned xb_xcc_id() { return (unsigned)__builtin_amdgcn_s_getreg((3 << 11) | 20) & 0xFu; }
#define XB_SPIN(cond, bar) do { unsigned _sp = 0; while (cond) { __builtin_amdgcn_s_sleep(1); \
    if ((++_sp & 255u) == 0u) { if (xb_ld(&(bar)[XB_TMO])) break; if (_sp > XB_SPIN_CAP) { atomicAdd(&(bar)[XB_TMO], 1u); break; } } } } while (0)

struct XcdBarrier {
    unsigned* bar; unsigned x;
    volatile LAS unsigned* st;
};

__device__ __forceinline__ XcdBarrier xcd_barrier_post(unsigned* bar, volatile LAS unsigned* st) {
    XcdBarrier b; b.bar = bar; b.x = xb_xcc_id(); b.st = st;
    if (threadIdx.x == 0) (void)xb_add(&bar[XB_XCNT(b.x)], 1u);
    return b;
}
__device__ __forceinline__ void xcd_barrier_complete(unsigned* bar, unsigned x, unsigned& nloc, unsigned& nx) {
    const unsigned G = gridDim.x * gridDim.y * gridDim.z;
    unsigned sum, cnt, mine, sp = 0u;
    for (;;) {
        sum = 0u; cnt = 0u; mine = 0u;
#pragma unroll
        for (unsigned j = 0; j < 16; ++j) { const unsigned c = xb_ld(&bar[XB_XCNT(j)]); sum += c; cnt += (c > 0u) ? 1u : 0u; mine = (j == x) ? c : mine; }
        if (sum == G) break;
        __builtin_amdgcn_s_sleep(1);
        if ((++sp & 255u) == 0u) { if (xb_ld(&bar[XB_TMO])) break; if (sp > XB_SPIN_CAP) { atomicAdd(&bar[XB_TMO], 1u); break; } }
    }
    nloc = mine > 0u ? mine : 1u; nx = cnt > 0u ? cnt : 1u;
}

__device__ __forceinline__ void xcd_barrier(const XcdBarrier& b) {
    asm volatile("s_waitcnt vmcnt(0)" ::: "memory");
    __syncthreads();
    if (threadIdx.x == 0) {
        unsigned* bar = b.bar;
        __builtin_amdgcn_s_waitcnt(0);
        unsigned nloc = b.st[0], nx = b.st[1];
        if (nloc == 0u) { xcd_barrier_complete(bar, b.x, nloc, nx); b.st[0] = nloc; b.st[1] = nx; }
        const unsigned old = xb_add(&bar[XB_XSUB(b.x)], 1u);
        const unsigned gen = old / nloc;
        if (old + 1u == (gen + 1u) * nloc) {
            __builtin_amdgcn_fence(__ATOMIC_RELEASE, "agent");
            asm volatile("s_waitcnt vmcnt(0)" ::: "memory");
            const unsigned og = xb_add(&bar[XB_TOP], 1u);
            const unsigned tg = og / nx;
            if (og + 1u == (tg + 1u) * nx) xb_add(&bar[XB_TOPGEN], 1u);
            else XB_SPIN(xb_ld(&bar[XB_TOPGEN]) == tg, bar);
            __builtin_amdgcn_fence(__ATOMIC_ACQUIRE, "agent");
            xb_add(&bar[XB_XGEN(b.x)], 1u);
            asm volatile("s_waitcnt vmcnt(0)" ::: "memory");
        } else {
            XB_SPIN(xb_ld(&bar[XB_XGEN(b.x)]) == gen, bar);
            __builtin_amdgcn_fence(__ATOMIC_ACQUIRE, "agent");
            asm volatile("s_waitcnt vmcnt(0)" ::: "memory");
        }
    }
    __syncthreads();
}

typedef const __attribute__((address_space(4))) unsigned char* kargp_t;
DI Params load_params(kargp_t kp) { asm volatile("" : "+s"(kp)); Params q; __builtin_memcpy(&q, kp, sizeof(Params)); return q; }
__global__ void __launch_bounds__(512, 2) hybrid_fwd(Params p_unused) {
    const kargp_t kp = (kargp_t)__builtin_amdgcn_kernarg_segment_ptr();
#define p (load_params(kp))
#define GSYNC() do { XcdBarrier b_; b_.bar = (unsigned*)(p.ws + WS_BAR); b_.x = xb_xcc_id(); b_.st = xst; xcd_barrier(b_); } while (0)
    extern __shared__ __attribute__((aligned(16))) unsigned char shm[];
    cg::grid_group grid = cg::this_grid();
    PG8_LAS unsigned char* lds = (PG8_LAS unsigned char*)shm;
    const int G = (int)gridDim.x, bid = (int)blockIdx.x;
#define Ub ((bf16_t*)(p.ws + WS_U))
#define Hb ((bf16_t*)(p.ws + WS_H))
    volatile LAS unsigned* xst = (volatile LAS unsigned*)(lds + (LDS_BYTES - 16));
    if (threadIdx.x == 0) { xst[0] = 0u; xst[1] = 0u; }
    __syncthreads();
    (void)xcd_barrier_post((unsigned*)(p.ws + WS_BAR), xst);
    phase_prologue(p, shm);
    convert_win(p, 0, bid, G, shm);
    if (G == 0x7fffffff) grid.sync();
    GSYNC();
    { pg8::StaticOrder S; S.init(2048, 2048, G, bid); pg8::Gemm g{(const bf16_t*)(p.ws + WS_MEMN), (const bf16_t*)(p.ws + WS_WMEM), 2048, 2048, 1024, 0, 0};
      EpiStoreBf16 E{(bf16_t*)(p.ws + WS_KVM), 2048}; pg8::gemm_phase<EpiStoreBf16, pg8::StaticOrder, false>(lds, g, S, E, nullptr); }
#pragma unroll 1
    for (int l = 0; l < 4; ++l) {
        const float* xin = (l == 0) ? p.x : p.out;
        PREP(9)
        phase_norm(p, l, xin, shm);
        GSYNC();
#pragma unroll 1
        for (int rep = 0; rep < 1 + PROBE_DUP_P2; ++rep)
        { pg8::StaticOrder S; S.init(T, NU, G, bid); pg8::Gemm g{Hb, (const bf16_t*)(p.ws + WS_WIN + (size_t)(l & 1) * SZ_WIN1), T, NU, 1024, 0, 0};
          EpiStoreBf16 E{Ub, NU}; pg8::gemm_phase<EpiStoreBf16, pg8::StaticOrder, false>(lds, g, S, E, nullptr); }
        if (PROBE_DUP_P2 == 0 && l < 3) { const int nrem = 3136 % G; if (bid >= nrem) convert_win(p, l + 1, bid - nrem, G - nrem, shm); }
        GSYNC();
#pragma unroll 1
        for (int rep = 0; rep < 1 + PROBE_DUP_P3; ++rep) {
        PREP(1)
        for (int u = bid; u < 256; u += G) swa_unit(p, l, u, shm);
        PREP(2)
        for (int u = bid; u < 256; u += G) xattn_unit(p, l, u, shm);
        PREP(3)
        for (int u = bid; u < 256; u += G) lru_local_unit(p, l, u, shm);
        if (G == 256 && PROBE_UNIT == 0 && PROBE_DUP_P3 == 0) { HgIn ia, ib; hgrn_issue<false>(p, l, bid, ia); hgrn_issue<false>(p, l, bid + 256, ib);
            for (int u = bid; u < 512; u += G) mlstm_local_unit(p, l, u, shm);
            hgrn_local_unit(p, l, bid, ia, shm);
            hgrn_issue<false>(p, l, bid + 512, ia); hgrn_local_unit(p, l, bid + 256, ib, shm); hgrn_issue<false>(p, l, bid + 768, ib); hgrn_local_unit(p, l, bid + 512, ia, shm); hgrn_local_unit(p, l, bid + 768, ib, shm); }
        else {
        PREP(4)
        for (int u = bid; u < 512; u += G) mlstm_local_unit(p, l, u, shm);
        PREP(5)
        if (G == 256) { HgIn ia, ib; hgrn_issue<false>(p, l, bid, ia); hgrn_issue<false>(p, l, bid + 256, ib); hgrn_local_unit(p, l, bid, ia, shm);
            hgrn_issue<false>(p, l, bid + 512, ia); hgrn_local_unit(p, l, bid + 256, ib, shm); hgrn_issue<false>(p, l, bid + 768, ib); hgrn_local_unit(p, l, bid + 512, ia, shm); hgrn_local_unit(p, l, bid + 768, ib, shm); }
        else for (int u = bid; u < 1024; u += G) { HgIn ia; hgrn_issue<false>(p, l, u, ia); hgrn_local_unit(p, l, u, ia, shm); }
        }
        }
#pragma unroll 1
        for (int i = 0; i < PROBE_SYNCS; ++i) GSYNC();
        GSYNC();
        mlstm_scan(p); hgrn_scan(p); lru_scan(p);
        GSYNC();
#pragma unroll 1
        for (int rep = 0; rep < 1 + PROBE_DUP_P5; ++rep) {
        if (G == 256 && PROBE_UNIT == 0 && PROBE_DUP_P5 == 0) { HgIn ia, ib; hgrn_issue<true>(p, l, bid, ia);
            for (int u = bid; u < 512; u += G) mlstm_out_unit(p, l, u, shm);
            hgrn_issue<true>(p, l, bid + 256, ib); hgrn_out_unit(p, l, bid, ia, shm);
            hgrn_issue<true>(p, l, bid + 512, ia); hgrn_out_unit(p, l, bid + 256, ib, shm); hgrn_issue<true>(p, l, bid + 768, ib); hgrn_out_unit(p, l, bid + 512, ia, shm); hgrn_out_unit(p, l, bid + 768, ib, shm); }
        else {
        PREP(6)
        for (int u = bid; u < 512; u += G) mlstm_out_unit(p, l, u, shm);
        PREP(7)
        if (G == 256) { HgIn ia, ib; hgrn_issue<true>(p, l, bid, ia); hgrn_issue<true>(p, l, bid + 256, ib); hgrn_out_unit(p, l, bid, ia, shm);
            hgrn_issue<true>(p, l, bid + 512, ia); hgrn_out_unit(p, l, bid + 256, ib, shm); hgrn_issue<true>(p, l, bid + 768, ib); hgrn_out_unit(p, l, bid + 512, ia, shm); hgrn_out_unit(p, l, bid + 768, ib, shm); }
        else for (int u = bid; u < 1024; u += G) { HgIn ia; hgrn_issue<true>(p, l, u, ia); hgrn_out_unit(p, l, u, ia, shm); }
        }
        PREP(8)
        lru_out(p);
        }
        GSYNC();
#pragma unroll 1
        for (int rep = 0; rep < 1 + PROBE_DUP_P6; ++rep) {
            bf16_t* Pb = (bf16_t*)(p.ws + WS_YF);
            { GroupOrder S{G, bid}; pg8::Gemm g{(const bf16_t*)(p.ws + WS_YS), (const bf16_t*)(p.ws + WS_WBR) + (size_t)l * 2304 * 1024, T, 1024, 512, (size_t)T * 512 * 2, (size_t)512 * 1024 * 2};
              EpiGateAcc E{Ub + U_G, Pb, Hb, 0}; pg8::gemm_phase<EpiGateAcc, GroupOrder, false>(lds, g, S, E, nullptr); }
            { pg8::StaticOrder S; S.init(T, 1024, G, bid); pg8::Gemm g{(const bf16_t*)(p.ws + WS_YE), (const bf16_t*)(p.ws + WS_WBR) + (size_t)l * 2304 * 1024 + (size_t)4 * 512 * 1024, T, 1024, 256, 0, 0};
              EpiGateAcc E{Ub + U_G, Pb, Hb, 4}; pg8::gemm_phase<EpiGateAcc, pg8::StaticOrder, false>(lds, g, S, E, nullptr); }
        }
        GSYNC();
        { pg8::StaticOrder S; S.init(T, 1024, G, bid); pg8::Gemm g{Hb, (const bf16_t*)(p.ws + WS_WOUT) + (size_t)l * 1024 * 1024, T, 1024, 1024, 0, 0};
          EpiRes E{xin, p.out}; pg8::gemm_phase<EpiRes, pg8::StaticOrder, false>(lds, g, S, E, nullptr); }
        GSYNC();
    }
    phase_final_norm(p);
}
#undef p
#undef GSYNC
#undef Ub
#undef Hb

extern "C" void kernel_launch(void* const* d_in, const int* in_sizes, int n_in, void* d_out, int out_size, void* d_ws, size_t ws_size, hipStream_t stream) {
    static int grid_blocks = 0;
    if (grid_blocks == 0) {
        if (n_in != 23 || ws_size < WS_END) { fprintf(stderr, "kernel_launch: unexpected n_in %d or ws_size %zu (< %zu)\n", n_in, ws_size, (size_t)WS_END); grid_blocks = -1; return; }
        int dev = 0, cus = 0, per_cu = 0;
        hipGetDevice(&dev); hipDeviceGetAttribute(&cus, hipDeviceAttributeMultiprocessorCount, dev);
        if (hipFuncSetAttribute((const void*)hybrid_fwd, hipFuncAttributeMaxDynamicSharedMemorySize, LDS_BYTES) != hipSuccess) { fprintf(stderr, "kernel_launch: hipFuncSetAttribute failed\n"); grid_blocks = -1; return; }
        if (hipOccupancyMaxActiveBlocksPerMultiprocessor(&per_cu, (const void*)hybrid_fwd, 512, LDS_BYTES) != hipSuccess || per_cu < 1) { fprintf(stderr, "kernel_launch: occupancy query failed (%d)\n", per_cu); (void)hipGetLastError(); per_cu = 1; }
        grid_blocks = cus * per_cu;
    }
    if (grid_blocks < 0) return;
    Params p{};
    p.x = (const float*)d_in[0]; p.mem = (const float*)d_in[1]; p.pos = (const int*)d_in[2]; p.norm_g = (const float*)d_in[3]; p.w_in = (const float*)d_in[4];
    p.mconv_w = (const float*)d_in[5]; p.b_if = (const float*)d_in[6]; p.mnorm_g = (const float*)d_in[7]; p.lconv_w = (const float*)d_in[8]; p.lconv_b = (const float*)d_in[9];
    p.wa = (const float*)d_in[10]; p.ba = (const float*)d_in[11]; p.wx = (const float*)d_in[12]; p.bx = (const float*)d_in[13]; p.lam = (const float*)d_in[14];
    p.sinks = (const float*)d_in[15]; p.hlb = (const float*)d_in[16]; p.hnorm_g = (const float*)d_in[17]; p.mem_g = (const float*)d_in[18]; p.w_mem = (const float*)d_in[19];
    p.w_br = (const float*)d_in[20]; p.w_out = (const float*)d_in[21]; p.fin_g = (const float*)d_in[22];
    p.out = (float*)d_out; p.ws = (unsigned char*)d_ws;
    if (hipMemsetAsync((unsigned char*)d_ws + WS_BAR, 0, 16384, stream) != hipSuccess) { fprintf(stderr, "kernel_launch: memset failed\n"); return; }
    void* args[] = {&p};
    hipError_t e = hipLaunchCooperativeKernel((const void*)hybrid_fwd, dim3(grid_blocks), dim3(512), args, LDS_BYTES, stream);
    if (e != hipSuccess) fprintf(stderr, "cooperative launch failed: %s (grid %d)\n", hipGetErrorString(e), grid_blocks);
}
```

```cpp
#include <hip/hip_runtime.h>
#include <hip/hip_cooperative_groups.h>
#include <cstdio>
#define PROBE_DUP_P3 0
#define PROBE_DUP_P5 0
#define PROBE_DUP_P6 0
#define PROBE_DUP_P2 0
#define PROBE_SYNCS 0
#define PROBE_UNIT 0
#define PREP(k) for (int rep_ = 0; rep_ < (PROBE_UNIT == (k) ? 2 : 1); ++rep_)
namespace cg = cooperative_groups;
__device__ __forceinline__ int opaque_tid() { int t = (int)threadIdx.x; asm volatile("" : "+v"(t)); return t; }
namespace pg8 {
#define PG8_LAS __attribute__((address_space(3)))
typedef unsigned short bf16_t;
typedef short bf16x8 __attribute__((ext_vector_type(8)));
typedef float f32x4 __attribute__((ext_vector_type(4)));
typedef unsigned u32x4 __attribute__((ext_vector_type(4)));
constexpr int BM = 256, BK = 64, HALF = 128, HTB = HALF * BK * 2  , STAGE_BYTES = 8 * HTB, NXCD = 8, WGM = 8;

__host__ __device__ __forceinline__ int lds_byte(int r, int c) { const int st = (r >> 4) * 2 + (c >> 5), rr = r & 15, cc = c & 31, ob = rr * 64 + cc * 2; return st * 1024 + (ob ^ (((ob >> 9) & 1) << 5)); }
__host__ __device__ __forceinline__ void stage_rc(int b, int& R, int& C) { const int st = b / 1024, sb = b % 1024, swz = sb ^ (((sb >> 9) & 1) << 5); R = (st >> 1) * 16 + swz / 64; C = (st & 1) * 32 + (swz % 64) / 2; }
__host__ __device__ __forceinline__ int perm32(int rho) { const int n = rho >> 4, i = rho & 15; return 8 * (i >> 2) + 4 * n + (i & 3); }

struct Unit { int pm, pn, g; };
struct Gemm { const bf16_t* A; const bf16_t* Bt; int M, N, K; size_t gsA, gsB; };

struct StaticOrder {
    int nM, nN, nwg, G, c;
    __host__ __device__ void init(int M, int N, int G_, int c_) { nM = M / BM; nN = N / BM; nwg = nM * nN; G = G_; c = c_; }
    __host__ __device__ bool next(int i, Unit& u) const {
        const long L = (long)i * G + c; if (L >= nwg) return false;
        int wgid = (int)L; { const int q = nwg / NXCD, r = nwg % NXCD, xcd = wgid % NXCD, off = wgid / NXCD; wgid = (xcd < r ? xcd * (q + 1) : r * (q + 1) + (xcd - r) * q) + off; }
        const int nig = WGM * nN, gid = wgid / nig, fm = gid * WGM, gsz = (nM - fm) < WGM ? (nM - fm) : WGM;
        u.pm = fm + ((wgid % nig) % gsz); u.pn = (wgid % nig) / gsz; u.g = 0; return true;
    }
    __device__ __forceinline__ void a_ready(const Unit&) const {}
    __device__ __forceinline__ void done(const Unit&) const {}
};
template <class Epi, class Sched, bool STAMP = false>
__device__ __forceinline__ void gemm_phase(PG8_LAS unsigned char* lds, const Gemm g_in, const Sched& S, const Epi& E, unsigned long long* stamps) {
    Gemm g = g_in;
    { unsigned long long v = (unsigned long long)g.A; g.A = (const bf16_t*)(((unsigned long long)(unsigned)__builtin_amdgcn_readfirstlane((int)(v >> 32)) << 32) | (unsigned)__builtin_amdgcn_readfirstlane((int)v));
      v = (unsigned long long)g.Bt; g.Bt = (const bf16_t*)(((unsigned long long)(unsigned)__builtin_amdgcn_readfirstlane((int)(v >> 32)) << 32) | (unsigned)__builtin_amdgcn_readfirstlane((int)v)); }
    const int tid = opaque_tid(), wid = __builtin_amdgcn_readfirstlane(tid >> 6), lane = tid & 63, wr = wid >> 2, wc = wid & 3, fr = lane & 15, fq = lane >> 4;
    int K = g.K; asm volatile("" : "+s"(K));
    const int nt = K / BK;
    int ts_lo = 0, ts_hi = 0, nts = 0; const unsigned long long rt_entry = STAMP ? (unsigned long long)wall_clock64() : 0ull;
#define PG8_STAMP() do { if (STAMP && wid == 0 && nts < 64) { const unsigned long long _c = (unsigned long long)clock64(); \
        ts_lo = (lane == nts) ? (int)(unsigned)_c : ts_lo; ts_hi = (lane == nts) ? (int)(unsigned)(_c >> 32) : ts_hi; ++nts; } } while (0)
    PG8_STAMP();
    unsigned voffA[2], voffB[2];
#pragma unroll
    for (int i = 0; i < 2; ++i) { int R, C; stage_rc(tid * 16 + i * 8192, R, C); const int Rb = Epi::PERM ? ((R & ~31) + perm32(R & 31)) : R;
        voffA[i] = (unsigned)(R * K + C) * 2u; voffB[i] = (unsigned)(Rb * K + C) * 2u; }
    const size_t kstep = (size_t)(BK * 2);
    const size_t hstep = (size_t)HALF * K * 2;
    const size_t tstep = 2 * hstep;
    const unsigned ldsw = (unsigned)wid * 1024u;
    const int aoff = lds_byte(wr * 64 + fr, fq * 8), boff = lds_byte(wc * 32 + fr, fq * 8);
#define PG8_SA(b, h) (((b) * 2 + (h)) * HTB)
#define PG8_SB(b, h) ((4 + (b) * 2 + (h)) * HTB)
#define PG8_STAGE(bufoff, gbase, voff) do { _Pragma("unroll") for (int _i = 0; _i < 2; ++_i) \
        __builtin_amdgcn_global_load_lds((const unsigned*)((const char*)(gbase) + (voff)[_i]), (PG8_LAS unsigned*)(lds + (bufoff) + ldsw + _i * 8192), 16, 0, 0); } while (0)
#define PG8_LDA(dst, b, h) do { _Pragma("unroll") for (int m = 0; m < 4; ++m) _Pragma("unroll") for (int k = 0; k < 2; ++k) dst[m][k] = *(const PG8_LAS bf16x8*)(lds + PG8_SA(b, h) + aoff + m * 2048 + k * 1024); } while (0)
#define PG8_LDB(dst, b, h) do { _Pragma("unroll") for (int n = 0; n < 2; ++n) _Pragma("unroll") for (int k = 0; k < 2; ++k) dst[n][k] = *(const PG8_LAS bf16x8*)(lds + PG8_SB(b, h) + boff + n * 2048 + k * 1024); } while (0)
#define PG8_MMA(ai, bj, At, Bt) do { __builtin_amdgcn_s_setprio(1); _Pragma("unroll") for (int m = 0; m < 4; ++m) _Pragma("unroll") for (int n = 0; n < 2; ++n) _Pragma("unroll") for (int k = 0; k < 2; ++k) \
        acc[ai][bj][m][n] = __builtin_amdgcn_mfma_f32_16x16x32_bf16(Bt[n][k], At[m][k], acc[ai][bj][m][n], 0, 0, 0); __builtin_amdgcn_s_setprio(0); } while (0)
#define PG8_WAIT_V(n) asm volatile("s_waitcnt vmcnt(" #n ")" ::: "memory")
#define PG8_WAIT_L(n) asm volatile("s_waitcnt lgkmcnt(" #n ")" ::: "memory")
#define PG8_BAR __builtin_amdgcn_s_barrier()
#define PG8_SCHED __builtin_amdgcn_sched_barrier(0)
    Unit cur, nxt; int ui = 0;
    if (!S.next(0, cur)) return;
    f32x4 acc[2][2][4][2];
#pragma unroll
    for (int a = 0; a < 2; ++a)
#pragma unroll
        for (int b = 0; b < 2; ++b)
#pragma unroll
            for (int m = 0; m < 4; ++m)
#pragma unroll
                for (int n = 0; n < 2; ++n) acc[a][b][m][n] = (f32x4){0.f, 0.f, 0.f, 0.f};
    bf16x8 At[4][2], B0[2][2], B1[2][2];
    const char* cA = (const char*)g.A + (size_t)cur.pm * tstep + (size_t)cur.g * g.gsA; const char* cB = (const char*)g.Bt + (size_t)cur.pn * tstep + (size_t)cur.g * g.gsB;
    S.a_ready(cur);
    PG8_STAGE(PG8_SB(0, 0), cB, voffB); PG8_STAGE(PG8_SA(0, 0), cA, voffA); PG8_STAGE(PG8_SB(0, 1), cB + hstep, voffB); PG8_STAGE(PG8_SA(0, 1), cA + hstep, voffA);
    if (wr == 1) PG8_BAR;
    PG8_WAIT_V(4); PG8_BAR;
    PG8_STAGE(PG8_SB(1, 0), cB + kstep, voffB); PG8_STAGE(PG8_SA(1, 0), cA + kstep, voffA); PG8_STAGE(PG8_SB(1, 1), cB + hstep + kstep, voffB);
    PG8_WAIT_V(6); PG8_BAR;
    PG8_STAMP();
    for (;;) {
        const bool has_next = S.next(ui + 1, nxt);
        const char* nA = has_next ? (const char*)g.A + (size_t)nxt.pm * tstep + (size_t)nxt.g * g.gsA : cA; const char* nB = has_next ? (const char*)g.Bt + (size_t)nxt.pn * tstep + (size_t)nxt.g * g.gsB : cB;
        for (int t = 0; t < nt; t += 2) {
            const bool last = (t == nt - 2);
            const char* a1 = cA + (size_t)(t + 1) * kstep;
            const char* a2 = last ? nA : cA + (size_t)(t + 2) * kstep; const char* b2 = last ? nB : cB + (size_t)(t + 2) * kstep;
            const char* a3 = a2 + kstep; const char* b3 = b2 + kstep;
            if (last && has_next) S.a_ready(nxt);
            PG8_LDB(B0, 0, 0); PG8_SCHED; PG8_LDA(At, 0, 0); PG8_STAGE(PG8_SA(1, 1), a1 + hstep, voffA);
            PG8_WAIT_L(8); PG8_BAR; PG8_WAIT_L(0); PG8_MMA(0, 0, At, B0); PG8_BAR; PG8_SCHED;
            PG8_LDB(B1, 0, 1); PG8_STAGE(PG8_SB(0, 0), b2, voffB);
            PG8_BAR; PG8_WAIT_L(0); PG8_MMA(0, 1, At, B1); PG8_BAR;
            PG8_LDA(At, 0, 1); PG8_STAGE(PG8_SA(0, 0), a2, voffA);
            PG8_BAR; PG8_WAIT_L(0); PG8_MMA(1, 0, At, B0); PG8_BAR; PG8_SCHED;
            PG8_STAGE(PG8_SB(0, 1), b2 + hstep, voffB);
            PG8_WAIT_V(6); PG8_BAR; PG8_MMA(1, 1, At, B1); PG8_BAR;
            PG8_LDB(B0, 1, 0); PG8_SCHED; PG8_LDA(At, 1, 0); PG8_STAGE(PG8_SA(0, 1), a2 + hstep, voffA);
            PG8_WAIT_L(8); PG8_BAR; PG8_WAIT_L(0); PG8_MMA(0, 0, At, B0); PG8_BAR; PG8_SCHED;
            PG8_LDB(B1, 1, 1); PG8_STAGE(PG8_SB(1, 0), b3, voffB);
            PG8_BAR; PG8_WAIT_L(0); PG8_MMA(0, 1, At, B1); PG8_BAR;
            PG8_LDA(At, 1, 1); PG8_STAGE(PG8_SA(1, 0), a3, voffA);
            PG8_BAR; PG8_WAIT_L(0); PG8_MMA(1, 0, At, B0); PG8_BAR; PG8_SCHED;
            PG8_STAGE(PG8_SB(1, 1), b3 + hstep, voffB);
            PG8_WAIT_V(6); PG8_BAR; PG8_MMA(1, 1, At, B1); PG8_BAR;
        }
        PG8_STAMP();
        if constexpr (!Epi::AFTER_DRAIN) { E(acc, cur, wr, wc, fr, fq); S.done(cur); }
        PG8_STAMP();
        if (!has_next) break;
#pragma unroll
        for (int a = 0; a < 2; ++a)
#pragma unroll
            for (int b = 0; b < 2; ++b)
#pragma unroll
                for (int m = 0; m < 4; ++m)
#pragma unroll
                    for (int n = 0; n < 2; ++n) acc[a][b][m][n] = (f32x4){0.f, 0.f, 0.f, 0.f};
        cur = nxt; cA = nA; cB = nB; ++ui;
    }
    PG8_WAIT_V(0);
    if (wr == 0) PG8_BAR;
    PG8_BAR;
    if constexpr (Epi::AFTER_DRAIN) { E.fused(acc, cur, wr, wc, fr, fq, lds, wid, lane); S.done(cur); }
    PG8_STAMP();
    if (STAMP && wid == 0) { stamps[lane] = lane < nts ? (((unsigned long long)(unsigned)ts_hi << 32) | (unsigned)ts_lo) : 0ull;
        if (lane == 62) stamps[62] = rt_entry; if (lane == 63) stamps[63] = (unsigned long long)wall_clock64(); }
#undef PG8_STAMP
#undef PG8_SA
#undef PG8_SB
#undef PG8_STAGE
#undef PG8_LDA
#undef PG8_LDB
#undef PG8_MMA
#undef PG8_WAIT_V
#undef PG8_WAIT_L
#undef PG8_BAR
#undef PG8_SCHED
}
}
using pg8::bf16_t; using pg8::bf16x8; using pg8::f32x4; using pg8::u32x4;
#define DI __device__ __forceinline__
typedef float f32x16 __attribute__((ext_vector_type(16)));
typedef float f32x2 __attribute__((ext_vector_type(2)));
typedef short s16x4 __attribute__((ext_vector_type(4)));
typedef unsigned u32x2 __attribute__((ext_vector_type(2)));
typedef __bf16 bfv2 __attribute__((ext_vector_type(2)));

constexpr int T = 16384, SEQ = 2048, DM = 1024, NIN = 12552, NU = 12544;
constexpr float EPS = 1e-6f, LOG2E = 1.4426950408889634f;
constexpr int U_QA = 0, U_KA = 512, U_VA = 1024, U_OA = 1536, U_ZA = 2048, U_XB = 2560, U_ZB = 3072, U_QC = 3584, U_KC = 4096, U_VC = 4224, U_ZC = 4352,
              U_QD = 4864, U_FD = 5376, U_ID = 5888, U_ZD = 6400, U_QE = 6912, U_ZE = 7168, U_G = 7424;
constexpr size_t WS_WIN = 0, SZ_WIN1 = (size_t)NU * 1024 * 2, SZ_WIN = 2 * SZ_WIN1;
constexpr size_t WS_WBR = WS_WIN + SZ_WIN, SZ_WBR = (size_t)4 * 2304 * 1024 * 2;
constexpr size_t WS_WOUT = WS_WBR + SZ_WBR, SZ_WOUT = (size_t)4 * 1024 * 1024 * 2;
constexpr size_t WS_KVM = WS_WOUT + SZ_WOUT, SZ_KVM = (size_t)2048 * 2048 * 2;
constexpr size_t WS_H = WS_KVM + SZ_KVM, SZ_H = (size_t)T * 1024 * 2;
constexpr size_t WS_IF = WS_H + SZ_H, SZ_IF = (size_t)T * 8 * 4;
constexpr size_t WS_LB = WS_IF + SZ_IF, SZ_LB = 4 * 512 * 4;
constexpr size_t WS_NA = WS_LB + SZ_LB, SZ_NA = 512 * 128 * 4;
constexpr size_t WS_GA = WS_NA + SZ_NA, SZ_GA = 512 * 4;
constexpr size_t WS_DECD = WS_GA + SZ_GA, SZ_DECD = 1024 * 128 * 4;
constexpr size_t WS_CARB = WS_DECD + SZ_DECD, SZ_CARB = 256 * 512 * 4;
constexpr size_t WS_U = WS_CARB + SZ_CARB, SZ_U = (size_t)T * NU * 2;
constexpr size_t WS_MEMN = WS_U, WS_WMEM = WS_U + (size_t)2048 * 1024 * 2;
constexpr size_t WS_YS = WS_U + SZ_U;
constexpr size_t WS_YA = WS_YS, WS_YB = WS_YA + (size_t)T * 512 * 2, WS_YC = WS_YB + (size_t)T * 512 * 2, WS_YD = WS_YC + (size_t)T * 512 * 2, WS_YE = WS_YD + (size_t)T * 512 * 2;
constexpr size_t WS_ST = WS_YE + (size_t)T * 256 * 2;
constexpr size_t WS_STA = WS_ST, WS_STD = WS_STA + (size_t)512 * 16384 * 4, WS_LRUH = WS_STD + (size_t)1024 * 16384 * 4, WS_LRUA = WS_LRUH + (size_t)T * 512 * 4;
constexpr size_t WS_YF = WS_ST;
constexpr size_t WS_BAR = WS_LRUA + (size_t)T * 512 * 4;
constexpr size_t WS_END = WS_BAR + 16384;
constexpr int LDS_BYTES = 155648;

struct Params {
    const float* x; const float* mem; const int* pos; const float* norm_g; const float* w_in; const float* mconv_w; const float* b_if; const float* mnorm_g;
    const float* lconv_w; const float* lconv_b; const float* wa; const float* ba; const float* wx; const float* bx; const float* lam; const float* sinks;
    const float* hlb; const float* hnorm_g; const float* mem_g; const float* w_mem; const float* w_br; const float* w_out; const float* fin_g;
    float* out; unsigned char* ws;
};

DI float bf2f(bf16_t b) { return __uint_as_float(((unsigned)b) << 16); }
DI float bflo(unsigned v) { return __uint_as_float(v << 16); }
DI float bfhi(unsigned v) { return __uint_as_float(v & 0xffff0000u); }
DI unsigned pack2(float lo, float hi) { f32x2 v = {lo, hi}; bfv2 b = __builtin_convertvector(v, bfv2); return __builtin_bit_cast(unsigned, b); }
DI bf16_t f2bf(float f) { return (bf16_t)(pack2(f, 0.f) & 0xffffu); }
DI float fexp_(float x) { return __builtin_amdgcn_exp2f(x * LOG2E); }
DI float sigmoidf_(float x) { return __builtin_amdgcn_rcpf(1.0f + fexp_(-x)); }
DI float siluf_(float x) { return x * sigmoidf_(x); }
DI float logsigf_(float x) { return fminf(x, 0.f) - log1pf(fexp_(-fabsf(x))); }
DI float wave_sum(float v) {
    int x = __float_as_int(v);
    x = __float_as_int(__int_as_float(x) + __int_as_float(__builtin_amdgcn_update_dpp(0, x, 0x128, 0xf, 0xf, false)));
    x = __float_as_int(__int_as_float(x) + __int_as_float(__builtin_amdgcn_update_dpp(0, x, 0x124, 0xf, 0xf, false)));
    x = __float_as_int(__int_as_float(x) + __int_as_float(__builtin_amdgcn_update_dpp(0, x, 0x122, 0xf, 0xf, false)));
    x = __float_as_int(__int_as_float(x) + __int_as_float(__builtin_amdgcn_update_dpp(0, x, 0x121, 0xf, 0xf, false)));
    const float r0 = __int_as_float(__builtin_amdgcn_readlane(x, 0)), r1 = __int_as_float(__builtin_amdgcn_readlane(x, 16)), r2 = __int_as_float(__builtin_amdgcn_readlane(x, 32)), r3 = __int_as_float(__builtin_amdgcn_readlane(x, 48));
    return (r0 + r1) + (r2 + r3);
}
DI int crow(int i, int h) { return (i & 3) + 8 * (i >> 2) + 4 * h; }

template <int MT, int NT> DI void mma_lds(f32x16 (&acc)[MT][NT], const bf16_t* A, int lda, const bf16_t* B, int ldb, int K, int lane) {
    const int r = lane & 31, h = lane >> 5;
    for (int k0 = 0; k0 < K; k0 += 16) {
        bf16x8 a[MT], b[NT];
#pragma unroll
        for (int mt = 0; mt < MT; ++mt) a[mt] = *(const bf16x8*)(A + (32 * mt + r) * lda + k0 + 8 * h);
#pragma unroll
        for (int nt = 0; nt < NT; ++nt) b[nt] = *(const bf16x8*)(B + (32 * nt + r) * ldb + k0 + 8 * h);
#pragma unroll
        for (int mt = 0; mt < MT; ++mt)
#pragma unroll
            for (int nt = 0; nt < NT; ++nt) acc[mt][nt] = __builtin_amdgcn_mfma_f32_32x32x16_bf16(a[mt], b[nt], acc[mt][nt], 0, 0, 0);
    }
}
template <int MT, int NT> DI void zero_acc(f32x16 (&acc)[MT][NT]) {
#pragma unroll
    for (int mt = 0; mt < MT; ++mt)
#pragma unroll
        for (int nt = 0; nt < NT; ++nt)
#pragma unroll
            for (int i = 0; i < 16; ++i) acc[mt][nt][i] = 0.f;
}

struct EpiStoreBf16 {
    static constexpr bool PERM = true, AFTER_DRAIN = false;
    bf16_t* O; int ldc;
    DI void operator()(const f32x4 (&acc)[2][2][4][2], const pg8::Unit& u, int wr, int wc, int fr, int fq) const {
        const int row0 = u.pm * 256 + wr * 64 + fr, col0 = u.pn * 256 + wc * 32 + 8 * fq;
#pragma unroll
        for (int ai = 0; ai < 2; ++ai)
#pragma unroll
            for (int m = 0; m < 4; ++m) { bf16_t* rowp = O + (size_t)(row0 + ai * 128 + m * 16) * ldc + col0;
#pragma unroll
                for (int bj = 0; bj < 2; ++bj) { const f32x4 v0 = acc[ai][bj][m][0], v1 = acc[ai][bj][m][1];
                    u32x4 w; w.x = pack2(v0[0], v0[1]); w.y = pack2(v0[2], v0[3]); w.z = pack2(v1[0], v1[1]); w.w = pack2(v1[2], v1[3]);
                    __builtin_nontemporal_store(w, (u32x4*)(rowp + bj * 128)); } }
    }
};
struct EpiRes {
    static constexpr bool PERM = false, AFTER_DRAIN = false;
    const float* xres; float* out;
    DI void operator()(const f32x4 (&acc)[2][2][4][2], const pg8::Unit& u, int wr, int wc, int fr, int fq) const {
        const int row0 = u.pm * 256 + wr * 64 + fr, col0 = u.pn * 256 + wc * 32 + 4 * fq;
#pragma unroll
        for (int am = 0; am < 4; ++am) { const int ai = am >> 1, m0 = (am & 1) * 2; f32x4 xv[2][2][2];
#pragma unroll
            for (int mm = 0; mm < 2; ++mm) { const size_t r = (size_t)(row0 + ai * 128 + (m0 + mm) * 16);
#pragma unroll
                for (int bj = 0; bj < 2; ++bj)
#pragma unroll
                    for (int n = 0; n < 2; ++n) xv[mm][bj][n] = *(const f32x4*)(xres + r * 1024 + col0 + bj * 128 + n * 16); }
            __builtin_amdgcn_sched_barrier(0);
#pragma unroll
            for (int mm = 0; mm < 2; ++mm) { const size_t r = (size_t)(row0 + ai * 128 + (m0 + mm) * 16);
#pragma unroll
                for (int bj = 0; bj < 2; ++bj)
#pragma unroll
                    for (int n = 0; n < 2; ++n) *(f32x4*)(out + r * 1024 + col0 + bj * 128 + n * 16) = xv[mm][bj][n] + acc[ai][bj][m0 + mm][n]; }
            __builtin_amdgcn_sched_barrier(0); }
    }
};
struct GroupOrder {
    int G, c;
    __device__ bool next(int i, pg8::Unit& u) const { const int tile = c + (i >> 2) * G; if (tile >= 256) return false; pg8::StaticOrder t; t.init(T, 1024, 256, tile); t.next(0, u); u.g = i & 3; return true; }
    DI void a_ready(const pg8::Unit&) const {}
    DI void done(const pg8::Unit&) const {}
};
struct EpiGateAcc {
    static constexpr bool PERM = true, AFTER_DRAIN = false;
    const bf16_t* gates; bf16_t* P; bf16_t* Y16; int goff;
    DI void operator()(const f32x4 (&acc)[2][2][4][2], const pg8::Unit& u, int wr, int wc, int fr, int fq) const {
        const int row0 = u.pm * 256 + wr * 64 + fr, col0 = u.pn * 256 + wc * 32 + 8 * fq, j = u.g + goff;
        const bf16_t* gp = gates + j * 1024 + col0; bf16_t* dst = ((j == 4) ? Y16 : P) + col0; const bf16_t* pp = P + col0;
#pragma unroll
        for (int am = 0; am < 4; ++am) { const int ai = am >> 1, m0 = (am & 1) * 2;
            u32x4 gv[4][2], pv[4][2];
#pragma unroll
            for (int m = m0; m < m0 + 2; ++m) { const size_t r = (size_t)(row0 + ai * 128 + m * 16);
#pragma unroll
                for (int bj = 0; bj < 2; ++bj) { gv[m][bj] = *(const u32x4*)(gp + r * NU + bj * 128); pv[m][bj] = (u32x4){0u, 0u, 0u, 0u}; if (j > 0) pv[m][bj] = *(const u32x4*)(pp + r * 1024 + bj * 128); } }
            __builtin_amdgcn_sched_barrier(0);
#pragma unroll
            for (int m = m0; m < m0 + 2; ++m) { const size_t r = (size_t)(row0 + ai * 128 + m * 16);
#pragma unroll
                for (int bj = 0; bj < 2; ++bj) { const u32x4 g4 = gv[m][bj], p4 = pv[m][bj]; const f32x4 a0 = acc[ai][bj][m][0], a1 = acc[ai][bj][m][1]; float o[8];
                    o[0] = a0[0] * sigmoidf_(bflo(g4.x)) + bflo(p4.x); o[1] = a0[1] * sigmoidf_(bfhi(g4.x)) + bfhi(p4.x); o[2] = a0[2] * sigmoidf_(bflo(g4.y)) + bflo(p4.y); o[3] = a0[3] * sigmoidf_(bfhi(g4.y)) + bfhi(p4.y);
                    o[4] = a1[0] * sigmoidf_(bflo(g4.z)) + bflo(p4.z); o[5] = a1[1] * sigmoidf_(bfhi(g4.z)) + bfhi(p4.z); o[6] = a1[2] * sigmoidf_(bflo(g4.w)) + bflo(p4.w); o[7] = a1[3] * sigmoidf_(bfhi(g4.w)) + bfhi(p4.w);
                    u32x4 w; w.x = pack2(o[0], o[1]); w.y = pack2(o[2], o[3]); w.z = pack2(o[4], o[5]); w.w = pack2(o[6], o[7]); *(u32x4*)(dst + r * 1024 + bj * 128) = w; } }
            __builtin_amdgcn_sched_barrier(0);
        }
    }
};
DI void conv_tile(const float* src, int ld_src, int gap_at, int gap_len, const float* scale, bf16_t* dst, int K, int n0, int k0, unsigned char* sm) {
    bf16_t* tl = (bf16_t*)sm;
    const int tid = opaque_tid();
    float vld[16];
#pragma unroll
    for (int i = 0; i < 16; ++i) { const int idx = i * 512 + tid, kk = idx >> 7, nn = idx & 127, n = n0 + nn, col = n + (n >= gap_at ? gap_len : 0);
        vld[i] = src[(size_t)(k0 + kk) * ld_src + col]; }
#pragma unroll
    for (int i = 0; i < 16; ++i) { const int idx = i * 512 + tid, kk = idx >> 7, nn = idx & 127;
        float v = vld[i]; if (scale) v *= scale[k0 + kk];
        tl[nn * 72 + kk] = f2bf(v); }
    __syncthreads();
#pragma unroll
    for (int i = 0; i < 2; ++i) { const int idx = i * 512 + tid, nn = idx >> 3, kc = idx & 7;
        *(u32x4*)(dst + (size_t)(n0 + nn) * K + k0 + kc * 8) = *(const u32x4*)(tl + nn * 72 + kc * 8); }
    __syncthreads();
}
DI void phase_prologue(const Params& p, unsigned char* sm) {
    const int tid = opaque_tid(), wid = tid >> 6, lane = tid & 63;
    bf16_t* WBR = (bf16_t*)(p.ws + WS_WBR); bf16_t* WOUT = (bf16_t*)(p.ws + WS_WOUT); bf16_t* WMEM = (bf16_t*)(p.ws + WS_WMEM); bf16_t* MEMN = (bf16_t*)(p.ws + WS_MEMN);
    for (int t = blockIdx.x; t < 4 * 480; t += gridDim.x) {
        const int l = t / 480, r = t % 480;
        if (r < 288) { int j, tt, Kj; if (r < 256) { j = r >> 6; tt = r & 63; Kj = 512; } else { j = 4; tt = r - 256; Kj = 256; }
            const int nkt = Kj / 64, nt = tt / nkt, kt = tt % nkt; const size_t off = (size_t)l * 2304 * 1024 + (size_t)j * 512 * 1024;
            conv_tile(p.w_br + off, 1024, 1 << 30, 0, nullptr, WBR + off, Kj, nt * 128, kt * 64, sm); }
        else if (r < 416) { const int tt = r - 288, nt = tt >> 4, kt = tt & 15; const size_t off = (size_t)l * 1024 * 1024;
            conv_tile(p.w_out + off, 1024, 1 << 30, 0, nullptr, WOUT + off, 1024, nt * 128, kt * 64, sm); }
        else { const int tt = r - 416, nt = tt >> 4, kt = tt & 15;
            conv_tile(p.w_mem + (size_t)l * 1024 * 512, 512, 1 << 30, 0, p.mem_g + l * 1024, WMEM + (size_t)l * 512 * 1024, 1024, nt * 128, kt * 64, sm); }
    }
    for (int row = blockIdx.x * 8 + wid; row < 2048; row += gridDim.x * 8) {
        const float* xr = p.mem + (size_t)row * 1024; f32x4 v[4]; float ss = 0.f;
#pragma unroll
        for (int i = 0; i < 4; ++i) { v[i] = *(const f32x4*)(xr + i * 256 + lane * 4); ss += v[i][0] * v[i][0] + v[i][1] * v[i][1] + v[i][2] * v[i][2] + v[i][3] * v[i][3]; }
        ss = wave_sum(ss); const float rs = rsqrtf(ss * (1.0f / 1024.0f) + EPS);
#pragma unroll
        for (int i = 0; i < 4; ++i) { u32x2 w; w.x = pack2(v[i][0] * rs, v[i][1] * rs); w.y = pack2(v[i][2] * rs, v[i][3] * rs); *(u32x2*)(MEMN + (size_t)row * 1024 + i * 256 + lane * 4) = w; }
    }
    if (blockIdx.x == 0) { float* LB = (float*)(p.ws + WS_LB); const int ch = tid;
        const float v0 = p.hlb[ch], v1 = p.hlb[512 + ch], v2 = p.hlb[1024 + ch], v3 = p.hlb[1536 + ch];
        const float mx = fmaxf(fmaxf(v0, v1), fmaxf(v2, v3)); const float e0 = expf(v0 - mx), e1 = expf(v1 - mx), e2 = expf(v2 - mx), e3 = expf(v3 - mx); const float inv = 1.0f / (e0 + e1 + e2 + e3);
        LB[ch] = 0.f; LB[512 + ch] = e1 * inv; LB[1024 + ch] = (e1 + e2) * inv; LB[1536 + ch] = (e1 + e2 + e3) * inv; }
}
DI void convert_win(const Params& p, int l, int first, int stride, unsigned char* sm) {
    bf16_t* WIN = (bf16_t*)(p.ws + WS_WIN + (size_t)(l & 1) * SZ_WIN1); const float* wl = p.w_in + (size_t)l * 1024 * NIN;
    for (int t = first; t < 98 * 16; t += stride) conv_tile(wl, NIN, 2560, 8, nullptr, WIN, 1024, (t >> 4) * 128, (t & 15) * 64, sm);
}
DI void phase_norm(const Params& p, int l, const float* xin, unsigned char* sm) {
    const int tid = opaque_tid(), wid = tid >> 6, lane = tid & 63;
    const float* wl = p.w_in + (size_t)l * 1024 * NIN;
    float* wif = (float*)sm;
    for (int i = tid; i < 8192; i += 512) wif[i] = wl[(size_t)(i >> 3) * NIN + 2560 + (i & 7)];
    __syncthreads();
    bf16_t* H = (bf16_t*)(p.ws + WS_H); float* IFp = (float*)(p.ws + WS_IF); const float* g = p.norm_g + l * 1024;
    f32x4 vn[4];
    { const int tok = blockIdx.x * 8 + wid; if (tok < T) {
#pragma unroll
        for (int i = 0; i < 4; ++i) vn[i] = *(const f32x4*)(xin + (size_t)tok * 1024 + i * 256 + lane * 4); } }
    for (int tok = blockIdx.x * 8 + wid; tok < T; tok += gridDim.x * 8) {
        f32x4 v[4]; float ss = 0.f;
#pragma unroll
        for (int i = 0; i < 4; ++i) { v[i] = vn[i]; ss += v[i][0] * v[i][0] + v[i][1] * v[i][1] + v[i][2] * v[i][2] + v[i][3] * v[i][3]; }
        { const int tn = tok + gridDim.x * 8; if (tn < T) {
#pragma unroll
            for (int i = 0; i < 4; ++i) vn[i] = *(const f32x4*)(xin + (size_t)tn * 1024 + i * 256 + lane * 4); } }
        ss = wave_sum(ss); const float rs = rsqrtf(ss * (1.0f / 1024.0f) + EPS);
        float d0 = 0.f, d1 = 0.f, d2 = 0.f, d3 = 0.f, d4 = 0.f, d5 = 0.f, d6 = 0.f, d7 = 0.f;
#pragma unroll
        for (int i = 0; i < 4; ++i) { const int c0 = i * 256 + lane * 4; const f32x4 gv = *(const f32x4*)(g + c0); f32x4 hv;
#pragma unroll
            for (int j = 0; j < 4; ++j) { hv[j] = v[i][j] * rs * gv[j]; const f32x4 wa_ = *(const f32x4*)(wif + (c0 + j) * 8), wb_ = *(const f32x4*)(wif + (c0 + j) * 8 + 4);
                d0 += hv[j] * wa_[0]; d1 += hv[j] * wa_[1]; d2 += hv[j] * wa_[2]; d3 += hv[j] * wa_[3]; d4 += hv[j] * wb_[0]; d5 += hv[j] * wb_[1]; d6 += hv[j] * wb_[2]; d7 += hv[j] * wb_[3]; }
            u32x2 w; w.x = pack2(hv[0], hv[1]); w.y = pack2(hv[2], hv[3]); *(u32x2*)(H + (size_t)tok * 1024 + c0) = w; }
        d0 = wave_sum(d0); d1 = wave_sum(d1); d2 = wave_sum(d2); d3 = wave_sum(d3); d4 = wave_sum(d4); d5 = wave_sum(d5); d6 = wave_sum(d6); d7 = wave_sum(d7);
        if (lane == 0) { f32x4 a = {d0, d1, d2, d3}, b = {d4, d5, d6, d7}; *(f32x4*)(IFp + (size_t)tok * 8) = a; *(f32x4*)(IFp + (size_t)tok * 8 + 4) = b; }
    }
    __syncthreads();
}
DI void phase_final_norm(const Params& p) {
    const int tid = opaque_tid(), wid = tid >> 6, lane = tid & 63;
    for (int tok = blockIdx.x * 8 + wid; tok < T; tok += gridDim.x * 8) {
        float* xr = p.out + (size_t)tok * 1024; f32x4 v[4]; float ss = 0.f;
#pragma unroll
        for (int i = 0; i < 4; ++i) { v[i] = *(const f32x4*)(xr + i * 256 + lane * 4); ss += v[i][0] * v[i][0] + v[i][1] * v[i][1] + v[i][2] * v[i][2] + v[i][3] * v[i][3]; }
        ss = wave_sum(ss); const float rs = rsqrtf(ss * (1.0f / 1024.0f) + EPS);
#pragma unroll
        for (int i = 0; i < 4; ++i) { const f32x4 gv = *(const f32x4*)(p.fin_g + i * 256 + lane * 4); f32x4 o = v[i] * rs * gv; *(f32x4*)(xr + i * 256 + lane * 4) = o; }
    }
}
template <int R> DI void transpose_pairs(const unsigned* N, int ldn, bf16_t* Tt, int ldt, int tid) {
    constexpr int CPT = 64 * R / 512; const int r = tid & (R - 1), cq = tid / R;
#pragma unroll
    for (int i = 0; i < CPT; ++i) { const int c = cq * CPT + i; const unsigned w = N[r * ldn + c]; Tt[(2 * c) * ldt + r] = (bf16_t)(w & 0xffffu); Tt[(2 * c + 1) * ldt + r] = (bf16_t)(w >> 16); }
}
DI void mlstm_gates(const Params& p, int l, int h, int tok0, float* sg, float* sig, float* stmp) {
    const int tid = opaque_tid(); const float* IFp = (const float*)(p.ws + WS_IF);
    float lf = 0.f;
    if (tid < 128) { const size_t tok = (size_t)(tok0 + tid);
        sig[tid] = IFp[tok * 8 + h] + p.b_if[l * 8 + h];
        lf = logsigf_(IFp[tok * 8 + 4 + h] + p.b_if[l * 8 + 4 + h]);
#pragma unroll
        for (int o = 1; o < 64; o <<= 1) { const float n = __shfl_up(lf, o); if ((tid & 63) >= o) lf += n; }
        if (tid == 63) stmp[0] = lf; }
    __syncthreads();
    if (tid < 128) { if (tid >= 64) lf += stmp[0]; sg[tid] = lf; }
    __syncthreads();
}
DI void load_win19(const bf16_t* U, int b, int tseq0, int ch, unsigned (&xs)[19]) {
    const bf16_t* ptr = U + ((size_t)(b * SEQ + tseq0) * NU + ch);
    const bool has_prev = tseq0 >= 3;
    xs[0] = 0u; xs[1] = 0u; xs[2] = 0u;
    if (has_prev) { xs[0] = *(const unsigned*)(ptr - 3 * (size_t)NU); xs[1] = *(const unsigned*)(ptr - 2 * (size_t)NU); xs[2] = *(const unsigned*)(ptr - (size_t)NU); }
#pragma unroll
    for (int m = 3; m < 19; ++m) xs[m] = *(const unsigned*)(ptr + (size_t)(m - 3) * NU);
}
DI void conv_win(const unsigned (&xs)[19], int i, const float (&w0)[4], const float (&w1)[4], float& y0, float& y1) {
    float a0 = 0.f, a1 = 0.f;
#pragma unroll
    for (int k = 0; k < 4; ++k) { a0 += w0[k] * bflo(xs[i + k]); a1 += w1[k] * bfhi(xs[i + k]); }
    y0 = siluf_(a0); y1 = siluf_(a1);
}
DI void mlstm_local_unit(const Params& p, int l, int ua, unsigned char* sm) {
    const int tid = opaque_tid(), wid = tid >> 6, lane = tid & 63;
    const int bh = ua >> 4, c = ua & 15, b = bh >> 2, h = bh & 3, tok0 = b * SEQ + c * 128;
    float* sg = (float*)sm; float* sig = sg + 128; float* stmp = sg + 256;
    bf16_t* KwT = (bf16_t*)(sm + 2048); bf16_t* VT = (bf16_t*)(sm + 2048 + 34816);
    const bf16_t* U = (const bf16_t*)(p.ws + WS_U);
    unsigned* N1 = (unsigned*)(sm + 71680); unsigned* N2 = (unsigned*)(sm + 104960);
    { const int dp = tid & 63, d = 2 * dp, ch = 512 + h * 128 + d; float w0[4], w1[4];
#pragma unroll
      for (int k = 0; k < 4; ++k) { w0[k] = p.mconv_w[(size_t)l * 4096 + k * 1024 + ch]; w1[k] = p.mconv_w[(size_t)l * 4096 + k * 1024 + ch + 1]; }
      unsigned xs[19]; load_win19(U, b, c * 128 + 16 * wid, ch, xs);
      unsigned vv[16];
#pragma unroll
      for (int i = 0; i < 16; ++i) vv[i] = *(const unsigned*)(U + (size_t)(tok0 + 16 * wid + i) * NU + U_VA + h * 128 + d);
      mlstm_gates(p, l, h, tok0, sg, sig, stmp);
      const float G_ = sg[127];
#pragma unroll
      for (int i = 0; i < 16; ++i) { const int r = 16 * wid + i; float y0, y1; conv_win(xs, i, w0, w1, y0, y1);
          const float wr_ = fexp_(G_ - sg[r] + sig[r]);
          N1[r * 65 + dp] = pack2(y0 * wr_, y1 * wr_); N2[r * 65 + dp] = vv[i]; } }
    const float G = sg[127];
    __syncthreads();
    transpose_pairs<128>(N1, 65, KwT, 136, tid); transpose_pairs<128>(N2, 65, VT, 136, tid);
    __syncthreads();
    f32x16 acc[1][2]; zero_acc<1, 2>(acc);
    const int dt = wid & 3, eh = wid >> 2;
    mma_lds<1, 2>(acc, KwT + 32 * dt * 136, 136, VT + 64 * eh * 136, 136, 128, lane);
    bf16_t* ST = (bf16_t*)(p.ws + WS_STA) + (size_t)ua * 16384;
    { const int r31 = lane & 31, hh = lane >> 5;
#pragma unroll
      for (int nt = 0; nt < 2; ++nt) { const int e = 64 * eh + 32 * nt + r31;
#pragma unroll
          for (int q4 = 0; q4 < 4; ++q4) { const int d0 = 32 * dt + 8 * q4 + 4 * hh; f32x4 v = {acc[0][nt][4 * q4], acc[0][nt][4 * q4 + 1], acc[0][nt][4 * q4 + 2], acc[0][nt][4 * q4 + 3]};
              u32x2 w; w.x = pack2(v[0], v[1]); w.y = pack2(v[2], v[3]); *(u32x2*)(ST + e * 128 + d0) = w; } } }
    { const int d = tid >> 2, qd = tid & 3; float s = 0.f;
#pragma unroll
      for (int i = 0; i < 4; ++i) { const u32x4 v = *(const u32x4*)(KwT + d * 136 + 32 * qd + 8 * i); s += bflo(v.x) + bfhi(v.x) + bflo(v.y) + bfhi(v.y) + bflo(v.z) + bfhi(v.z) + bflo(v.w) + bfhi(v.w); }
      s += __shfl_xor(s, 1); s += __shfl_xor(s, 2);
      if (qd == 0) ((float*)(p.ws + WS_NA))[ua * 128 + d] = s; }
    if (tid == 0) ((float*)(p.ws + WS_GA))[ua] = G;
    __syncthreads();
}
DI void mlstm_scan(const Params& p) {
    const int gt = blockIdx.x * 512 + opaque_tid(), nth = gridDim.x * 512; const float* GA = (const float*)(p.ws + WS_GA);
    for (int it = gt; it < 32 * 4096; it += nth) { const int bh = it >> 12, v = it & 4095; u32x2* base = (u32x2*)((bf16_t*)(p.ws + WS_STA) + (size_t)bh * 16 * 16384) + v;
        u32x2 tmp[16]; float eg[16];
#pragma unroll
        for (int c = 0; c < 16; ++c) { tmp[c] = base[(size_t)c * 4096]; eg[c] = fexp_(GA[bh * 16 + c]); }
        f32x4 S = {0.f, 0.f, 0.f, 0.f};
#pragma unroll
        for (int c = 0; c < 16; ++c) { u32x2 w; w.x = pack2(S[0], S[1]); w.y = pack2(S[2], S[3]); base[(size_t)c * 4096] = w;
            const f32x4 t = {bflo(tmp[c].x), bfhi(tmp[c].x), bflo(tmp[c].y), bfhi(tmp[c].y)}; S = S * eg[c] + t; } }
    for (int it = gt; it < 32 * 32; it += nth) { const int bh = it >> 5, v = it & 31; f32x4* base = (f32x4*)((float*)(p.ws + WS_NA) + (size_t)bh * 16 * 128) + v;
        f32x4 tmp[16]; float eg[16];
#pragma unroll
        for (int c = 0; c < 16; ++c) { tmp[c] = base[c * 32]; eg[c] = fexp_(GA[bh * 16 + c]); }
        f32x4 S = {0.f, 0.f, 0.f, 0.f};
#pragma unroll
        for (int c = 0; c < 16; ++c) { base[c * 32] = S; S = S * eg[c] + tmp[c]; } }
}
DI void mlstm_out_unit(const Params& p, int l, int ua, unsigned char* sm) {
    const int tid = opaque_tid(), wid = tid >> 6, lane = tid & 63, r31 = lane & 31, hh = lane >> 5;
    const int bh = ua >> 4, c = ua & 15, b = bh >> 2, h = bh & 3, tok0 = b * SEQ + c * 128;
    float* sg = (float*)sm; float* sig = sg + 128; float* sden = sg + 256; float* snp = sg + 384;
    bf16_t* Q = (bf16_t*)(sm + 2048); bf16_t* KP = (bf16_t*)(sm + 36864); bf16_t* VT = (bf16_t*)(sm + 71680); bf16_t* STs = (bf16_t*)(sm + 106496);
    float* Hs = (float*)(sm + 2048);
    const bf16_t* U = (const bf16_t*)(p.ws + WS_U);
    unsigned* N2 = (unsigned*)(sm + 106496);
    unsigned fov[16], fzv[16];
#pragma unroll
    for (int jj = 0; jj < 16; ++jj) { const size_t tk = (size_t)(tok0 + wid * 16 + jj); fov[jj] = *(const unsigned*)(U + tk * NU + U_OA + h * 128 + 2 * lane); fzv[jj] = *(const unsigned*)(U + tk * NU + U_ZA + h * 128 + 2 * lane); }
    u32x4 stv[4];
    { const bf16_t* ST = (const bf16_t*)(p.ws + WS_STA) + (size_t)ua * 16384;
#pragma unroll
      for (int i = 0; i < 4; ++i) { const int idx = i * 512 + tid, e = idx >> 4, d8 = (idx & 15) * 8; stv[i] = *(const u32x4*)(ST + e * 128 + d8); } }
    { const int dp = tid & 63, d = 2 * dp, chq = h * 128 + d, chk = 512 + chq; float wq0[4], wq1[4], wk0[4], wk1[4];
#pragma unroll
      for (int k = 0; k < 4; ++k) { wq0[k] = p.mconv_w[(size_t)l * 4096 + k * 1024 + chq]; wq1[k] = p.mconv_w[(size_t)l * 4096 + k * 1024 + chq + 1];
                                    wk0[k] = p.mconv_w[(size_t)l * 4096 + k * 1024 + chk]; wk1[k] = p.mconv_w[(size_t)l * 4096 + k * 1024 + chk + 1]; }
      unsigned xq[19], xk[19]; load_win19(U, b, c * 128 + 16 * wid, chq, xq); load_win19(U, b, c * 128 + 16 * wid, chk, xk);
      unsigned vv[16];
#pragma unroll
      for (int i = 0; i < 16; ++i) vv[i] = *(const unsigned*)(U + (size_t)(tok0 + 16 * wid + i) * NU + U_VA + h * 128 + d);
      mlstm_gates(p, l, h, tok0, sg, sig, sden);
      __builtin_amdgcn_sched_barrier(0);
#pragma unroll
      for (int i = 0; i < 16; ++i) { const int r = 16 * wid + i; float y0, y1;
          conv_win(xq, i, wq0, wq1, y0, y1); *(unsigned*)(Q + r * 136 + d) = pack2(y0 * 0.08838834764831845f, y1 * 0.08838834764831845f);
          if ((i & 3) == 3) __builtin_amdgcn_sched_barrier(0); }
#pragma unroll
      for (int i = 0; i < 16; ++i) { const int r = 16 * wid + i; float y0, y1;
          conv_win(xk, i, wk0, wk1, y0, y1); *(unsigned*)(KP + r * 136 + d) = pack2(y0, y1);
          if ((i & 3) == 3) __builtin_amdgcn_sched_barrier(0); }
#pragma unroll
      for (int i = 0; i < 16; ++i) N2[(16 * wid + i) * 65 + dp] = vv[i];
      __builtin_amdgcn_sched_barrier(0); }
    if (tid < 128) snp[tid] = ((const float*)(p.ws + WS_NA))[ua * 128 + tid];
    __syncthreads();
    const int jt = wid & 3, ch2 = wid >> 2;
    f32x16 acc[1][2]; zero_acc<1, 2>(acc);
    mma_lds<1, 2>(acc, Q + 32 * jt * 136, 136, KP + 64 * ch2 * 136, 136, 128, lane);
    transpose_pairs<128>(N2, 65, VT, 136, tid);
    __syncthreads();
#pragma unroll
    for (int i = 0; i < 4; ++i) { const int idx = i * 512 + tid, e = idx >> 4, d8 = (idx & 15) * 8; *(u32x4*)(STs + e * 136 + d8) = stv[i]; }
#pragma unroll
    for (int nt = 0; nt < 2; ++nt) { const int r = 64 * ch2 + 32 * nt + r31; const float gr = sg[r], ir = sig[r];
#pragma unroll
        for (int i = 0; i < 16; ++i) { const int j = 32 * jt + crow(i, hh); const float val = (r <= j) ? acc[0][nt][i] * fexp_(sg[j] - gr + ir) : 0.f; KP[j * 136 + r] = f2bf(val); } }
    __syncthreads();
    f32x16 apv[1][2], aqs[1][2]; zero_acc<1, 2>(apv); zero_acc<1, 2>(aqs);
    mma_lds<1, 2>(apv, KP + 32 * jt * 136, 136, VT + 64 * ch2 * 136, 136, 128, lane);
    mma_lds<1, 2>(aqs, Q + 32 * jt * 136, 136, STs + 64 * ch2 * 136, 136, 128, lane);
    { const int j = tid >> 2, qd = tid & 3; float s1 = 0.f, s2 = 0.f;
#pragma unroll
      for (int i = 0; i < 4; ++i) { const u32x4 pv = *(const u32x4*)(KP + j * 136 + 32 * qd + 8 * i), qv = *(const u32x4*)(Q + j * 136 + 32 * qd + 8 * i);
          const f32x4 n0 = *(const f32x4*)(snp + 32 * qd + 8 * i), n1 = *(const f32x4*)(snp + 32 * qd + 8 * i + 4);
          s1 += bflo(pv.x) + bfhi(pv.x) + bflo(pv.y) + bfhi(pv.y) + bflo(pv.z) + bfhi(pv.z) + bflo(pv.w) + bfhi(pv.w);
          s2 += bflo(qv.x) * n0[0] + bfhi(qv.x) * n0[1] + bflo(qv.y) * n0[2] + bfhi(qv.y) * n0[3] + bflo(qv.z) * n1[0] + bfhi(qv.z) * n1[1] + bflo(qv.w) * n1[2] + bfhi(qv.w) * n1[3]; }
      s1 += __shfl_xor(s1, 1); s1 += __shfl_xor(s1, 2); s2 += __shfl_xor(s2, 1); s2 += __shfl_xor(s2, 2);
      if (qd == 0) sden[j] = s1 + fexp_(sg[j]) * s2; }
    __syncthreads();
#pragma unroll
    for (int nt = 0; nt < 2; ++nt) { const int e = 64 * ch2 + 32 * nt + r31;
#pragma unroll
        for (int i = 0; i < 16; ++i) { const int j = 32 * jt + crow(i, hh); const float num = apv[0][nt][i] + fexp_(sg[j]) * aqs[0][nt][i]; Hs[j * 132 + e] = num * __builtin_amdgcn_rcpf(fmaxf(fabsf(sden[j]), 1.0f)); } }
    __syncthreads();
    { bf16_t* YA = (bf16_t*)(p.ws + WS_YA); const int e = 2 * lane; const float g0 = p.mnorm_g[l * 512 + h * 128 + e], g1 = p.mnorm_g[l * 512 + h * 128 + e + 1];
#pragma unroll
      for (int jj = 0; jj < 16; ++jj) { const int j = wid * 16 + jj; const f32x2 v = *(const f32x2*)(Hs + j * 132 + e); const float ss = wave_sum(v[0] * v[0] + v[1] * v[1]); const float rs = rsqrtf(ss * (1.0f / 128.0f) + EPS);
          const size_t tok = (size_t)(tok0 + j);
          *(unsigned*)(YA + tok * 512 + h * 128 + e) = pack2(v[0] * rs * g0 * sigmoidf_(bflo(fov[jj])) * siluf_(bflo(fzv[jj])), v[1] * rs * g1 * sigmoidf_(bfhi(fov[jj])) * siluf_(bfhi(fzv[jj]))); } }
    __syncthreads();
}
struct HgIn { unsigned fv[8], qv[8], vv[8], zv[8]; float lb0, lb1; };
template <bool WITH_Q> DI void hgrn_issue(const Params& p, int l, int ud, HgIn& in) {
    const int tid = opaque_tid(), wid = tid >> 6; const int bh = ud >> 5, c = ud & 31, b = bh >> 2, h = bh & 3, tok0 = b * SEQ + c * 64, d = 2 * (tid & 63);
    const bf16_t* U = (const bf16_t*)(p.ws + WS_U); const float* LB = (const float*)(p.ws + WS_LB);
    in.lb0 = LB[l * 512 + h * 128 + d]; in.lb1 = LB[l * 512 + h * 128 + d + 1];
#pragma unroll
    for (int i = 0; i < 8; ++i) { const size_t rowb = (size_t)(tok0 + 8 * wid + i) * NU + h * 128 + d; in.fv[i] = *(const unsigned*)(U + rowb + U_FD); in.qv[i] = 0u; in.zv[i] = 0u; if (WITH_Q) { in.qv[i] = *(const unsigned*)(U + rowb + U_QD); in.zv[i] = *(const unsigned*)(U + (size_t)(tok0 + 8 * wid + i) * NU + U_ZD + h * 128 + 2 * (tid & 63)); } in.vv[i] = *(const unsigned*)(U + rowb + U_ID); }
}
DI void hgrn_local_unit(const Params& p, int l, int ud, const HgIn& in, unsigned char* sm) {
    const int tid = opaque_tid(), wid = tid >> 6, lane = tid & 63;
    const int bh = ud >> 5, c = ud & 31, b = bh >> 2, h = bh & 3, tok0 = b * SEQ + c * 64;
    float* bS = (float*)sm; float* kS = (float*)(sm + 33024);
    bf16_t* KwT = (bf16_t*)(sm + 66048); bf16_t* VT = (bf16_t*)(sm + 84480); unsigned* N2 = (unsigned*)(sm + 102912);
    const bf16_t* U = (const bf16_t*)(p.ws + WS_U); const float* LB = (const float*)(p.ws + WS_LB);
    { const int dp = tid & 63, d = 2 * dp; const float lb0 = in.lb0, lb1 = in.lb1;
#pragma unroll
      for (int i = 0; i < 8; ++i) { const int r = 8 * wid + i; const float f0 = bflo(in.fv[i]), f1 = bfhi(in.fv[i]);
          bS[r * 129 + d] = __builtin_amdgcn_logf(lb0 + (1.0f - lb0) * sigmoidf_(f0)); bS[r * 129 + d + 1] = __builtin_amdgcn_logf(lb1 + (1.0f - lb1) * sigmoidf_(f1));
          kS[r * 129 + d] = (1.0f - lb0) * sigmoidf_(-f0); kS[r * 129 + d + 1] = (1.0f - lb1) * sigmoidf_(-f1);
          N2[r * 65 + dp] = in.vv[i]; } }
    __syncthreads();
    float* tot = (float*)(sm + 119552);
    { const int dd = tid & 127, J = tid >> 7; float s = 0.f;
#pragma unroll
      for (int rr = 0; rr < 16; ++rr) { s += bS[(16 * J + rr) * 129 + dd]; bS[(16 * J + rr) * 129 + dd] = s; }
      tot[J * 128 + dd] = s; }
    transpose_pairs<64>(N2, 65, VT, 72, tid);
    __syncthreads();
#pragma unroll
    for (int i = 0; i < 16; ++i) { const int idx = i * 512 + tid, r = idx & 63, d = idx >> 6, J = r >> 4;
        const float t0 = tot[d], t1 = tot[128 + d], t2 = tot[256 + d], t3 = tot[384 + d];
        const float rest = J == 0 ? t0 + t1 + t2 + t3 : (J == 1 ? t1 + t2 + t3 : (J == 2 ? t2 + t3 : t3));
        KwT[d * 72 + r] = f2bf(kS[r * 129 + d] * __builtin_amdgcn_exp2f(rest - bS[r * 129 + d])); }
    if (tid < 128) ((float*)(p.ws + WS_DECD))[ud * 128 + tid] = __builtin_amdgcn_exp2f(tot[tid] + tot[128 + tid] + tot[256 + tid] + tot[384 + tid]);
    __syncthreads();
    f32x16 acc[1][2]; zero_acc<1, 2>(acc);
    const int dt = wid & 3, eh = wid >> 2;
    mma_lds<1, 2>(acc, KwT + 32 * dt * 72, 72, VT + 64 * eh * 72, 72, 64, lane);
    bf16_t* ST = (bf16_t*)(p.ws + WS_STD) + (size_t)ud * 16384;
    { const int r31 = lane & 31, hh = lane >> 5;
#pragma unroll
      for (int nt = 0; nt < 2; ++nt) { const int e = 64 * eh + 32 * nt + r31;
#pragma unroll
          for (int q4 = 0; q4 < 4; ++q4) { const int d0 = 32 * dt + 8 * q4 + 4 * hh; f32x4 v = {acc[0][nt][4 * q4], acc[0][nt][4 * q4 + 1], acc[0][nt][4 * q4 + 2], acc[0][nt][4 * q4 + 3]};
              u32x2 w; w.x = pack2(v[0], v[1]); w.y = pack2(v[2], v[3]); *(u32x2*)(ST + e * 128 + d0) = w; } } }
    __syncthreads();
}
DI void hgrn_scan(const Params& p) {
    const int gt = blockIdx.x * 512 + opaque_tid(), nth = gridDim.x * 512; const float* DEC = (const float*)(p.ws + WS_DECD);
    for (int it = gt; it < 32 * 4096; it += nth) { const int bh = it >> 12, v = it & 4095, d4 = (v & 31) * 4; f32x4 S = {0.f, 0.f, 0.f, 0.f};
#pragma unroll 1
        for (int half = 0; half < 2; ++half) { u32x2* base = (u32x2*)((bf16_t*)(p.ws + WS_STD) + (size_t)(bh * 32 + half * 16) * 16384) + v; const float* db = DEC + (bh * 32 + half * 16) * 128 + d4;
            u32x2 tmp[16]; f32x4 dec[16];
#pragma unroll
            for (int c = 0; c < 16; ++c) { tmp[c] = base[(size_t)c * 4096]; dec[c] = *(const f32x4*)(db + c * 128); }
#pragma unroll
            for (int c = 0; c < 16; ++c) { u32x2 w; w.x = pack2(S[0], S[1]); w.y = pack2(S[2], S[3]); base[(size_t)c * 4096] = w;
                const f32x4 t = {bflo(tmp[c].x), bfhi(tmp[c].x), bflo(tmp[c].y), bfhi(tmp[c].y)}; S = S * dec[c] + t; } } }
}
DI void hgrn_out_unit(const Params& p, int l, int ud, const HgIn& in, unsigned char* sm) {
    const int tid = opaque_tid(), wid = tid >> 6, lane = tid & 63, r31 = lane & 31, hh = lane >> 5;
    const int bh = ud >> 5, c = ud & 31, b = bh >> 2, h = bh & 3, tok0 = b * SEQ + c * 64;
    float* bS = (float*)sm; bf16_t* STs = (bf16_t*)sm; float* tot = (float*)(sm + 32768);
    bf16_t* Qh = (bf16_t*)(sm + 34816); bf16_t* Qb = (bf16_t*)(sm + 52224); bf16_t* KK = (bf16_t*)(sm + 69632); float* Hs = (float*)(sm + 69632);
    bf16_t* VT = (bf16_t*)(sm + 113152); bf16_t* aS = (bf16_t*)(sm + 131584); unsigned* N2 = (unsigned*)(sm + 69632);
    const bf16_t* U = (const bf16_t*)(p.ws + WS_U); const float* LB = (const float*)(p.ws + WS_LB);
    const int dp = tid & 63, d = 2 * dp, R = wid >> 1;
    float q0[8], q1[8], k0[8], k1[8];
    { const float lb0 = in.lb0, lb1 = in.lb1;
#pragma unroll
      for (int i = 0; i < 8; ++i) { const int r = 8 * wid + i; const float f0 = bflo(in.fv[i]), f1 = bfhi(in.fv[i]);
          bS[r * 128 + d] = __builtin_amdgcn_logf(lb0 + (1.0f - lb0) * sigmoidf_(f0)); bS[r * 128 + d + 1] = __builtin_amdgcn_logf(lb1 + (1.0f - lb1) * sigmoidf_(f1));
          k0[i] = (1.0f - lb0) * sigmoidf_(-f0); k1[i] = (1.0f - lb1) * sigmoidf_(-f1);
          q0[i] = siluf_(bflo(in.qv[i])) * 0.08838834764831845f; q1[i] = siluf_(bfhi(in.qv[i])) * 0.08838834764831845f;
          N2[r * 65 + dp] = in.vv[i]; } }
    __syncthreads();
    transpose_pairs<64>(N2, 65, VT, 72, tid);
    { const int dd = tid & 127, J = tid >> 7; float s = 0.f;
#pragma unroll
      for (int rr = 0; rr < 16; ++rr) { s += bS[(16 * J + rr) * 128 + dd]; bS[(16 * J + rr) * 128 + dd] = s; }
      tot[J * 128 + dd] = s; }
    __syncthreads();
    { const f32x2 t0 = *(const f32x2*)(tot + d), t1 = *(const f32x2*)(tot + 128 + d), t2 = *(const f32x2*)(tot + 256 + d);
      float offa[4], offb[4]; offa[0] = 0.f; offb[0] = 0.f; offa[1] = t0[0]; offb[1] = t0[1]; offa[2] = t0[0] + t1[0]; offb[2] = t0[1] + t1[1]; offa[3] = offa[2] + t2[0]; offb[3] = offb[2] + t2[1];
      const float oRa = R == 0 ? offa[0] : (R == 1 ? offa[1] : (R == 2 ? offa[2] : offa[3])), oRb = R == 0 ? offb[0] : (R == 1 ? offb[1] : (R == 2 ? offb[2] : offb[3]));
#pragma unroll
      for (int i = 0; i < 8; ++i) { const int r = 8 * wid + i; const f32x2 lc = *(const f32x2*)(bS + r * 128 + d);
          *(unsigned*)(Qh + r * 136 + d) = pack2(q0[i] * __builtin_amdgcn_exp2f(lc[0]), q1[i] * __builtin_amdgcn_exp2f(lc[1]));
          *(unsigned*)(Qb + r * 136 + d) = pack2(q0[i] * __builtin_amdgcn_exp2f(lc[0] + oRa), q1[i] * __builtin_amdgcn_exp2f(lc[1] + oRb));
#pragma unroll
          for (int J = 0; J < 4; ++J) if (J >= R) { const int rowoff = 8 * J * (J + 1);
              *(unsigned*)(KK + (rowoff + r) * 136 + d) = pack2(k0[i] * __builtin_amdgcn_exp2f(fminf(offa[J] - oRa - lc[0], 100.f)), k1[i] * __builtin_amdgcn_exp2f(fminf(offb[J] - oRb - lc[1], 100.f))); } } }
    __syncthreads();
    { const bf16_t* ST = (const bf16_t*)(p.ws + WS_STD) + (size_t)ud * 16384;
#pragma unroll
      for (int i = 0; i < 4; ++i) { const int idx = i * 512 + tid, e = idx >> 4, d8 = (idx & 15) * 8; *(u32x4*)(STs + e * 136 + d8) = *(const u32x4*)(ST + e * 128 + d8); } }
    { const int c15 = lane & 15, q4 = lane >> 4;
#pragma unroll
      for (int sl = 0; sl < 2; ++sl) { const int slot = 2 * wid + sl, J = slot >> 2, Rt = slot & 3; f32x4 acc = {0.f, 0.f, 0.f, 0.f};
          if (Rt <= J) { const int rowoff = 8 * J * (J + 1);
#pragma unroll
              for (int ks = 0; ks < 4; ++ks) { const bf16x8 af = *(const bf16x8*)(Qh + (16 * J + c15) * 136 + 32 * ks + 8 * q4), bfr = *(const bf16x8*)(KK + (rowoff + 16 * Rt + c15) * 136 + 32 * ks + 8 * q4);
                  acc = __builtin_amdgcn_mfma_f32_16x16x32_bf16(af, bfr, acc, 0, 0, 0); } }
#pragma unroll
          for (int i = 0; i < 4; ++i) { const int jj = 16 * J + 4 * q4 + i, rr = 16 * Rt + c15; aS[jj * 72 + rr] = f2bf((Rt <= J && rr <= jj) ? acc[i] : 0.f); } } }
    __syncthreads();
    const int jt = wid & 1, et = wid >> 1;
    f32x16 acc[1][1]; zero_acc<1, 1>(acc);
    mma_lds<1, 1>(acc, aS + 32 * jt * 72, 72, VT + 32 * et * 72, 72, 64, lane);
    mma_lds<1, 1>(acc, Qb + 32 * jt * 136, 136, STs + 32 * et * 136, 136, 128, lane);
#pragma unroll
    for (int i = 0; i < 16; ++i) Hs[(32 * jt + crow(i, hh)) * 132 + 32 * et + r31] = acc[0][0][i];
    __syncthreads();
    { bf16_t* YD = (bf16_t*)(p.ws + WS_YD); const int e = 2 * lane; const float g0 = p.hnorm_g[l * 512 + h * 128 + e], g1 = p.hnorm_g[l * 512 + h * 128 + e + 1];
#pragma unroll
      for (int jj = 0; jj < 8; ++jj) { const int j = wid * 8 + jj; const f32x2 v = *(const f32x2*)(Hs + j * 132 + e); const float ss = wave_sum(v[0] * v[0] + v[1] * v[1]); const float rs = rsqrtf(ss * (1.0f / 128.0f) + EPS);
          const size_t tok = (size_t)(tok0 + j);
          *(unsigned*)(YD + tok * 512 + h * 128 + e) = pack2(v[0] * rs * g0 * siluf_(bflo(in.zv[jj])), v[1] * rs * g1 * siluf_(bfhi(in.zv[jj]))); } }
    __syncthreads();
}
DI void lru_local_unit(const Params& p, int l, int ub, unsigned char* sm) {
    const int tid = opaque_tid(), wid = tid >> 6, lane = tid & 63, c15 = lane & 15, q = lane >> 4;
    const int b = ub >> 5, c = ub & 31, tseq0 = c * 64, tok0 = b * SEQ + tseq0;
    float* xcf = (float*)sm; bf16_t* xcb = (bf16_t*)(sm + 32768); float* aS = (float*)(sm + 49408); float* uS = (float*)(sm + 82176);
    const bf16_t* U = (const bf16_t*)(p.ws + WS_U);
    unsigned* LHA = (unsigned*)(p.ws + WS_LRUH);
    bf16x8 waf[4][2], wxf[4][2];
    { const float* wa = p.wa + ((size_t)l * 8 + wid) * 4096; const float* wx = p.wx + ((size_t)l * 8 + wid) * 4096;
#pragma unroll
      for (int nt = 0; nt < 4; ++nt)
#pragma unroll
          for (int ks = 0; ks < 2; ++ks) { u32x4 ta, tx;
#pragma unroll
              for (int jp = 0; jp < 4; ++jp) { const int d = 32 * ks + 8 * q + 2 * jp, e = 16 * nt + c15;
                  ta[jp] = pack2(wa[d * 64 + e], wa[(d + 1) * 64 + e]); tx[jp] = pack2(wx[d * 64 + e], wx[(d + 1) * 64 + e]); }
              waf[nt][ks] = __builtin_bit_cast(bf16x8, ta); wxf[nt][ks] = __builtin_bit_cast(bf16x8, tx); } }
    float gba[4], gbx[4], gsp[4];
#pragma unroll
    for (int nt = 0; nt < 4; ++nt) { const int ch = wid * 64 + 16 * nt + c15; gba[nt] = p.ba[l * 512 + ch]; gbx[nt] = p.bx[l * 512 + ch]; gsp[nt] = 8.0f * log1pf(expf(-p.lam[l * 512 + ch])); }
    const int ch = tid; float cw0 = p.lconv_w[l * 2048 + ch], cw1 = p.lconv_w[l * 2048 + 512 + ch], cw2 = p.lconv_w[l * 2048 + 1024 + ch], cw3 = p.lconv_w[l * 2048 + 1536 + ch], cb = p.lconv_b[l * 512 + ch];
    float x0 = 0.f, x1 = 0.f, x2 = 0.f;
    if (tseq0 > 0) { x0 = bf2f(U[(size_t)(tok0 - 3) * NU + U_XB + ch]); x1 = bf2f(U[(size_t)(tok0 - 2) * NU + U_XB + ch]); x2 = bf2f(U[(size_t)(tok0 - 1) * NU + U_XB + ch]); }
    float hst = 0.f, Ac = 1.f;
    float xr[16];
#pragma unroll
    for (int tt = 0; tt < 16; ++tt) xr[tt] = bf2f(U[(size_t)(tok0 + tt) * NU + U_XB + ch]);
    for (int sc = 0; sc < 4; ++sc) {
#pragma unroll
        for (int tt = 0; tt < 16; ++tt) { const float x3 = xr[tt]; const float xc = cb + cw0 * x0 + cw1 * x1 + cw2 * x2 + cw3 * x3;
            xcf[tt * 512 + ch] = xc; xcb[tt * 520 + ch] = f2bf(xc); x0 = x1; x1 = x2; x2 = x3; }
        if (sc < 3) {
#pragma unroll
            for (int tt = 0; tt < 16; ++tt) xr[tt] = bf2f(U[(size_t)(tok0 + (sc + 1) * 16 + tt) * NU + U_XB + ch]); }
        __syncthreads();
        { f32x4 accA[4], accX[4];
#pragma unroll
          for (int nt = 0; nt < 4; ++nt) { accA[nt] = (f32x4){0.f, 0.f, 0.f, 0.f}; accX[nt] = (f32x4){0.f, 0.f, 0.f, 0.f}; }
#pragma unroll
          for (int ks = 0; ks < 2; ++ks) { const bf16x8 af = *(const bf16x8*)(xcb + c15 * 520 + wid * 64 + 32 * ks + 8 * q);
#pragma unroll
              for (int nt = 0; nt < 4; ++nt) { accA[nt] = __builtin_amdgcn_mfma_f32_16x16x32_bf16(af, waf[nt][ks], accA[nt], 0, 0, 0); accX[nt] = __builtin_amdgcn_mfma_f32_16x16x32_bf16(af, wxf[nt][ks], accX[nt], 0, 0, 0); } }
#pragma unroll
          for (int nt = 0; nt < 4; ++nt) { const int che = wid * 64 + 16 * nt + c15;
#pragma unroll
              for (int i = 0; i < 4; ++i) { const int t = 4 * q + i; const float rg = sigmoidf_(accA[nt][i] + gba[nt]), ig = sigmoidf_(accX[nt][i] + gbx[nt]);
                  const float la = -rg * gsp[nt]; const float a = fexp_(la); const float mult = __builtin_amdgcn_sqrtf(fmaxf(fmaf(-a, a, 1.0f), 0.f));
                  aS[t * 512 + che] = a; uS[t * 512 + che] = mult * ig * xcf[t * 512 + che]; } } }
        __syncthreads();
#pragma unroll 4
        for (int tt = 0; tt < 16; ++tt) { const float a = aS[tt * 512 + ch], u = uS[tt * 512 + ch]; hst = a * hst + u; Ac *= a; const size_t o = (size_t)(tok0 + sc * 16 + tt) * 512 + ch; LHA[o] = pack2(hst, Ac); }
    }
    __syncthreads();
}
DI void lru_scan(const Params& p) {
    const int gt = blockIdx.x * 512 + opaque_tid(), nth = gridDim.x * 512; const unsigned* LHA = (const unsigned*)(p.ws + WS_LRUH); float* CB = (float*)(p.ws + WS_CARB);
    for (int it = gt; it < 8 * 512; it += nth) { const int b = it >> 9, ch = it & 511; unsigned ha[32];
#pragma unroll
        for (int c = 0; c < 32; ++c) ha[c] = LHA[(size_t)(b * SEQ + c * 64 + 63) * 512 + ch];
        float H = 0.f;
#pragma unroll
        for (int c = 0; c < 32; ++c) { CB[(b * 32 + c) * 512 + ch] = H; H = bfhi(ha[c]) * H + bflo(ha[c]); } }
}
DI void lru_out(const Params& p) {
    const int gt = blockIdx.x * 512 + opaque_tid(), nth = gridDim.x * 512; const unsigned* LHA = (const unsigned*)(p.ws + WS_LRUH); const float* CB = (const float*)(p.ws + WS_CARB);
    const bf16_t* U = (const bf16_t*)(p.ws + WS_U); bf16_t* YB = (bf16_t*)(p.ws + WS_YB);
    for (int it0 = gt; it0 < T * 128; it0 += 8 * nth) {
        u32x4 ha[8]; f32x4 cr[8]; u32x2 zv[8];
#pragma unroll
        for (int k = 0; k < 8; ++k) { const int it = it0 + k * nth; if (it < T * 128) { const int tok = it >> 7, c4 = (it & 127) * 4; const size_t o = (size_t)tok * 512 + c4;
            ha[k] = *(const u32x4*)(LHA + o); cr[k] = *(const f32x4*)(CB + (size_t)(tok >> 6) * 512 + c4); zv[k] = *(const u32x2*)(U + (size_t)tok * NU + U_ZB + c4); } }
#pragma unroll
        for (int k = 0; k < 8; ++k) { const int it = it0 + k * nth; if (it < T * 128) { const int tok = it >> 7, c4 = (it & 127) * 4; const size_t o = (size_t)tok * 512 + c4;
            const float h0 = bflo(ha[k].x) + bfhi(ha[k].x) * cr[k][0], h1 = bflo(ha[k].y) + bfhi(ha[k].y) * cr[k][1], h2 = bflo(ha[k].z) + bfhi(ha[k].z) * cr[k][2], h3 = bflo(ha[k].w) + bfhi(ha[k].w) * cr[k][3];
            u32x2 w; w.x = pack2(h0 * siluf_(bflo(zv[k].x)), h1 * siluf_(bfhi(zv[k].x))); w.y = pack2(h2 * siluf_(bflo(zv[k].y)), h3 * siluf_(bfhi(zv[k].y))); *(u32x2*)(YB + o) = w; } } }
}
#define MFMA32(a, b, c) __builtin_amdgcn_mfma_f32_32x32x16_bf16((a), (b), (c), 0, 0, 0)
DI bf16x8 pack_p(const f32x16& x, int s) {
    u32x4 w; w.x = pack2(x[8 * s], x[8 * s + 1]); w.y = pack2(x[8 * s + 2], x[8 * s + 3]); w.z = pack2(x[8 * s + 4], x[8 * s + 5]); w.w = pack2(x[8 * s + 6], x[8 * s + 7]);
    return __builtin_bit_cast(bf16x8, w);
}
DI bf16x8 vt_frag(const bf16_t* VT, int e, int key0, int hh) {
    const s16x4 lo = *(const s16x4*)(VT + e * 260 + key0 + 4 * hh), hi = *(const s16x4*)(VT + e * 260 + key0 + 8 + 4 * hh);
    return __builtin_shufflevector(lo, hi, 0, 1, 2, 3, 4, 5, 6, 7);
}
DI void swa_unit(const Params& p, int l, int uc, unsigned char* sm) {
    const int tid = opaque_tid(), wid = tid >> 6, lane = tid & 63, r31 = lane & 31, hh = lane >> 5;
    const int b = uc >> 5, nb = (uc >> 1) & 15, kv = uc & 1;
    bf16_t* Ks = (bf16_t*)sm; bf16_t* VT = (bf16_t*)(sm + 36864); int* posk = (int*)(sm + 70656); unsigned* N2 = (unsigned*)(sm + 71680);
    const bf16_t* U = (const bf16_t*)(p.ws + WS_U); bf16_t* YC = (bf16_t*)(p.ws + WS_YC);
#pragma unroll
    for (int i = 0; i < 4; ++i) { const int idx = i * 512 + tid, s = idx >> 3, c8 = idx & 7, tseq = nb * 128 - 128 + s; u32x4 v = {0u, 0u, 0u, 0u};
        if (tseq >= 0) v = *(const u32x4*)(U + (size_t)(b * SEQ + tseq) * NU + U_KC + kv * 64 + c8 * 8);
        *(u32x4*)(Ks + s * 72 + c8 * 8) = v; }
    { unsigned vv[16];
#pragma unroll
      for (int i = 0; i < 16; ++i) { const int idx = i * 512 + tid, s = idx >> 5, ep = idx & 31; int tseq = nb * 128 - 128 + s; tseq = tseq < 0 ? 0 : tseq;
          vv[i] = *(const unsigned*)(U + (size_t)(b * SEQ + tseq) * NU + U_VC + kv * 64 + 2 * ep); }
#pragma unroll
      for (int i = 0; i < 16; ++i) { const int idx = i * 512 + tid, s = idx >> 5, ep = idx & 31; N2[s * 33 + ep] = (nb * 128 - 128 + s >= 0) ? vv[i] : 0u; } }
    if (tid < 256) { const int tseq = nb * 128 - 128 + tid; posk[tid] = tseq >= 0 ? p.pos[b * SEQ + tseq] : 0; }
    const int g = wid >> 1, th = wid & 1, head = kv * 4 + g; const float slope = exp2f(-(float)(head + 1)), sink = p.sinks[l * 8 + head];
    bf16x8 qn[4];
#pragma unroll
    for (int ks = 0; ks < 4; ++ks) qn[ks] = *(const bf16x8*)(U + (size_t)(b * SEQ + nb * 128 + 64 * th + r31) * NU + U_QC + head * 64 + 16 * ks + 8 * hh);
    __syncthreads();
    { const int s = tid & 255, eq = tid >> 8;
#pragma unroll
      for (int i = 0; i < 16; ++i) { const int ep = eq * 16 + i; const unsigned w = N2[s * 33 + ep]; VT[(2 * ep) * 260 + s] = (bf16_t)(w & 0xffffu); VT[(2 * ep + 1) * 260 + s] = (bf16_t)(w >> 16); } }
    __syncthreads();
#pragma unroll 1
    for (int pass = 0; pass < 2; ++pass) {
        const int t0 = 64 * th + 32 * pass, t = t0 + r31; const size_t tok = (size_t)(b * SEQ + nb * 128 + t);
        bf16x8 qf[4];
#pragma unroll
        for (int ks = 0; ks < 4; ++ks) { qf[ks] = qn[ks]; qn[ks] = *(const bf16x8*)(U + (tok + 32 * (1 - pass)) * NU + U_QC + head * 64 + 16 * ks + 8 * hh); }
        u32x2 zpre[2][4];
#pragma unroll
        for (int et = 0; et < 2; ++et)
#pragma unroll
            for (int q4 = 0; q4 < 4; ++q4) zpre[et][q4] = *(const u32x2*)(U + tok * NU + U_ZC + head * 64 + 32 * et + 8 * q4 + 4 * hh);
        f32x16 acc[5];
#pragma unroll
        for (int mt = 0; mt < 5; ++mt) {
#pragma unroll
            for (int i = 0; i < 16; ++i) acc[mt][i] = 0.f;
#pragma unroll
            for (int ks = 0; ks < 4; ++ks) { const bf16x8 kf = *(const bf16x8*)(Ks + (t0 + 32 * mt + r31) * 72 + 16 * ks + 8 * hh); acc[mt] = MFMA32(kf, qf[ks], acc[mt]); } }
        const int pq = posk[128 + t]; float m = -INFINITY;
#pragma unroll
        for (int mt = 0; mt < 5; ++mt)
#pragma unroll
            for (int g4 = 0; g4 < 4; ++g4) { const int cr0 = 8 * g4 + 4 * hh, sb = t0 + 32 * mt + cr0; const u32x4 pk = *(const u32x4*)(posk + sb);
#pragma unroll
                for (int k = 0; k < 4; ++k) { const int i = 4 * g4 + k; bool valid = (nb > 0) || (sb + k >= 128);
                    if (mt == 0) valid = valid && (cr0 + k > r31);
                    if (mt == 4) valid = valid && (cr0 + k <= r31);
                    const float dist = fabsf((float)(pq - (int)pk[k])); const float sc = valid ? acc[mt][i] * 0.125f - slope * dist : -INFINITY; acc[mt][i] = sc; m = fmaxf(m, sc); } }
        m = fmaxf(m, __shfl_xor(m, 32)); m = fmaxf(m, sink);
        float sum = 0.f;
#pragma unroll
        for (int mt = 0; mt < 5; ++mt)
#pragma unroll
            for (int i = 0; i < 16; ++i) { const float pv = fexp_(acc[mt][i] - m); acc[mt][i] = pv; sum += pv; }
        sum += __shfl_xor(sum, 32); sum += fexp_(sink - m); const float inv = __builtin_amdgcn_rcpf(sum);
        f32x16 o[2];
#pragma unroll
        for (int i = 0; i < 16; ++i) { o[0][i] = 0.f; o[1][i] = 0.f; }
#pragma unroll
        for (int mt = 0; mt < 5; ++mt) {
#pragma unroll
            for (int i = 0; i < 16; ++i) acc[mt][i] *= inv;
#pragma unroll
            for (int s2 = 0; s2 < 2; ++s2) { const bf16x8 pf = pack_p(acc[mt], s2);
#pragma unroll
                for (int et = 0; et < 2; ++et) o[et] = MFMA32(vt_frag(VT, 32 * et + r31, t0 + 32 * mt + 16 * s2, hh), pf, o[et]); } }
#pragma unroll
        for (int et = 0; et < 2; ++et)
#pragma unroll
            for (int q4 = 0; q4 < 4; ++q4) { const int e0 = 32 * et + 8 * q4 + 4 * hh; const u32x2 zv = zpre[et][q4];
                u32x2 w; w.x = pack2(o[et][4 * q4] * siluf_(bflo(zv.x)), o[et][4 * q4 + 1] * siluf_(bfhi(zv.x))); w.y = pack2(o[et][4 * q4 + 2] * siluf_(bflo(zv.y)), o[et][4 * q4 + 3] * siluf_(bfhi(zv.y)));
                *(u32x2*)(YC + tok * 512 + head * 64 + e0) = w; }
    }
    __syncthreads();
}
DI void xattn_unit(const Params& p, int l, int ue, unsigned char* sm) {
    const int tid = opaque_tid(), wid = tid >> 6, lane = tid & 63, r31 = lane & 31, hh = lane >> 5;
    const int b = ue >> 5, hd = (ue >> 3) & 3, qt = ue & 7;
    bf16_t* Ks = (bf16_t*)sm; bf16_t* VT = (bf16_t*)(sm + 36864); unsigned* N2 = (unsigned*)(sm + 71680);
    const bf16_t* U = (const bf16_t*)(p.ws + WS_U); const bf16_t* KVM = (const bf16_t*)(p.ws + WS_KVM); bf16_t* YE = (bf16_t*)(p.ws + WS_YE);
#pragma unroll
    for (int i = 0; i < 4; ++i) { const int idx = i * 512 + tid, s = idx >> 3, c8 = idx & 7;
        *(u32x4*)(Ks + s * 72 + c8 * 8) = *(const u32x4*)(KVM + (size_t)(b * 256 + s) * 2048 + l * 512 + hd * 64 + c8 * 8); }
    { unsigned vv[16];
#pragma unroll
      for (int i = 0; i < 16; ++i) { const int idx = i * 512 + tid, s = idx >> 5, ep = idx & 31; vv[i] = *(const unsigned*)(KVM + (size_t)(b * 256 + s) * 2048 + l * 512 + 256 + hd * 64 + 2 * ep); }
#pragma unroll
      for (int i = 0; i < 16; ++i) { const int idx = i * 512 + tid, s = idx >> 5, ep = idx & 31; N2[s * 33 + ep] = vv[i]; } }
    const int t = qt * 256 + 32 * wid + r31; const size_t tok = (size_t)(b * SEQ + t);
    bf16x8 qf[4];
#pragma unroll
    for (int ks = 0; ks < 4; ++ks) qf[ks] = *(const bf16x8*)(U + tok * NU + U_QE + hd * 64 + 16 * ks + 8 * hh);
    u32x2 zpre[2][4];
#pragma unroll
    for (int et = 0; et < 2; ++et)
#pragma unroll
        for (int q4 = 0; q4 < 4; ++q4) zpre[et][q4] = *(const u32x2*)(U + tok * NU + U_ZE + hd * 64 + 32 * et + 8 * q4 + 4 * hh);
    __syncthreads();
    { const int s = tid & 255, eq = tid >> 8;
#pragma unroll
      for (int i = 0; i < 16; ++i) { const int ep = eq * 16 + i; const unsigned w = N2[s * 33 + ep]; VT[(2 * ep) * 260 + s] = (bf16_t)(w & 0xffffu); VT[(2 * ep + 1) * 260 + s] = (bf16_t)(w >> 16); } }
    __syncthreads();
    float m = -INFINITY;
#pragma unroll 1
    for (int half = 0; half < 2; ++half) { f32x16 acc[4];
#pragma unroll
        for (int mt = 0; mt < 4; ++mt) {
#pragma unroll
            for (int i = 0; i < 16; ++i) acc[mt][i] = 0.f;
#pragma unroll
            for (int ks = 0; ks < 4; ++ks) { const bf16x8 kf = *(const bf16x8*)(Ks + (128 * half + 32 * mt + r31) * 72 + 16 * ks + 8 * hh); acc[mt] = MFMA32(kf, qf[ks], acc[mt]); }
#pragma unroll
            for (int i = 0; i < 16; ++i) m = fmaxf(m, acc[mt][i]); } }
    m = fmaxf(m, __shfl_xor(m, 32)) * 0.125f;
    float sum = 0.f; f32x16 o[2];
#pragma unroll
    for (int i = 0; i < 16; ++i) { o[0][i] = 0.f; o[1][i] = 0.f; }
#pragma unroll 1
    for (int half = 0; half < 2; ++half) { f32x16 acc[4];
#pragma unroll
        for (int mt = 0; mt < 4; ++mt) {
#pragma unroll
            for (int i = 0; i < 16; ++i) acc[mt][i] = 0.f;
#pragma unroll
            for (int ks = 0; ks < 4; ++ks) { const bf16x8 kf = *(const bf16x8*)(Ks + (128 * half + 32 * mt + r31) * 72 + 16 * ks + 8 * hh); acc[mt] = MFMA32(kf, qf[ks], acc[mt]); }
#pragma unroll
            for (int i = 0; i < 16; ++i) { const float pv = fexp_(acc[mt][i] * 0.125f - m); acc[mt][i] = pv; sum += pv; }
#pragma unroll
            for (int s2 = 0; s2 < 2; ++s2) { const bf16x8 pf = pack_p(acc[mt], s2);
#pragma unroll
                for (int et = 0; et < 2; ++et) o[et] = MFMA32(vt_frag(VT, 32 * et + r31, 128 * half + 32 * mt + 16 * s2, hh), pf, o[et]); } } }
    sum += __shfl_xor(sum, 32); const float inv = __builtin_amdgcn_rcpf(sum);
#pragma unroll
    for (int et = 0; et < 2; ++et)
#pragma unroll
        for (int q4 = 0; q4 < 4; ++q4) { const int e0 = 32 * et + 8 * q4 + 4 * hh; const u32x2 zv = zpre[et][q4];
            u32x2 w; w.x = pack2(o[et][4 * q4] * inv * siluf_(bflo(zv.x)), o[et][4 * q4 + 1] * inv * siluf_(bfhi(zv.x))); w.y = pack2(o[et][4 * q4 + 2] * inv * siluf_(bflo(zv.y)), o[et][4 * q4 + 3] * inv * siluf_(bfhi(zv.y)));
            *(u32x2*)(YE + tok * 256 + hd * 64 + e0) = w; }
    __syncthreads();
}
#define XB_TMO      128
#define XB_XCNT(j)  (256  + 64 * (j))
#define XB_XSUB(j)  (1280 + 64 * (j))
#define XB_XGEN(j)  (2304 + 64 * (j))
#define XB_TOP      3328
#define XB_TOPGEN   3392
#define XCD_BAR_WORDS 3456
#define XB_SPIN_CAP (1u << 18)
#define LAS __attribute__((address_space(3)))
__device__ __forceinline__ unsigned xb_ld(unsigned* p)              { return __hip_atomic_load(p, __ATOMIC_RELAXED, __HIP_MEMORY_SCOPE_AGENT); }
__device__ __forceinline__ unsigned xb_add(unsigned* p, unsigned v) { return __hip_atomic_fetch_add(p, v, __ATOMIC_RELAXED, __HIP_MEMORY_SCOPE_AGENT); }
__device__ __forceinline__ unsigned xb_xcc_id() { return (unsigned)__builtin_amdgcn_s_getreg((3 << 11) | 20) & 0xFu; }
#define XB_SPIN(cond, bar) do { unsigned _sp = 0; while (cond) { __builtin_amdgcn_s_sleep(1); \
    if ((++_sp & 255u) == 0u) { if (xb_ld(&(bar)[XB_TMO])) break; if (_sp > XB_SPIN_CAP) { atomicAdd(&(bar)[XB_TMO], 1u); break; } } } } while (0)

struct XcdBarrier {
    unsigned* bar; unsigned x;
    volatile LAS unsigned* st;
};

__device__ __forceinline__ XcdBarrier xcd_barrier_post(unsigned* bar, volatile LAS unsigned* st) {
    XcdBarrier b; b.bar = bar; b.x = xb_xcc_id(); b.st = st;
    if (threadIdx.x == 0) (void)xb_add(&bar[XB_XCNT(b.x)], 1u);
    return b;
}
__device__ __forceinline__ void xcd_barrier_complete(unsigned* bar, unsigned x, unsigned& nloc, unsigned& nx) {
    const unsigned G = gridDim.x * gridDim.y * gridDim.z;
    unsigned sum, cnt, mine, sp = 0u;
    for (;;) {
        sum = 0u; cnt = 0u; mine = 0u;
#pragma unroll
        for (unsigned j = 0; j < 16; ++j) { const unsigned c = xb_ld(&bar[XB_XCNT(j)]); sum += c; cnt += (c > 0u) ? 1u : 0u; mine = (j == x) ? c : mine; }
        if (sum == G) break;
        __builtin_amdgcn_s_sleep(1);
        if ((++sp & 255u) == 0u) { if (xb_ld(&bar[XB_TMO])) break; if (sp > XB_SPIN_CAP) { atomicAdd(&bar[XB_TMO], 1u); break; } }
    }
    nloc = mine > 0u ? mine : 1u; nx = cnt > 0u ? cnt : 1u;
}

__device__ __forceinline__ void xcd_barrier(const XcdBarrier& b) {
    asm volatile("s_waitcnt vmcnt(0)" ::: "memory");
    __syncthreads();
    if (threadIdx.x == 0) {
        unsigned* bar = b.bar;
        __builtin_amdgcn_s_waitcnt(0);
        unsigned nloc = b.st[0], nx = b.st[1];
        if (nloc == 0u) { xcd_barrier_complete(bar, b.x, nloc, nx); b.st[0] = nloc; b.st[1] = nx; }
        const unsigned old = xb_add(&bar[XB_XSUB(b.x)], 1u);
        const unsigned gen = old / nloc;
        if (old + 1u == (gen + 1u) * nloc) {
            __builtin_amdgcn_fence(__ATOMIC_RELEASE, "agent");
            asm volatile("s_waitcnt vmcnt(0)" ::: "memory");
            const unsigned og = xb_add(&bar[XB_TOP], 1u);
            const unsigned tg = og / nx;
            if (og + 1u == (tg + 1u) * nx) xb_add(&bar[XB_TOPGEN], 1u);
            else XB_SPIN(xb_ld(&bar[XB_TOPGEN]) == tg, bar);
            __builtin_amdgcn_fence(__ATOMIC_ACQUIRE, "agent");
            xb_add(&bar[XB_XGEN(b.x)], 1u);
            asm volatile("s_waitcnt vmcnt(0)" ::: "memory");
        } else {
            XB_SPIN(xb_ld(&bar[XB_XGEN(b.x)]) == gen, bar);
            __builtin_amdgcn_fence(__ATOMIC_ACQUIRE, "agent");
            asm volatile("s_waitcnt vmcnt(0)" ::: "memory");
        }
    }
    __syncthreads();
}

typedef const __attribute__((address_space(4))) unsigned char* kargp_t;
DI Params load_params(kargp_t kp) { asm volatile("" : "+s"(kp)); Params q; __builtin_memcpy(&q, kp, sizeof(Params)); return q; }
__global__ void __launch_bounds__(512, 2) hybrid_fwd(Params p_unused) {
    const kargp_t kp = (kargp_t)__builtin_amdgcn_kernarg_segment_ptr();
#define p (load_params(kp))
#define GSYNC() do { XcdBarrier b_; b_.bar = (unsigned*)(p.ws + WS_BAR); b_.x = xb_xcc_id(); b_.st = xst; xcd_barrier(b_); } while (0)
    extern __shared__ __attribute__((aligned(16))) unsigned char shm[];
    cg::grid_group grid = cg::this_grid();
    PG8_LAS unsigned char* lds = (PG8_LAS unsigned char*)shm;
    const int G = (int)gridDim.x, bid = (int)blockIdx.x;
#define Ub ((bf16_t*)(p.ws + WS_U))
#define Hb ((bf16_t*)(p.ws + WS_H))
    volatile LAS unsigned* xst = (volatile LAS unsigned*)(lds + (LDS_BYTES - 16));
    if (threadIdx.x == 0) { xst[0] = 0u; xst[1] = 0u; }
    __syncthreads();
    (void)xcd_barrier_post((unsigned*)(p.ws + WS_BAR), xst);
    phase_prologue(p, shm);
    convert_win(p, 0, bid, G, shm);
    if (G == 0x7fffffff) grid.sync();
    GSYNC();
    { pg8::StaticOrder S; S.init(2048, 2048, G, bid); pg8::Gemm g{(const bf16_t*)(p.ws + WS_MEMN), (const bf16_t*)(p.ws + WS_WMEM), 2048, 2048, 1024, 0, 0};
      EpiStoreBf16 E{(bf16_t*)(p.ws + WS_KVM), 2048}; pg8::gemm_phase<EpiStoreBf16, pg8::StaticOrder, false>(lds, g, S, E, nullptr); }
#pragma unroll 1
    for (int l = 0; l < 4; ++l) {
        const float* xin = (l == 0) ? p.x : p.out;
        PREP(9)
        phase_norm(p, l, xin, shm);
        GSYNC();
#pragma unroll 1
        for (int rep = 0; rep < 1 + PROBE_DUP_P2; ++rep)
        { pg8::StaticOrder S; S.init(T, NU, G, bid); pg8::Gemm g{Hb, (const bf16_t*)(p.ws + WS_WIN + (size_t)(l & 1) * SZ_WIN1), T, NU, 1024, 0, 0};
          EpiStoreBf16 E{Ub, NU}; pg8::gemm_phase<EpiStoreBf16, pg8::StaticOrder, false>(lds, g, S, E, nullptr); }
        if (PROBE_DUP_P2 == 0 && l < 3) { const int nrem = 3136 % G; if (bid >= nrem) convert_win(p, l + 1, bid - nrem, G - nrem, shm); }
        GSYNC();
#pragma unroll 1
        for (int rep = 0; rep < 1 + PROBE_DUP_P3; ++rep) {
        PREP(1)
        for (int u = bid; u < 256; u += G) swa_unit(p, l, u, shm);
        PREP(2)
        for (int u = bid; u < 256; u += G) xattn_unit(p, l, u, shm);
        PREP(3)
        for (int u = bid; u < 256; u += G) lru_local_unit(p, l, u, shm);
        if (G == 256 && PROBE_UNIT == 0 && PROBE_DUP_P3 == 0) { HgIn ia, ib; hgrn_issue<false>(p, l, bid, ia); hgrn_issue<false>(p, l, bid + 256, ib);
            for (int u = bid; u < 512; u += G) mlstm_local_unit(p, l, u, shm);
            hgrn_local_unit(p, l, bid, ia, shm);
            hgrn_issue<false>(p, l, bid + 512, ia); hgrn_local_unit(p, l, bid + 256, ib, shm); hgrn_issue<false>(p, l, bid + 768, ib); hgrn_local_unit(p, l, bid + 512, ia, shm); hgrn_local_unit(p, l, bid + 768, ib, shm); }
        else {
        PREP(4)
        for (int u = bid; u < 512; u += G) mlstm_local_unit(p, l, u, shm);
        PREP(5)
        if (G == 256) { HgIn ia, ib; hgrn_issue<false>(p, l, bid, ia); hgrn_issue<false>(p, l, bid + 256, ib); hgrn_local_unit(p, l, bid, ia, shm);
            hgrn_issue<false>(p, l, bid + 512, ia); hgrn_local_unit(p, l, bid + 256, ib, shm); hgrn_issue<false>(p, l, bid + 768, ib); hgrn_local_unit(p, l, bid + 512, ia, shm); hgrn_local_unit(p, l, bid + 768, ib, shm); }
        else for (int u = bid; u < 1024; u += G) { HgIn ia; hgrn_issue<false>(p, l, u, ia); hgrn_local_unit(p, l, u, ia, shm); }
        }
        }
#pragma unroll 1
        for (int i = 0; i < PROBE_SYNCS; ++i) GSYNC();
        GSYNC();
        mlstm_scan(p); hgrn_scan(p); lru_scan(p);
        GSYNC();
#pragma unroll 1
        for (int rep = 0; rep < 1 + PROBE_DUP_P5; ++rep) {
        if (G == 256 && PROBE_UNIT == 0 && PROBE_DUP_P5 == 0) { HgIn ia, ib; hgrn_issue<true>(p, l, bid, ia);
            for (int u = bid; u < 512; u += G) mlstm_out_unit(p, l, u, shm);
            hgrn_issue<true>(p, l, bid + 256, ib); hgrn_out_unit(p, l, bid, ia, shm);
            hgrn_issue<true>(p, l, bid + 512, ia); hgrn_out_unit(p, l, bid + 256, ib, shm); hgrn_issue<true>(p, l, bid + 768, ib); hgrn_out_unit(p, l, bid + 512, ia, shm); hgrn_out_unit(p, l, bid + 768, ib, shm); }
        else {
        PREP(6)
        for (int u = bid; u < 512; u += G) mlstm_out_unit(p, l, u, shm);
        PREP(7)
        if (G == 256) { HgIn ia, ib; hgrn_issue<true>(p, l, bid, ia); hgrn_issue<true>(p, l, bid + 256, ib); hgrn_out_unit(p, l, bid, ia, shm);
            hgrn_issue<true>(p, l, bid + 512, ia); hgrn_out_unit(p, l, bid + 256, ib, shm); hgrn_issue<true>(p, l, bid + 768, ib); hgrn_out_unit(p, l, bid + 512, ia, shm); hgrn_out_unit(p, l, bid + 768, ib, shm); }
        else for (int u = bid; u < 1024; u += G) { HgIn ia; hgrn_issue<true>(p, l, u, ia); hgrn_out_unit(p, l, u, ia, shm); }
        }
        PREP(8)
        lru_out(p);
        }
        GSYNC();
#pragma unroll 1
        for (int rep = 0; rep < 1 + PROBE_DUP_P6; ++rep) {
            bf16_t* Pb = (bf16_t*)(p.ws + WS_YF);
            { GroupOrder S{G, bid}; pg8::Gemm g{(const bf16_t*)(p.ws + WS_YS), (const bf16_t*)(p.ws + WS_WBR) + (size_t)l * 2304 * 1024, T, 1024, 512, (size_t)T * 512 * 2, (size_t)512 * 1024 * 2};
              EpiGateAcc E{Ub + U_G, Pb, Hb, 0}; pg8::gemm_phase<EpiGateAcc, GroupOrder, false>(lds, g, S, E, nullptr); }
            { pg8::StaticOrder S; S.init(T, 1024, G, bid); pg8::Gemm g{(const bf16_t*)(p.ws + WS_YE), (const bf16_t*)(p.ws + WS_WBR) + (size_t)l * 2304 * 1024 + (size_t)4 * 512 * 1024, T, 1024, 256, 0, 0};
              EpiGateAcc E{Ub + U_G, Pb, Hb, 4}; pg8::gemm_phase<EpiGateAcc, pg8::StaticOrder, false>(lds, g, S, E, nullptr); }
        }
        GSYNC();
        { pg8::StaticOrder S; S.init(T, 1024, G, bid); pg8::Gemm g{Hb, (const bf16_t*)(p.ws + WS_WOUT) + (size_t)l * 1024 * 1024, T, 1024, 1024, 0, 0};
          EpiRes E{xin, p.out}; pg8::gemm_phase<EpiRes, pg8::StaticOrder, false>(lds, g, S, E, nullptr); }
        GSYNC();
    }
    phase_final_norm(p);
}
#undef p
#undef GSYNC
#undef Ub
#undef Hb

extern "C" void kernel_launch(void* const* d_in, const int* in_sizes, int n_in, void* d_out, int out_size, void* d_ws, size_t ws_size, hipStream_t stream) {
    static int grid_blocks = 0;
    if (grid_blocks == 0) {
        if (n_in != 23 || ws_size < WS_END) { fprintf(stderr, "kernel_launch: unexpected n_in %d or ws_size %zu (< %zu)\n", n_in, ws_size, (size_t)WS_END); grid_blocks = -1; return; }
        int dev = 0, cus = 0, per_cu = 0;
        hipGetDevice(&dev); hipDeviceGetAttribute(&cus, hipDeviceAttributeMultiprocessorCount, dev);
        if (hipFuncSetAttribute((const void*)hybrid_fwd, hipFuncAttributeMaxDynamicSharedMemorySize, LDS_BYTES) != hipSuccess) { fprintf(stderr, "kernel_launch: hipFuncSetAttribute failed\n"); grid_blocks = -1; return; }
        if (hipOccupancyMaxActiveBlocksPerMultiprocessor(&per_cu, (const void*)hybrid_fwd, 512, LDS_BYTES) != hipSuccess || per_cu < 1) { fprintf(stderr, "kernel_launch: occupancy query failed (%d)\n", per_cu); (void)hipGetLastError(); per_cu = 1; }
        grid_blocks = cus * per_cu;
    }
    if (grid_blocks < 0) return;
    Params p{};
    p.x = (const float*)d_in[0]; p.mem = (const float*)d_in[1]; p.pos = (const int*)d_in[2]; p.norm_g = (const float*)d_in[3]; p.w_in = (const float*)d_in[4];
    p.mconv_w = (const float*)d_in[5]; p.b_if = (const float*)d_in[6]; p.mnorm_g = (const float*)d_in[7]; p.lconv_w = (const float*)d_in[8]; p.lconv_b = (const float*)d_in[9];
    p.wa = (const float*)d_in[10]; p.ba = (const float*)d_in[11]; p.wx = (const float*)d_in[12]; p.bx = (const float*)d_in[13]; p.lam = (const float*)d_in[14];
    p.sinks = (const float*)d_in[15]; p.hlb = (const float*)d_in[16]; p.hnorm_g = (const float*)d_in[17]; p.mem_g = (const float*)d_in[18]; p.w_mem = (const float*)d_in[19];
    p.w_br = (const float*)d_in[20]; p.w_out = (const float*)d_in[21]; p.fin_g = (const float*)d_in[22];
    p.out = (float*)d_out; p.ws = (unsigned char*)d_ws;
    if (hipMemsetAsync((unsigned char*)d_ws + WS_BAR, 0, 16384, stream) != hipSuccess) { fprintf(stderr, "kernel_launch: memset failed\n"); return; }
    void* args[] = {&p};
    hipError_t e = hipLaunchCooperativeKernel((const void*)hybrid_fwd, dim3(grid_blocks), dim3(512), args, LDS_BYTES, stream);
    if (e != hipSuccess) fprintf(stderr, "cooperative launch failed: %s (grid %d)\n", hipGetErrorString(e), grid_blocks);
}
```

```cpp
#include <hip/hip_runtime.h>
#include <hip/hip_cooperative_groups.h>
#include <cstdio>
#define PROBE_DUP_P3 0
#define PROBE_DUP_P5 0
#define PROBE_DUP_P6 0
#define PROBE_DUP_P2 0
#define PROBE_SYNCS 0
#define PROBE_UNIT 0
#define PREP(k) for (int rep_ = 0; rep_ < (PROBE_UNIT == (k) ? 2 : 1); ++rep_)
namespace cg = cooperative_groups;
__device__ __forceinline__ int opaque_tid() { int t = (int)threadIdx.x; asm volatile("" : "+v"(t)); return t; }
namespace pg8 {
#define PG8_LAS __attribute__((address_space(3)))
typedef unsigned short bf16_t;
typedef short bf16x8 __attribute__((ext_vector_type(8)));
typedef float f32x4 __attribute__((ext_vector_type(4)));
typedef unsigned u32x4 __attribute__((ext_vector_type(4)));
constexpr int BM = 256, BK = 64, HALF = 128, HTB = HALF * BK * 2  , STAGE_BYTES = 8 * HTB, NXCD = 8, WGM = 2;

__host__ __device__ __forceinline__ int lds_byte(int r, int c) { const int st = (r >> 4) * 2 + (c >> 5), rr = r & 15, cc = c & 31, ob = rr * 64 + cc * 2; return st * 1024 + (ob ^ (((ob >> 9) & 1) << 5)); }
__host__ __device__ __forceinline__ void stage_rc(int b, int& R, int& C) { const int st = b / 1024, sb = b % 1024, swz = sb ^ (((sb >> 9) & 1) << 5); R = (st >> 1) * 16 + swz / 64; C = (st & 1) * 32 + (swz % 64) / 2; }
__host__ __device__ __forceinline__ int perm32(int rho) { const int n = rho >> 4, i = rho & 15; return 8 * (i >> 2) + 4 * n + (i & 3); }

struct Unit { int pm, pn, g; };
struct Gemm { const bf16_t* A; const bf16_t* Bt; int M, N, K; size_t gsA, gsB; };

struct StaticOrder {
    int nM, nN, nwg, G, c;
    __host__ __device__ void init(int M, int N, int G_, int c_) { nM = M / BM; nN = N / BM; nwg = nM * nN; G = G_; c = c_; }
    __host__ __device__ bool next(int i, Unit& u) const {
        const long L = (long)i * G + c; if (L >= nwg) return false;
        int wgid = (int)L; { const int q = nwg / NXCD, r = nwg % NXCD, xcd = wgid % NXCD, off = wgid / NXCD; wgid = (xcd < r ? xcd * (q + 1) : r * (q + 1) + (xcd - r) * q) + off; }
        const int nig = WGM * nN, gid = wgid / nig, fm = gid * WGM, gsz = (nM - fm) < WGM ? (nM - fm) : WGM;
        u.pm = fm + ((wgid % nig) % gsz); u.pn = (wgid % nig) / gsz; u.g = 0; return true;
    }
    __device__ __forceinline__ void a_ready(const Unit&) const {}
    __device__ __forceinline__ void done(const Unit&) const {}
};
template <class Epi, class Sched, bool STAMP = false>
__device__ __forceinline__ void gemm_phase(PG8_LAS unsigned char* lds, const Gemm g_in, const Sched& S, const Epi& E, unsigned long long* stamps) {
    Gemm g = g_in;
    { unsigned long long v = (unsigned long long)g.A; g.A = (const bf16_t*)(((unsigned long long)(unsigned)__builtin_amdgcn_readfirstlane((int)(v >> 32)) << 32) | (unsigned)__builtin_amdgcn_readfirstlane((int)v));
      v = (unsigned long long)g.Bt; g.Bt = (const bf16_t*)(((unsigned long long)(unsigned)__builtin_amdgcn_readfirstlane((int)(v >> 32)) << 32) | (unsigned)__builtin_amdgcn_readfirstlane((int)v)); }
    const int tid = opaque_tid(), wid = __builtin_amdgcn_readfirstlane(tid >> 6), lane = tid & 63, wr = wid >> 2, wc = wid & 3, fr = lane & 15, fq = lane >> 4;
    int K = g.K; asm volatile("" : "+s"(K));
    const int nt = K / BK;
    int ts_lo = 0, ts_hi = 0, nts = 0; const unsigned long long rt_entry = STAMP ? (unsigned long long)wall_clock64() : 0ull;
#define PG8_STAMP() do { if (STAMP && wid == 0 && nts < 64) { const unsigned long long _c = (unsigned long long)clock64(); \
        ts_lo = (lane == nts) ? (int)(unsigned)_c : ts_lo; ts_hi = (lane == nts) ? (int)(unsigned)(_c >> 32) : ts_hi; ++nts; } } while (0)
    PG8_STAMP();
    unsigned voffA[2], voffB[2];
#pragma unroll
    for (int i = 0; i < 2; ++i) { int R, C; stage_rc(tid * 16 + i * 8192, R, C); const int Rb = Epi::PERM ? ((R & ~31) + perm32(R & 31)) : R;
        voffA[i] = (unsigned)(R * K + C) * 2u; voffB[i] = (unsigned)(Rb * K + C) * 2u; }
    const size_t kstep = (size_t)(BK * 2);
    const size_t hstep = (size_t)HALF * K * 2;
    const size_t tstep = 2 * hstep;
    const unsigned ldsw = (unsigned)wid * 1024u;
    const int aoff = lds_byte(wr * 64 + fr, fq * 8), boff = lds_byte(wc * 32 + fr, fq * 8);
#define PG8_SA(b, h) (((b) * 2 + (h)) * HTB)
#define PG8_SB(b, h) ((4 + (b) * 2 + (h)) * HTB)
#define PG8_STAGE(bufoff, gbase, voff) do { _Pragma("unroll") for (int _i = 0; _i < 2; ++_i) \
        __builtin_amdgcn_global_load_lds((const unsigned*)((const char*)(gbase) + (voff)[_i]), (PG8_LAS unsigned*)(lds + (bufoff) + ldsw + _i * 8192), 16, 0, 0); } while (0)
#define PG8_LDA(dst, b, h) do { _Pragma("unroll") for (int m = 0; m < 4; ++m) _Pragma("unroll") for (int k = 0; k < 2; ++k) dst[m][k] = *(const PG8_LAS bf16x8*)(lds + PG8_SA(b, h) + aoff + m * 2048 + k * 1024); } while (0)
#define PG8_LDB(dst, b, h) do { _Pragma("unroll") for (int n = 0; n < 2; ++n) _Pragma("unroll") for (int k = 0; k < 2; ++k) dst[n][k] = *(const PG8_LAS bf16x8*)(lds + PG8_SB(b, h) + boff + n * 2048 + k * 1024); } while (0)
#define PG8_MMA(ai, bj, At, Bt) do { __builtin_amdgcn_s_setprio(1); _Pragma("unroll") for (int m = 0; m < 4; ++m) _Pragma("unroll") for (int n = 0; n < 2; ++n) _Pragma("unroll") for (int k = 0; k < 2; ++k) \
        acc[ai][bj][m][n] = __builtin_amdgcn_mfma_f32_16x16x32_bf16(Bt[n][k], At[m][k], acc[ai][bj][m][n], 0, 0, 0); __builtin_amdgcn_s_setprio(0); } while (0)
#define PG8_WAIT_V(n) asm volatile("s_waitcnt vmcnt(" #n ")" ::: "memory")
#define PG8_WAIT_L(n) asm volatile("s_waitcnt lgkmcnt(" #n ")" ::: "memory")
#define PG8_BAR __builtin_amdgcn_s_barrier()
#define PG8_SCHED __builtin_amdgcn_sched_barrier(0)
    Unit cur, nxt; int ui = 0;
    if (!S.next(0, cur)) return;
    f32x4 acc[2][2][4][2];
#pragma unroll
    for (int a = 0; a < 2; ++a)
#pragma unroll
        for (int b = 0; b < 2; ++b)
#pragma unroll
            for (int m = 0; m < 4; ++m)
#pragma unroll
                for (int n = 0; n < 2; ++n) acc[a][b][m][n] = (f32x4){0.f, 0.f, 0.f, 0.f};
    bf16x8 At[4][2], B0[2][2], B1[2][2];
    const char* cA = (const char*)g.A + (size_t)cur.pm * tstep + (size_t)cur.g * g.gsA; const char* cB = (const char*)g.Bt + (size_t)cur.pn * tstep + (size_t)cur.g * g.gsB;
    S.a_ready(cur);
    PG8_STAGE(PG8_SB(0, 0), cB, voffB); PG8_STAGE(PG8_SA(0, 0), cA, voffA); PG8_STAGE(PG8_SB(0, 1), cB + hstep, voffB); PG8_STAGE(PG8_SA(0, 1), cA + hstep, voffA);
    if (wr == 1) PG8_BAR;
    PG8_WAIT_V(4); PG8_BAR;
    PG8_STAGE(PG8_SB(1, 0), cB + kstep, voffB); PG8_STAGE(PG8_SA(1, 0), cA + kstep, voffA); PG8_STAGE(PG8_SB(1, 1), cB + hstep + kstep, voffB);
    PG8_WAIT_V(6); PG8_BAR;
    PG8_STAMP();
    for (;;) {
        const bool has_next = S.next(ui + 1, nxt);
        const char* nA = has_next ? (const char*)g.A + (size_t)nxt.pm * tstep + (size_t)nxt.g * g.gsA : cA; const char* nB = has_next ? (const char*)g.Bt + (size_t)nxt.pn * tstep + (size_t)nxt.g * g.gsB : cB;
        for (int t = 0; t < nt; t += 2) {
            const bool last = (t == nt - 2);
            const char* a1 = cA + (size_t)(t + 1) * kstep;
            const char* a2 = last ? nA : cA + (size_t)(t + 2) * kstep; const char* b2 = last ? nB : cB + (size_t)(t + 2) * kstep;
            const char* a3 = a2 + kstep; const char* b3 = b2 + kstep;
            if (last && has_next) S.a_ready(nxt);
            PG8_LDB(B0, 0, 0); PG8_SCHED; PG8_LDA(At, 0, 0); PG8_STAGE(PG8_SA(1, 1), a1 + hstep, voffA);
            PG8_WAIT_L(8); PG8_BAR; PG8_WAIT_L(0); PG8_MMA(0, 0, At, B0); PG8_BAR; PG8_SCHED;
            PG8_LDB(B1, 0, 1); PG8_STAGE(PG8_SB(0, 0), b2, voffB);
            PG8_BAR; PG8_WAIT_L(0); PG8_MMA(0, 1, At, B1); PG8_BAR;
            PG8_LDA(At, 0, 1); PG8_STAGE(PG8_SA(0, 0), a2, voffA);
            PG8_BAR; PG8_WAIT_L(0); PG8_MMA(1, 0, At, B0); PG8_BAR; PG8_SCHED;
            PG8_STAGE(PG8_SB(0, 1), b2 + hstep, voffB);
            PG8_WAIT_V(6); PG8_BAR; PG8_MMA(1, 1, At, B1); PG8_BAR;
            PG8_LDB(B0, 1, 0); PG8_SCHED; PG8_LDA(At, 1, 0); PG8_STAGE(PG8_SA(0, 1), a2 + hstep, voffA);
            PG8_WAIT_L(8); PG8_BAR; PG8_WAIT_L(0); PG8_MMA(0, 0, At, B0); PG8_BAR; PG8_SCHED;
            PG8_LDB(B1, 1, 1); PG8_STAGE(PG8_SB(1, 0), b3, voffB);
            PG8_BAR; PG8_WAIT_L(0); PG8_MMA(0, 1, At, B1); PG8_BAR;
            PG8_LDA(At, 1, 1); PG8_STAGE(PG8_SA(1, 0), a3, voffA);
            PG8_BAR; PG8_WAIT_L(0); PG8_MMA(1, 0, At, B0); PG8_BAR; PG8_SCHED;
            PG8_STAGE(PG8_SB(1, 1), b3 + hstep, voffB);
            PG8_WAIT_V(6); PG8_BAR; PG8_MMA(1, 1, At, B1); PG8_BAR;
        }
        PG8_STAMP();
        if constexpr (!Epi::AFTER_DRAIN) { E(acc, cur, wr, wc, fr, fq); S.done(cur); }
        PG8_STAMP();
        if (!has_next) break;
#pragma unroll
        for (int a = 0; a < 2; ++a)
#pragma unroll
            for (int b = 0; b < 2; ++b)
#pragma unroll
                for (int m = 0; m < 4; ++m)
#pragma unroll
                    for (int n = 0; n < 2; ++n) acc[a][b][m][n] = (f32x4){0.f, 0.f, 0.f, 0.f};
        cur = nxt; cA = nA; cB = nB; ++ui;
    }
    PG8_WAIT_V(0);
    if (wr == 0) PG8_BAR;
    PG8_BAR;
    if constexpr (Epi::AFTER_DRAIN) { E.fused(acc, cur, wr, wc, fr, fq, lds, wid, lane); S.done(cur); }
    PG8_STAMP();
    if (STAMP && wid == 0) { stamps[lane] = lane < nts ? (((unsigned long long)(unsigned)ts_hi << 32) | (unsigned)ts_lo) : 0ull;
        if (lane == 62) stamps[62] = rt_entry; if (lane == 63) stamps[63] = (unsigned long long)wall_clock64(); }
#undef PG8_STAMP
#undef PG8_SA
#undef PG8_SB
#undef PG8_STAGE
#undef PG8_LDA
#undef PG8_LDB
#undef PG8_MMA
#undef PG8_WAIT_V
#undef PG8_WAIT_L
#undef PG8_BAR
#undef PG8_SCHED
}
}
using pg8::bf16_t; using pg8::bf16x8; using pg8::f32x4; using pg8::u32x4;
#define DI __device__ __forceinline__
typedef float f32x16 __attribute__((ext_vector_type(16)));
typedef float f32x2 __attribute__((ext_vector_type(2)));
typedef short s16x4 __attribute__((ext_vector_type(4)));
typedef unsigned u32x2 __attribute__((ext_vector_type(2)));
typedef __bf16 bfv2 __attribute__((ext_vector_type(2)));

constexpr int T = 16384, SEQ = 2048, DM = 1024, NIN = 12552, NU = 12544;
constexpr float EPS = 1e-6f, LOG2E = 1.4426950408889634f;
constexpr int U_QA = 0, U_KA = 512, U_VA = 1024, U_OA = 1536, U_ZA = 2048, U_XB = 2560, U_ZB = 3072, U_QC = 3584, U_KC = 4096, U_VC = 4224, U_ZC = 4352,
              U_QD = 4864, U_FD = 5376, U_ID = 5888, U_ZD = 6400, U_QE = 6912, U_ZE = 7168, U_G = 7424;
constexpr size_t WS_WIN = 0, SZ_WIN1 = (size_t)NU * 1024 * 2, SZ_WIN = 2 * SZ_WIN1;
constexpr size_t WS_WBR = WS_WIN + SZ_WIN, SZ_WBR = (size_t)4 * 2304 * 1024 * 2;
constexpr size_t WS_WOUT = WS_WBR + SZ_WBR, SZ_WOUT = (size_t)4 * 1024 * 1024 * 2;
constexpr size_t WS_KVM = WS_WOUT + SZ_WOUT, SZ_KVM = (size_t)2048 * 2048 * 2;
constexpr size_t WS_H = WS_KVM + SZ_KVM, SZ_H = (size_t)T * 1024 * 2;
constexpr size_t WS_IF = WS_H + SZ_H, SZ_IF = (size_t)T * 8 * 4;
constexpr size_t WS_LB = WS_IF + SZ_IF, SZ_LB = 4 * 512 * 4;
constexpr size_t WS_NA = WS_LB + SZ_LB, SZ_NA = 512 * 128 * 4;
constexpr size_t WS_GA = WS_NA + SZ_NA, SZ_GA = 512 * 4;
constexpr size_t WS_DECD = WS_GA + SZ_GA, SZ_DECD = 1024 * 128 * 4;
constexpr size_t WS_CARB = WS_DECD + SZ_DECD, SZ_CARB = 256 * 512 * 4;
constexpr size_t WS_U = WS_CARB + SZ_CARB, SZ_U = (size_t)T * NU * 2;
constexpr size_t WS_MEMN = WS_U, WS_WMEM = WS_U + (size_t)2048 * 1024 * 2;
constexpr size_t WS_YS = WS_U + SZ_U;
constexpr size_t WS_YA = WS_YS, WS_YB = WS_YA + (size_t)T * 512 * 2, WS_YC = WS_YB + (size_t)T * 512 * 2, WS_YD = WS_YC + (size_t)T * 512 * 2, WS_YE = WS_YD + (size_t)T * 512 * 2;
constexpr size_t WS_ST = WS_YE + (size_t)T * 256 * 2;
constexpr size_t WS_STA = WS_ST, WS_STD = WS_STA + (size_t)512 * 16384 * 4, WS_LRUH = WS_STD + (size_t)1024 * 16384 * 4, WS_LRUA = WS_LRUH + (size_t)T * 512 * 4;
constexpr size_t WS_YF = WS_ST;
constexpr size_t WS_BAR = WS_LRUA + (size_t)T * 512 * 4;
constexpr size_t WS_END = WS_BAR + 16384;
constexpr int LDS_BYTES = 155648;

struct Params {
    const float* x; const float* mem; const int* pos; const float* norm_g; const float* w_in; const float* mconv_w; const float* b_if; const float* mnorm_g;
    const float* lconv_w; const float* lconv_b; const float* wa; const float* ba; const float* wx; const float* bx; const float* lam; const float* sinks;
    const float* hlb; const float* hnorm_g; const float* mem_g; const float* w_mem; const float* w_br; const float* w_out; const float* fin_g;
    float* out; unsigned char* ws;
};

DI float bf2f(bf16_t b) { return __uint_as_float(((unsigned)b) << 16); }
DI float bflo(unsigned v) { return __uint_as_float(v << 16); }
DI float bfhi(unsigned v) { return __uint_as_float(v & 0xffff0000u); }
DI unsigned pack2(float lo, float hi) { f32x2 v = {lo, hi}; bfv2 b = __builtin_convertvector(v, bfv2); return __builtin_bit_cast(unsigned, b); }
DI bf16_t f2bf(float f) { return (bf16_t)(pack2(f, 0.f) & 0xffffu); }
DI float fexp_(float x) { return __builtin_amdgcn_exp2f(x * LOG2E); }
DI float sigmoidf_(float x) { return __builtin_amdgcn_rcpf(1.0f + fexp_(-x)); }
DI float siluf_(float x) { return x * sigmoidf_(x); }
DI float logsigf_(float x) { return fminf(x, 0.f) - log1pf(fexp_(-fabsf(x))); }
DI float wave_sum(float v) {
    int x = __float_as_int(v);
    x = __float_as_int(__int_as_float(x) + __int_as_float(__builtin_amdgcn_update_dpp(0, x, 0x128, 0xf, 0xf, false)));
    x = __float_as_int(__int_as_float(x) + __int_as_float(__builtin_amdgcn_update_dpp(0, x, 0x124, 0xf, 0xf, false)));
    x = __float_as_int(__int_as_float(x) + __int_as_float(__builtin_amdgcn_update_dpp(0, x, 0x122, 0xf, 0xf, false)));
    x = __float_as_int(__int_as_float(x) + __int_as_float(__builtin_amdgcn_update_dpp(0, x, 0x121, 0xf, 0xf, false)));
    const float r0 = __int_as_float(__builtin_amdgcn_readlane(x, 0)), r1 = __int_as_float(__builtin_amdgcn_readlane(x, 16)), r2 = __int_as_float(__builtin_amdgcn_readlane(x, 32)), r3 = __int_as_float(__builtin_amdgcn_readlane(x, 48));
    return (r0 + r1) + (r2 + r3);
}
DI int crow(int i, int h) { return (i & 3) + 8 * (i >> 2) + 4 * h; }

template <int MT, int NT> DI void mma_lds(f32x16 (&acc)[MT][NT], const bf16_t* A, int lda, const bf16_t* B, int ldb, int K, int lane) {
    const int r = lane & 31, h = lane >> 5;
    for (int k0 = 0; k0 < K; k0 += 16) {
        bf16x8 a[MT], b[NT];
#pragma unroll
        for (int mt = 0; mt < MT; ++mt) a[mt] = *(const bf16x8*)(A + (32 * mt + r) * lda + k0 + 8 * h);
#pragma unroll
        for (int nt = 0; nt < NT; ++nt) b[nt] = *(const bf16x8*)(B + (32 * nt + r) * ldb + k0 + 8 * h);
#pragma unroll
        for (int mt = 0; mt < MT; ++mt)
#pragma unroll
            for (int nt = 0; nt < NT; ++nt) acc[mt][nt] = __builtin_amdgcn_mfma_f32_32x32x16_bf16(a[mt], b[nt], acc[mt][nt], 0, 0, 0);
    }
}
template <int MT, int NT> DI void zero_acc(f32x16 (&acc)[MT][NT]) {
#pragma unroll
    for (int mt = 0; mt < MT; ++mt)
#pragma unroll
        for (int nt = 0; nt < NT; ++nt)
#pragma unroll
            for (int i = 0; i < 16; ++i) acc[mt][nt][i] = 0.f;
}

struct EpiStoreBf16 {
    static constexpr bool PERM = true, AFTER_DRAIN = false;
    bf16_t* O; int ldc;
    DI void operator()(const f32x4 (&acc)[2][2][4][2], const pg8::Unit& u, int wr, int wc, int fr, int fq) const {
        const int row0 = u.pm * 256 + wr * 64 + fr, col0 = u.pn * 256 + wc * 32 + 8 * fq;
#pragma unroll
        for (int ai = 0; ai < 2; ++ai)
#pragma unroll
            for (int m = 0; m < 4; ++m) { bf16_t* rowp = O + (size_t)(row0 + ai * 128 + m * 16) * ldc + col0;
#pragma unroll
                for (int bj = 0; bj < 2; ++bj) { const f32x4 v0 = acc[ai][bj][m][0], v1 = acc[ai][bj][m][1];
                    u32x4 w; w.x = pack2(v0[0], v0[1]); w.y = pack2(v0[2], v0[3]); w.z = pack2(v1[0], v1[1]); w.w = pack2(v1[2], v1[3]);
                    __builtin_nontemporal_store(w, (u32x4*)(rowp + bj * 128)); } }
    }
};
struct EpiRes {
    static constexpr bool PERM = false, AFTER_DRAIN = false;
    const float* xres; float* out;
    DI void operator()(const f32x4 (&acc)[2][2][4][2], const pg8::Unit& u, int wr, int wc, int fr, int fq) const {
        const int row0 = u.pm * 256 + wr * 64 + fr, col0 = u.pn * 256 + wc * 32 + 4 * fq;
#pragma unroll
        for (int am = 0; am < 4; ++am) { const int ai = am >> 1, m0 = (am & 1) * 2; f32x4 xv[2][2][2];
#pragma unroll
            for (int mm = 0; mm < 2; ++mm) { const size_t r = (size_t)(row0 + ai * 128 + (m0 + mm) * 16);
#pragma unroll
                for (int bj = 0; bj < 2; ++bj)
#pragma unroll
                    for (int n = 0; n < 2; ++n) xv[mm][bj][n] = *(const f32x4*)(xres + r * 1024 + col0 + bj * 128 + n * 16); }
            __builtin_amdgcn_sched_barrier(0);
#pragma unroll
            for (int mm = 0; mm < 2; ++mm) { const size_t r = (size_t)(row0 + ai * 128 + (m0 + mm) * 16);
#pragma unroll
                for (int bj = 0; bj < 2; ++bj)
#pragma unroll
                    for (int n = 0; n < 2; ++n) *(f32x4*)(out + r * 1024 + col0 + bj * 128 + n * 16) = xv[mm][bj][n] + acc[ai][bj][m0 + mm][n]; }
            __builtin_amdgcn_sched_barrier(0); }
    }
};
struct GroupOrder {
    int G, c;
    __device__ bool next(int i, pg8::Unit& u) const { const int tile = c + (i >> 2) * G; if (tile >= 256) return false; pg8::StaticOrder t; t.init(T, 1024, 256, tile); t.next(0, u); u.g = i & 3; return true; }
    DI void a_ready(const pg8::Unit&) const {}
    DI void done(const pg8::Unit&) const {}
};
struct EpiGateAcc {
    static constexpr bool PERM = true, AFTER_DRAIN = false;
    const bf16_t* gates; bf16_t* P; bf16_t* Y16; int goff;
    DI void operator()(const f32x4 (&acc)[2][2][4][2], const pg8::Unit& u, int wr, int wc, int fr, int fq) const {
        const int row0 = u.pm * 256 + wr * 64 + fr, col0 = u.pn * 256 + wc * 32 + 8 * fq, j = u.g + goff;
        const bf16_t* gp = gates + j * 1024 + col0; bf16_t* dst = ((j == 4) ? Y16 : P) + col0; const bf16_t* pp = P + col0;
#pragma unroll
        for (int am = 0; am < 4; ++am) { const int ai = am >> 1, m0 = (am & 1) * 2;
            u32x4 gv[4][2], pv[4][2];
#pragma unroll
            for (int m = m0; m < m0 + 2; ++m) { const size_t r = (size_t)(row0 + ai * 128 + m * 16);
#pragma unroll
                for (int bj = 0; bj < 2; ++bj) { gv[m][bj] = *(const u32x4*)(gp + r * NU + bj * 128); pv[m][bj] = (u32x4){0u, 0u, 0u, 0u}; if (j > 0) pv[m][bj] = *(const u32x4*)(pp + r * 1024 + bj * 128); } }
            __builtin_amdgcn_sched_barrier(0);
#pragma unroll
            for (int m = m0; m < m0 + 2; ++m) { const size_t r = (size_t)(row0 + ai * 128 + m * 16);
#pragma unroll
                for (int bj = 0; bj < 2; ++bj) { const u32x4 g4 = gv[m][bj], p4 = pv[m][bj]; const f32x4 a0 = acc[ai][bj][m][0], a1 = acc[ai][bj][m][1]; float o[8];
                    o[0] = a0[0] * sigmoidf_(bflo(g4.x)) + bflo(p4.x); o[1] = a0[1] * sigmoidf_(bfhi(g4.x)) + bfhi(p4.x); o[2] = a0[2] * sigmoidf_(bflo(g4.y)) + bflo(p4.y); o[3] = a0[3] * sigmoidf_(bfhi(g4.y)) + bfhi(p4.y);
                    o[4] = a1[0] * sigmoidf_(bflo(g4.z)) + bflo(p4.z); o[5] = a1[1] * sigmoidf_(bfhi(g4.z)) + bfhi(p4.z); o[6] = a1[2] * sigmoidf_(bflo(g4.w)) + bflo(p4.w); o[7] = a1[3] * sigmoidf_(bfhi(g4.w)) + bfhi(p4.w);
                    u32x4 w; w.x = pack2(o[0], o[1]); w.y = pack2(o[2], o[3]); w.z = pack2(o[4], o[5]); w.w = pack2(o[6], o[7]); *(u32x4*)(dst + r * 1024 + bj * 128) = w; } }
            __builtin_amdgcn_sched_barrier(0);
        }
    }
};
DI void conv_tile(const float* src, int ld_src, int gap_at, int gap_len, const float* scale, bf16_t* dst, int K, int n0, int k0, unsigned char* sm) {
    bf16_t* tl = (bf16_t*)sm;
    const int tid = opaque_tid();
    float vld[16];
#pragma unroll
    for (int i = 0; i < 16; ++i) { const int idx = i * 512 + tid, kk = idx >> 7, nn = idx & 127, n = n0 + nn, col = n + (n >= gap_at ? gap_len : 0);
        vld[i] = src[(size_t)(k0 + kk) * ld_src + col]; }
#pragma unroll
    for (int i = 0; i < 16; ++i) { const int idx = i * 512 + tid, kk = idx >> 7, nn = idx & 127;
        float v = vld[i]; if (scale) v *= scale[k0 + kk];
        tl[nn * 72 + kk] = f2bf(v); }
    __syncthreads();
#pragma unroll
    for (int i = 0; i < 2; ++i) { const int idx = i * 512 + tid, nn = idx >> 3, kc = idx & 7;
        *(u32x4*)(dst + (size_t)(n0 + nn) * K + k0 + kc * 8) = *(const u32x4*)(tl + nn * 72 + kc * 8); }
    __syncthreads();
}
DI void phase_prologue(const Params& p, unsigned char* sm) {
    const int tid = opaque_tid(), wid = tid >> 6, lane = tid & 63;
    bf16_t* WBR = (bf16_t*)(p.ws + WS_WBR); bf16_t* WOUT = (bf16_t*)(p.ws + WS_WOUT); bf16_t* WMEM = (bf16_t*)(p.ws + WS_WMEM); bf16_t* MEMN = (bf16_t*)(p.ws + WS_MEMN);
    for (int t = blockIdx.x; t < 4 * 480; t += gridDim.x) {
        const int l = t / 480, r = t % 480;
        if (r < 288) { int j, tt, Kj; if (r < 256) { j = r >> 6; tt = r & 63; Kj = 512; } else { j = 4; tt = r - 256; Kj = 256; }
            const int nkt = Kj / 64, nt = tt / nkt, kt = tt % nkt; const size_t off = (size_t)l * 2304 * 1024 + (size_t)j * 512 * 1024;
            conv_tile(p.w_br + off, 1024, 1 << 30, 0, nullptr, WBR + off, Kj, nt * 128, kt * 64, sm); }
        else if (r < 416) { const int tt = r - 288, nt = tt >> 4, kt = tt & 15; const size_t off = (size_t)l * 1024 * 1024;
            conv_tile(p.w_out + off, 1024, 1 << 30, 0, nullptr, WOUT + off, 1024, nt * 128, kt * 64, sm); }
        else { const int tt = r - 416, nt = tt >> 4, kt = tt & 15;
            conv_tile(p.w_mem + (size_t)l * 1024 * 512, 512, 1 << 30, 0, p.mem_g + l * 1024, WMEM + (size_t)l * 512 * 1024, 1024, nt * 128, kt * 64, sm); }
    }
    for (int row = blockIdx.x * 8 + wid; row < 2048; row += gridDim.x * 8) {
        const float* xr = p.mem + (size_t)row * 1024; f32x4 v[4]; float ss = 0.f;
#pragma unroll
        for (int i = 0; i < 4; ++i) { v[i] = *(const f32x4*)(xr + i * 256 + lane * 4); ss += v[i][0] * v[i][0] + v[i][1] * v[i][1] + v[i][2] * v[i][2] + v[i][3] * v[i][3]; }
        ss = wave_sum(ss); const float rs = rsqrtf(ss * (1.0f / 1024.0f) + EPS);
#pragma unroll
        for (int i = 0; i < 4; ++i) { u32x2 w; w.x = pack2(v[i][0] * rs, v[i][1] * rs); w.y = pack2(v[i][2] * rs, v[i][3] * rs); *(u32x2*)(MEMN + (size_t)row * 1024 + i * 256 + lane * 4) = w; }
    }
    if (blockIdx.x == 0) { float* LB = (float*)(p.ws + WS_LB); const int ch = tid;
        const float v0 = p.hlb[ch], v1 = p.hlb[512 + ch], v2 = p.hlb[1024 + ch], v3 = p.hlb[1536 + ch];
        const float mx = fmaxf(fmaxf(v0, v1), fmaxf(v2, v3)); const float e0 = expf(v0 - mx), e1 = expf(v1 - mx), e2 = expf(v2 - mx), e3 = expf(v3 - mx); const float inv = 1.0f / (e0 + e1 + e2 + e3);
        LB[ch] = 0.f; LB[512 + ch] = e1 * inv; LB[1024 + ch] = (e1 + e2) * inv; LB[1536 + ch] = (e1 + e2 + e3) * inv; }
}
DI void convert_win(const Params& p, int l, int first, int stride, unsigned char* sm) {
    bf16_t* WIN = (bf16_t*)(p.ws + WS_WIN + (size_t)(l & 1) * SZ_WIN1); const float* wl = p.w_in + (size_t)l * 1024 * NIN;
    for (int t = first; t < 98 * 16; t += stride) conv_tile(wl, NIN, 2560, 8, nullptr, WIN, 1024, (t >> 4) * 128, (t & 15) * 64, sm);
}
DI void phase_norm(const Params& p, int l, const float* xin, unsigned char* sm) {
    const int tid = opaque_tid(), wid = tid >> 6, lane = tid & 63;
    const float* wl = p.w_in + (size_t)l * 1024 * NIN;
    float* wif = (float*)sm;
    for (int i = tid; i < 8192; i += 512) wif[i] = wl[(size_t)(i >> 3) * NIN + 2560 + (i & 7)];
    __syncthreads();
    bf16_t* H = (bf16_t*)(p.ws + WS_H); float* IFp = (float*)(p.ws + WS_IF); const float* g = p.norm_g + l * 1024;
    f32x4 vn[4];
    { const int tok = blockIdx.x * 8 + wid; if (tok < T) {
#pragma unroll
        for (int i = 0; i < 4; ++i) vn[i] = *(const f32x4*)(xin + (size_t)tok * 1024 + i * 256 + lane * 4); } }
    for (int tok = blockIdx.x * 8 + wid; tok < T; tok += gridDim.x * 8) {
        f32x4 v[4]; float ss = 0.f;
#pragma unroll
        for (int i = 0; i < 4; ++i) { v[i] = vn[i]; ss += v[i][0] * v[i][0] + v[i][1] * v[i][1] + v[i][2] * v[i][2] + v[i][3] * v[i][3]; }
        { const int tn = tok + gridDim.x * 8; if (tn < T) {
#pragma unroll
            for (int i = 0; i < 4; ++i) vn[i] = *(const f32x4*)(xin + (size_t)tn * 1024 + i * 256 + lane * 4); } }
        ss = wave_sum(ss); const float rs = rsqrtf(ss * (1.0f / 1024.0f) + EPS);
        float d0 = 0.f, d1 = 0.f, d2 = 0.f, d3 = 0.f, d4 = 0.f, d5 = 0.f, d6 = 0.f, d7 = 0.f;
#pragma unroll
        for (int i = 0; i < 4; ++i) { const int c0 = i * 256 + lane * 4; const f32x4 gv = *(const f32x4*)(g + c0); f32x4 hv;
#pragma unroll
            for (int j = 0; j < 4; ++j) { hv[j] = v[i][j] * rs * gv[j]; const f32x4 wa_ = *(const f32x4*)(wif + (c0 + j) * 8), wb_ = *(const f32x4*)(wif + (c0 + j) * 8 + 4);
                d0 += hv[j] * wa_[0]; d1 += hv[j] * wa_[1]; d2 += hv[j] * wa_[2]; d3 += hv[j] * wa_[3]; d4 += hv[j] * wb_[0]; d5 += hv[j] * wb_[1]; d6 += hv[j] * wb_[2]; d7 += hv[j] * wb_[3]; }
            u32x2 w; w.x = pack2(hv[0], hv[1]); w.y = pack2(hv[2], hv[3]); *(u32x2*)(H + (size_t)tok * 1024 + c0) = w; }
        d0 = wave_sum(d0); d1 = wave_sum(d1); d2 = wave_sum(d2); d3 = wave_sum(d3); d4 = wave_sum(d4); d5 = wave_sum(d5); d6 = wave_sum(d6); d7 = wave_sum(d7);
        if (lane == 0) { f32x4 a = {d0, d1, d2, d3}, b = {d4, d5, d6, d7}; *(f32x4*)(IFp + (size_t)tok * 8) = a; *(f32x4*)(IFp + (size_t)tok * 8 + 4) = b; }
    }
    __syncthreads();
}
DI void phase_final_norm(const Params& p) {
    const int tid = opaque_tid(), wid = tid >> 6, lane = tid & 63;
    for (int tok = blockIdx.x * 8 + wid; tok < T; tok += gridDim.x * 8) {
        float* xr = p.out + (size_t)tok * 1024; f32x4 v[4]; float ss = 0.f;
#pragma unroll
        for (int i = 0; i < 4; ++i) { v[i] = *(const f32x4*)(xr + i * 256 + lane * 4); ss += v[i][0] * v[i][0] + v[i][1] * v[i][1] + v[i][2] * v[i][2] + v[i][3] * v[i][3]; }
        ss = wave_sum(ss); const float rs = rsqrtf(ss * (1.0f / 1024.0f) + EPS);
#pragma unroll
        for (int i = 0; i < 4; ++i) { const f32x4 gv = *(const f32x4*)(p.fin_g + i * 256 + lane * 4); f32x4 o = v[i] * rs * gv; *(f32x4*)(xr + i * 256 + lane * 4) = o; }
    }
}
template <int R> DI void transpose_pairs(const unsigned* N, int ldn, bf16_t* Tt, int ldt, int tid) {
    constexpr int CPT = 64 * R / 512; const int r = tid & (R - 1), cq = tid / R;
#pragma unroll
    for (int i = 0; i < CPT; ++i) { const int c = cq * CPT + i; const unsigned w = N[r * ldn + c]; Tt[(2 * c) * ldt + r] = (bf16_t)(w & 0xffffu); Tt[(2 * c + 1) * ldt + r] = (bf16_t)(w >> 16); }
}
DI void mlstm_gates(const Params& p, int l, int h, int tok0, float* sg, float* sig, float* stmp) {
    const int tid = opaque_tid(); const float* IFp = (const float*)(p.ws + WS_IF);
    float lf = 0.f;
    if (tid < 128) { const size_t tok = (size_t)(tok0 + tid);
        sig[tid] = IFp[tok * 8 + h] + p.b_if[l * 8 + h];
        lf = logsigf_(IFp[tok * 8 + 4 + h] + p.b_if[l * 8 + 4 + h]);
#pragma unroll
        for (int o = 1; o < 64; o <<= 1) { const float n = __shfl_up(lf, o); if ((tid & 63) >= o) lf += n; }
        if (tid == 63) stmp[0] = lf; }
    __syncthreads();
    if (tid < 128) { if (tid >= 64) lf += stmp[0]; sg[tid] = lf; }
    __syncthreads();
}
DI void load_win19(const bf16_t* U, int b, int tseq0, int ch, unsigned (&xs)[19]) {
    const bf16_t* ptr = U + ((size_t)(b * SEQ + tseq0) * NU + ch);
    const bool has_prev = tseq0 >= 3;
    xs[0] = 0u; xs[1] = 0u; xs[2] = 0u;
    if (has_prev) { xs[0] = *(const unsigned*)(ptr - 3 * (size_t)NU); xs[1] = *(const unsigned*)(ptr - 2 * (size_t)NU); xs[2] = *(const unsigned*)(ptr - (size_t)NU); }
#pragma unroll
    for (int m = 3; m < 19; ++m) xs[m] = *(const unsigned*)(ptr + (size_t)(m - 3) * NU);
}
DI void conv_win(const unsigned (&xs)[19], int i, const float (&w0)[4], const float (&w1)[4], float& y0, float& y1) {
    float a0 = 0.f, a1 = 0.f;
#pragma unroll
    for (int k = 0; k < 4; ++k) { a0 += w0[k] * bflo(xs[i + k]); a1 += w1[k] * bfhi(xs[i + k]); }
    y0 = siluf_(a0); y1 = siluf_(a1);
}
DI void mlstm_local_unit(const Params& p, int l, int ua, unsigned char* sm) {
    const int tid = opaque_tid(), wid = tid >> 6, lane = tid & 63;
    const int bh = ua >> 4, c = ua & 15, b = bh >> 2, h = bh & 3, tok0 = b * SEQ + c * 128;
    float* sg = (float*)sm; float* sig = sg + 128; float* stmp = sg + 256;
    bf16_t* KwT = (bf16_t*)(sm + 2048); bf16_t* VT = (bf16_t*)(sm + 2048 + 34816);
    const bf16_t* U = (const bf16_t*)(p.ws + WS_U);
    unsigned* N1 = (unsigned*)(sm + 71680); unsigned* N2 = (unsigned*)(sm + 104960);
    { const int dp = tid & 63, d = 2 * dp, ch = 512 + h * 128 + d; float w0[4], w1[4];
#pragma unroll
      for (int k = 0; k < 4; ++k) { w0[k] = p.mconv_w[(size_t)l * 4096 + k * 1024 + ch]; w1[k] = p.mconv_w[(size_t)l * 4096 + k * 1024 + ch + 1]; }
      unsigned xs[19]; load_win19(U, b, c * 128 + 16 * wid, ch, xs);
      unsigned vv[16];
#pragma unroll
      for (int i = 0; i < 16; ++i) vv[i] = *(const unsigned*)(U + (size_t)(tok0 + 16 * wid + i) * NU + U_VA + h * 128 + d);
      mlstm_gates(p, l, h, tok0, sg, sig, stmp);
      const float G_ = sg[127];
#pragma unroll
      for (int i = 0; i < 16; ++i) { const int r = 16 * wid + i; float y0, y1; conv_win(xs, i, w0, w1, y0, y1);
          const float wr_ = fexp_(G_ - sg[r] + sig[r]);
          N1[r * 65 + dp] = pack2(y0 * wr_, y1 * wr_); N2[r * 65 + dp] = vv[i]; } }
    const float G = sg[127];
    __syncthreads();
    transpose_pairs<128>(N1, 65, KwT, 136, tid); transpose_pairs<128>(N2, 65, VT, 136, tid);
    __syncthreads();
    f32x16 acc[1][2]; zero_acc<1, 2>(acc);
    const int dt = wid & 3, eh = wid >> 2;
    mma_lds<1, 2>(acc, KwT + 32 * dt * 136, 136, VT + 64 * eh * 136, 136, 128, lane);
    bf16_t* ST = (bf16_t*)(p.ws + WS_STA) + (size_t)ua * 16384;
    { const int r31 = lane & 31, hh = lane >> 5;
#pragma unroll
      for (int nt = 0; nt < 2; ++nt) { const int e = 64 * eh + 32 * nt + r31;
#pragma unroll
          for (int q4 = 0; q4 < 4; ++q4) { const int d0 = 32 * dt + 8 * q4 + 4 * hh; f32x4 v = {acc[0][nt][4 * q4], acc[0][nt][4 * q4 + 1], acc[0][nt][4 * q4 + 2], acc[0][nt][4 * q4 + 3]};
              u32x2 w; w.x = pack2(v[0], v[1]); w.y = pack2(v[2], v[3]); *(u32x2*)(ST + e * 128 + d0) = w; } } }
    { const int d = tid >> 2, qd = tid & 3; float s = 0.f;
#pragma unroll
      for (int i = 0; i < 4; ++i) { const u32x4 v = *(const u32x4*)(KwT + d * 136 + 32 * qd + 8 * i); s += bflo(v.x) + bfhi(v.x) + bflo(v.y) + bfhi(v.y) + bflo(v.z) + bfhi(v.z) + bflo(v.w) + bfhi(v.w); }
      s += __shfl_xor(s, 1); s += __shfl_xor(s, 2);
      if (qd == 0) ((float*)(p.ws + WS_NA))[ua * 128 + d] = s; }
    if (tid == 0) ((float*)(p.ws + WS_GA))[ua] = G;
    __syncthreads();
}
DI void mlstm_scan(const Params& p) {
    const int gt = blockIdx.x * 512 + opaque_tid(), nth = gridDim.x * 512; const float* GA = (const float*)(p.ws + WS_GA);
    for (int it = gt; it < 32 * 4096; it += nth) { const int bh = it >> 12, v = it & 4095; u32x2* base = (u32x2*)((bf16_t*)(p.ws + WS_STA) + (size_t)bh * 16 * 16384) + v;
        u32x2 tmp[16]; float eg[16];
#pragma unroll
        for (int c = 0; c < 16; ++c) { tmp[c] = base[(size_t)c * 4096]; eg[c] = fexp_(GA[bh * 16 + c]); }
        f32x4 S = {0.f, 0.f, 0.f, 0.f};
#pragma unroll
        for (int c = 0; c < 16; ++c) { u32x2 w; w.x = pack2(S[0], S[1]); w.y = pack2(S[2], S[3]); base[(size_t)c * 4096] = w;
            const f32x4 t = {bflo(tmp[c].x), bfhi(tmp[c].x), bflo(tmp[c].y), bfhi(tmp[c].y)}; S = S * eg[c] + t; } }
    for (int it = gt; it < 32 * 32; it += nth) { const int bh = it >> 5, v = it & 31; f32x4* base = (f32x4*)((float*)(p.ws + WS_NA) + (size_t)bh * 16 * 128) + v;
        f32x4 tmp[16]; float eg[16];
#pragma unroll
        for (int c = 0; c < 16; ++c) { tmp[c] = base[c * 32]; eg[c] = fexp_(GA[bh * 16 + c]); }
        f32x4 S = {0.f, 0.f, 0.f, 0.f};
#pragma unroll
        for (int c = 0; c < 16; ++c) { base[c * 32] = S; S = S * eg[c] + tmp[c]; } }
}
DI void mlstm_out_unit(const Params& p, int l, int ua, unsigned char* sm) {
    const int tid = opaque_tid(), wid = tid >> 6, lane = tid & 63, r31 = lane & 31, hh = lane >> 5;
    const int bh = ua >> 4, c = ua & 15, b = bh >> 2, h = bh & 3, tok0 = b * SEQ + c * 128;
    float* sg = (float*)sm; float* sig = sg + 128; float* sden = sg + 256; float* snp = sg + 384;
    bf16_t* Q = (bf16_t*)(sm + 2048); bf16_t* KP = (bf16_t*)(sm + 36864); bf16_t* VT = (bf16_t*)(sm + 71680); bf16_t* STs = (bf16_t*)(sm + 106496);
    float* Hs = (float*)(sm + 2048);
    const bf16_t* U = (const bf16_t*)(p.ws + WS_U);
    unsigned* N2 = (unsigned*)(sm + 106496);
    unsigned fov[16], fzv[16];
#pragma unroll
    for (int jj = 0; jj < 16; ++jj) { const size_t tk = (size_t)(tok0 + wid * 16 + jj); fov[jj] = *(const unsigned*)(U + tk * NU + U_OA + h * 128 + 2 * lane); fzv[jj] = *(const unsigned*)(U + tk * NU + U_ZA + h * 128 + 2 * lane); }
    u32x4 stv[4];
    { const bf16_t* ST = (const bf16_t*)(p.ws + WS_STA) + (size_t)ua * 16384;
#pragma unroll
      for (int i = 0; i < 4; ++i) { const int idx = i * 512 + tid, e = idx >> 4, d8 = (idx & 15) * 8; stv[i] = *(const u32x4*)(ST + e * 128 + d8); } }
    { const int dp = tid & 63, d = 2 * dp, chq = h * 128 + d, chk = 512 + chq; float wq0[4], wq1[4], wk0[4], wk1[4];
#pragma unroll
      for (int k = 0; k < 4; ++k) { wq0[k] = p.mconv_w[(size_t)l * 4096 + k * 1024 + chq]; wq1[k] = p.mconv_w[(size_t)l * 4096 + k * 1024 + chq + 1];
                                    wk0[k] = p.mconv_w[(size_t)l * 4096 + k * 1024 + chk]; wk1[k] = p.mconv_w[(size_t)l * 4096 + k * 1024 + chk + 1]; }
      unsigned xq[19], xk[19]; load_win19(U, b, c * 128 + 16 * wid, chq, xq); load_win19(U, b, c * 128 + 16 * wid, chk, xk);
      unsigned vv[16];
#pragma unroll
      for (int i = 0; i < 16; ++i) vv[i] = *(const unsigned*)(U + (size_t)(tok0 + 16 * wid + i) * NU + U_VA + h * 128 + d);
      mlstm_gates(p, l, h, tok0, sg, sig, sden);
      __builtin_amdgcn_sched_barrier(0);
#pragma unroll
      for (int i = 0; i < 16; ++i) { const int r = 16 * wid + i; float y0, y1;
          conv_win(xq, i, wq0, wq1, y0, y1); *(unsigned*)(Q + r * 136 + d) = pack2(y0 * 0.08838834764831845f, y1 * 0.08838834764831845f);
          if ((i & 3) == 3) __builtin_amdgcn_sched_barrier(0); }
#pragma unroll
      for (int i = 0; i < 16; ++i) { const int r = 16 * wid + i; float y0, y1;
          conv_win(xk, i, wk0, wk1, y0, y1); *(unsigned*)(KP + r * 136 + d) = pack2(y0, y1);
          if ((i & 3) == 3) __builtin_amdgcn_sched_barrier(0); }
#pragma unroll
      for (int i = 0; i < 16; ++i) N2[(16 * wid + i) * 65 + dp] = vv[i];
      __builtin_amdgcn_sched_barrier(0); }
    if (tid < 128) snp[tid] = ((const float*)(p.ws + WS_NA))[ua * 128 + tid];
    __syncthreads();
    const int jt = wid & 3, ch2 = wid >> 2;
    f32x16 acc[1][2]; zero_acc<1, 2>(acc);
    mma_lds<1, 2>(acc, Q + 32 * jt * 136, 136, KP + 64 * ch2 * 136, 136, 128, lane);
    transpose_pairs<128>(N2, 65, VT, 136, tid);
    __syncthreads();
#pragma unroll
    for (int i = 0; i < 4; ++i) { const int idx = i * 512 + tid, e = idx >> 4, d8 = (idx & 15) * 8; *(u32x4*)(STs + e * 136 + d8) = stv[i]; }
#pragma unroll
    for (int nt = 0; nt < 2; ++nt) { const int r = 64 * ch2 + 32 * nt + r31; const float gr = sg[r], ir = sig[r];
#pragma unroll
        for (int i = 0; i < 16; ++i) { const int j = 32 * jt + crow(i, hh); const float val = (r <= j) ? acc[0][nt][i] * fexp_(sg[j] - gr + ir) : 0.f; KP[j * 136 + r] = f2bf(val); } }
    __syncthreads();
    f32x16 apv[1][2], aqs[1][2]; zero_acc<1, 2>(apv); zero_acc<1, 2>(aqs);
    mma_lds<1, 2>(apv, KP + 32 * jt * 136, 136, VT + 64 * ch2 * 136, 136, 128, lane);
    mma_lds<1, 2>(aqs, Q + 32 * jt * 136, 136, STs + 64 * ch2 * 136, 136, 128, lane);
    { const int j = tid >> 2, qd = tid & 3; float s1 = 0.f, s2 = 0.f;
#pragma unroll
      for (int i = 0; i < 4; ++i) { const u32x4 pv = *(const u32x4*)(KP + j * 136 + 32 * qd + 8 * i), qv = *(const u32x4*)(Q + j * 136 + 32 * qd + 8 * i);
          const f32x4 n0 = *(const f32x4*)(snp + 32 * qd + 8 * i), n1 = *(const f32x4*)(snp + 32 * qd + 8 * i + 4);
          s1 += bflo(pv.x) + bfhi(pv.x) + bflo(pv.y) + bfhi(pv.y) + bflo(pv.z) + bfhi(pv.z) + bflo(pv.w) + bfhi(pv.w);
          s2 += bflo(qv.x) * n0[0] + bfhi(qv.x) * n0[1] + bflo(qv.y) * n0[2] + bfhi(qv.y) * n0[3] + bflo(qv.z) * n1[0] + bfhi(qv.z) * n1[1] + bflo(qv.w) * n1[2] + bfhi(qv.w) * n1[3]; }
      s1 += __shfl_xor(s1, 1); s1 += __shfl_xor(s1, 2); s2 += __shfl_xor(s2, 1); s2 += __shfl_xor(s2, 2);
      if (qd == 0) sden[j] = s1 + fexp_(sg[j]) * s2; }
    __syncthreads();
#pragma unroll
    for (int nt = 0; nt < 2; ++nt) { const int e = 64 * ch2 + 32 * nt + r31;
#pragma unroll
        for (int i = 0; i < 16; ++i) { const int j = 32 * jt + crow(i, hh); const float num = apv[0][nt][i] + fexp_(sg[j]) * aqs[0][nt][i]; Hs[j * 132 + e] = num * __builtin_amdgcn_rcpf(fmaxf(fabsf(sden[j]), 1.0f)); } }
    __syncthreads();
    { bf16_t* YA = (bf16_t*)(p.ws + WS_YA); const int e = 2 * lane; const float g0 = p.mnorm_g[l * 512 + h * 128 + e], g1 = p.mnorm_g[l * 512 + h * 128 + e + 1];
#pragma unroll
      for (int jj = 0; jj < 16; ++jj) { const int j = wid * 16 + jj; const f32x2 v = *(const f32x2*)(Hs + j * 132 + e); const float ss = wave_sum(v[0] * v[0] + v[1] * v[1]); const float rs = rsqrtf(ss * (1.0f / 128.0f) + EPS);
          const size_t tok = (size_t)(tok0 + j);
          *(unsigned*)(YA + tok * 512 + h * 128 + e) = pack2(v[0] * rs * g0 * sigmoidf_(bflo(fov[jj])) * siluf_(bflo(fzv[jj])), v[1] * rs * g1 * sigmoidf_(bfhi(fov[jj])) * siluf_(bfhi(fzv[jj]))); } }
    __syncthreads();
}
struct HgIn { unsigned fv[8], qv[8], vv[8], zv[8]; float lb0, lb1; };
template <bool WITH_Q> DI void hgrn_issue(const Params& p, int l, int ud, HgIn& in) {
    const int tid = opaque_tid(), wid = tid >> 6; const int bh = ud >> 5, c = ud & 31, b = bh >> 2, h = bh & 3, tok0 = b * SEQ + c * 64, d = 2 * (tid & 63);
    const bf16_t* U = (const bf16_t*)(p.ws + WS_U); const float* LB = (const float*)(p.ws + WS_LB);
    in.lb0 = LB[l * 512 + h * 128 + d]; in.lb1 = LB[l * 512 + h * 128 + d + 1];
#pragma unroll
    for (int i = 0; i < 8; ++i) { const size_t rowb = (size_t)(tok0 + 8 * wid + i) * NU + h * 128 + d; in.fv[i] = *(const unsigned*)(U + rowb + U_FD); in.qv[i] = 0u; in.zv[i] = 0u; if (WITH_Q) { in.qv[i] = *(const unsigned*)(U + rowb + U_QD); in.zv[i] = *(const unsigned*)(U + (size_t)(tok0 + 8 * wid + i) * NU + U_ZD + h * 128 + 2 * (tid & 63)); } in.vv[i] = *(const unsigned*)(U + rowb + U_ID); }
}
DI void hgrn_local_unit(const Params& p, int l, int ud, const HgIn& in, unsigned char* sm) {
    const int tid = opaque_tid(), wid = tid >> 6, lane = tid & 63;
    const int bh = ud >> 5, c = ud & 31, b = bh >> 2, h = bh & 3, tok0 = b * SEQ + c * 64;
    float* bS = (float*)sm; float* kS = (float*)(sm + 33024);
    bf16_t* KwT = (bf16_t*)(sm + 66048); bf16_t* VT = (bf16_t*)(sm + 84480); unsigned* N2 = (unsigned*)(sm + 102912);
    const bf16_t* U = (const bf16_t*)(p.ws + WS_U); const float* LB = (const float*)(p.ws + WS_LB);
    { const int dp = tid & 63, d = 2 * dp; const float lb0 = in.lb0, lb1 = in.lb1;
#pragma unroll
      for (int i = 0; i < 8; ++i) { const int r = 8 * wid + i; const float f0 = bflo(in.fv[i]), f1 = bfhi(in.fv[i]);
          bS[r * 129 + d] = __builtin_amdgcn_logf(lb0 + (1.0f - lb0) * sigmoidf_(f0)); bS[r * 129 + d + 1] = __builtin_amdgcn_logf(lb1 + (1.0f - lb1) * sigmoidf_(f1));
          kS[r * 129 + d] = (1.0f - lb0) * sigmoidf_(-f0); kS[r * 129 + d + 1] = (1.0f - lb1) * sigmoidf_(-f1);
          N2[r * 65 + dp] = in.vv[i]; } }
    __syncthreads();
    float* tot = (float*)(sm + 119552);
    { const int dd = tid & 127, J = tid >> 7; float s = 0.f;
#pragma unroll
      for (int rr = 0; rr < 16; ++rr) { s += bS[(16 * J + rr) * 129 + dd]; bS[(16 * J + rr) * 129 + dd] = s; }
      tot[J * 128 + dd] = s; }
    transpose_pairs<64>(N2, 65, VT, 72, tid);
    __syncthreads();
#pragma unroll
    for (int i = 0; i < 16; ++i) { const int idx = i * 512 + tid, r = idx & 63, d = idx >> 6, J = r >> 4;
        const float t0 = tot[d], t1 = tot[128 + d], t2 = tot[256 + d], t3 = tot[384 + d];
        const float rest = J == 0 ? t0 + t1 + t2 + t3 : (J == 1 ? t1 + t2 + t3 : (J == 2 ? t2 + t3 : t3));
        KwT[d * 72 + r] = f2bf(kS[r * 129 + d] * __builtin_amdgcn_exp2f(rest - bS[r * 129 + d])); }
    if (tid < 128) ((float*)(p.ws + WS_DECD))[ud * 128 + tid] = __builtin_amdgcn_exp2f(tot[tid] + tot[128 + tid] + tot[256 + tid] + tot[384 + tid]);
    __syncthreads();
    f32x16 acc[1][2]; zero_acc<1, 2>(acc);
    const int dt = wid & 3, eh = wid >> 2;
    mma_lds<1, 2>(acc, KwT + 32 * dt * 72, 72, VT + 64 * eh * 72, 72, 64, lane);
    bf16_t* ST = (bf16_t*)(p.ws + WS_STD) + (size_t)ud * 16384;
    { const int r31 = lane & 31, hh = lane >> 5;
#pragma unroll
      for (int nt = 0; nt < 2; ++nt) { const int e = 64 * eh + 32 * nt + r31;
#pragma unroll
          for (int q4 = 0; q4 < 4; ++q4) { const int d0 = 32 * dt + 8 * q4 + 4 * hh; f32x4 v = {acc[0][nt][4 * q4], acc[0][nt][4 * q4 + 1], acc[0][nt][4 * q4 + 2], acc[0][nt][4 * q4 + 3]};
              u32x2 w; w.x = pack2(v[0], v[1]); w.y = pack2(v[2], v[3]); *(u32x2*)(ST + e * 128 + d0) = w; } } }
    __syncthreads();
}
DI void hgrn_scan(const Params& p) {
    const int gt = blockIdx.x * 512 + opaque_tid(), nth = gridDim.x * 512; const float* DEC = (const float*)(p.ws + WS_DECD);
    for (int it = gt; it < 32 * 4096; it += nth) { const int bh = it >> 12, v = it & 4095, d4 = (v & 31) * 4; f32x4 S = {0.f, 0.f, 0.f, 0.f};
#pragma unroll 1
        for (int half = 0; half < 2; ++half) { u32x2* base = (u32x2*)((bf16_t*)(p.ws + WS_STD) + (size_t)(bh * 32 + half * 16) * 16384) + v; const float* db = DEC + (bh * 32 + half * 16) * 128 + d4;
            u32x2 tmp[16]; f32x4 dec[16];
#pragma unroll
            for (int c = 0; c < 16; ++c) { tmp[c] = base[(size_t)c * 4096]; dec[c] = *(const f32x4*)(db + c * 128); }
#pragma unroll
            for (int c = 0; c < 16; ++c) { u32x2 w; w.x = pack2(S[0], S[1]); w.y = pack2(S[2], S[3]); base[(size_t)c * 4096] = w;
                const f32x4 t = {bflo(tmp[c].x), bfhi(tmp[c].x), bflo(tmp[c].y), bfhi(tmp[c].y)}; S = S * dec[c] + t; } } }
}
DI void hgrn_out_unit(const Params& p, int l, int ud, const HgIn& in, unsigned char* sm) {
    const int tid = opaque_tid(), wid = tid >> 6, lane = tid & 63, r31 = lane & 31, hh = lane >> 5;
    const int bh = ud >> 5, c = ud & 31, b = bh >> 2, h = bh & 3, tok0 = b * SEQ + c * 64;
    float* bS = (float*)sm; bf16_t* STs = (bf16_t*)sm; float* tot = (float*)(sm + 32768);
    bf16_t* Qh = (bf16_t*)(sm + 34816); bf16_t* Qb = (bf16_t*)(sm + 52224); bf16_t* KK = (bf16_t*)(sm + 69632); float* Hs = (float*)(sm + 69632);
    bf16_t* VT = (bf16_t*)(sm + 113152); bf16_t* aS = (bf16_t*)(sm + 131584); unsigned* N2 = (unsigned*)(sm + 69632);
    const bf16_t* U = (const bf16_t*)(p.ws + WS_U); const float* LB = (const float*)(p.ws + WS_LB);
    const int dp = tid & 63, d = 2 * dp, R = wid >> 1;
    float q0[8], q1[8], k0[8], k1[8];
    { const float lb0 = in.lb0, lb1 = in.lb1;
#pragma unroll
      for (int i = 0; i < 8; ++i) { const int r = 8 * wid + i; const float f0 = bflo(in.fv[i]), f1 = bfhi(in.fv[i]);
          bS[r * 128 + d] = __builtin_amdgcn_logf(lb0 + (1.0f - lb0) * sigmoidf_(f0)); bS[r * 128 + d + 1] = __builtin_amdgcn_logf(lb1 + (1.0f - lb1) * sigmoidf_(f1));
          k0[i] = (1.0f - lb0) * sigmoidf_(-f0); k1[i] = (1.0f - lb1) * sigmoidf_(-f1);
          q0[i] = siluf_(bflo(in.qv[i])) * 0.08838834764831845f; q1[i] = siluf_(bfhi(in.qv[i])) * 0.08838834764831845f;
          N2[r * 65 + dp] = in.vv[i]; } }
    __syncthreads();
    transpose_pairs<64>(N2, 65, VT, 72, tid);
    { const int dd = tid & 127, J = tid >> 7; float s = 0.f;
#pragma unroll
      for (int rr = 0; rr < 16; ++rr) { s += bS[(16 * J + rr) * 128 + dd]; bS[(16 * J + rr) * 128 + dd] = s; }
      tot[J * 128 + dd] = s; }
    __syncthreads();
    { const f32x2 t0 = *(const f32x2*)(tot + d), t1 = *(const f32x2*)(tot + 128 + d), t2 = *(const f32x2*)(tot + 256 + d);
      float offa[4], offb[4]; offa[0] = 0.f; offb[0] = 0.f; offa[1] = t0[0]; offb[1] = t0[1]; offa[2] = t0[0] + t1[0]; offb[2] = t0[1] + t1[1]; offa[3] = offa[2] + t2[0]; offb[3] = offb[2] + t2[1];
      const float oRa = R == 0 ? offa[0] : (R == 1 ? offa[1] : (R == 2 ? offa[2] : offa[3])), oRb = R == 0 ? offb[0] : (R == 1 ? offb[1] : (R == 2 ? offb[2] : offb[3]));
#pragma unroll
      for (int i = 0; i < 8; ++i) { const int r = 8 * wid + i; const f32x2 lc = *(const f32x2*)(bS + r * 128 + d);
          *(unsigned*)(Qh + r * 136 + d) = pack2(q0[i] * __builtin_amdgcn_exp2f(lc[0]), q1[i] * __builtin_amdgcn_exp2f(lc[1]));
          *(unsigned*)(Qb + r * 136 + d) = pack2(q0[i] * __builtin_amdgcn_exp2f(lc[0] + oRa), q1[i] * __builtin_amdgcn_exp2f(lc[1] + oRb));
#pragma unroll
          for (int J = 0; J < 4; ++J) if (J >= R) { const int rowoff = 8 * J * (J + 1);
              *(unsigned*)(KK + (rowoff + r) * 136 + d) = pack2(k0[i] * __builtin_amdgcn_exp2f(fminf(offa[J] - oRa - lc[0], 100.f)), k1[i] * __builtin_amdgcn_exp2f(fminf(offb[J] - oRb - lc[1], 100.f))); } } }
    __syncthreads();
    { const bf16_t* ST = (const bf16_t*)(p.ws + WS_STD) + (size_t)ud * 16384;
#pragma unroll
      for (int i = 0; i < 4; ++i) { const int idx = i * 512 + tid, e = idx >> 4, d8 = (idx & 15) * 8; *(u32x4*)(STs + e * 136 + d8) = *(const u32x4*)(ST + e * 128 + d8); } }
    { const int c15 = lane & 15, q4 = lane >> 4;
#pragma unroll
      for (int sl = 0; sl < 2; ++sl) { const int slot = 2 * wid + sl, J = slot >> 2, Rt = slot & 3; f32x4 acc = {0.f, 0.f, 0.f, 0.f};
          if (Rt <= J) { const int rowoff = 8 * J * (J + 1);
#pragma unroll
              for (int ks = 0; ks < 4; ++ks) { const bf16x8 af = *(const bf16x8*)(Qh + (16 * J + c15) * 136 + 32 * ks + 8 * q4), bfr = *(const bf16x8*)(KK + (rowoff + 16 * Rt + c15) * 136 + 32 * ks + 8 * q4);
                  acc = __builtin_amdgcn_mfma_f32_16x16x32_bf16(af, bfr, acc, 0, 0, 0); } }
#pragma unroll
          for (int i = 0; i < 4; ++i) { const int jj = 16 * J + 4 * q4 + i, rr = 16 * Rt + c15; aS[jj * 72 + rr] = f2bf((Rt <= J && rr <= jj) ? acc[i] : 0.f); } } }
    __syncthreads();
    const int jt = wid & 1, et = wid >> 1;
    f32x16 acc[1][1]; zero_acc<1, 1>(acc);
    mma_lds<1, 1>(acc, aS + 32 * jt * 72, 72, VT + 32 * et * 72, 72, 64, lane);
    mma_lds<1, 1>(acc, Qb + 32 * jt * 136, 136, STs + 32 * et * 136, 136, 128, lane);
#pragma unroll
    for (int i = 0; i < 16; ++i) Hs[(32 * jt + crow(i, hh)) * 132 + 32 * et + r31] = acc[0][0][i];
    __syncthreads();
    { bf16_t* YD = (bf16_t*)(p.ws + WS_YD); const int e = 2 * lane; const float g0 = p.hnorm_g[l * 512 + h * 128 + e], g1 = p.hnorm_g[l * 512 + h * 128 + e + 1];
#pragma unroll
      for (int jj = 0; jj < 8; ++jj) { const int j = wid * 8 + jj; const f32x2 v = *(const f32x2*)(Hs + j * 132 + e); const float ss = wave_sum(v[0] * v[0] + v[1] * v[1]); const float rs = rsqrtf(ss * (1.0f / 128.0f) + EPS);
          const size_t tok = (size_t)(tok0 + j);
          *(unsigned*)(YD + tok * 512 + h * 128 + e) = pack2(v[0] * rs * g0 * siluf_(bflo(in.zv[jj])), v[1] * rs * g1 * siluf_(bfhi(in.zv[jj]))); } }
    __syncthreads();
}
DI void lru_local_unit(const Params& p, int l, int ub, unsigned char* sm) {
    const int tid = opaque_tid(), wid = tid >> 6, lane = tid & 63, c15 = lane & 15, q = lane >> 4;
    const int b = ub >> 5, c = ub & 31, tseq0 = c * 64, tok0 = b * SEQ + tseq0;
    float* xcf = (float*)sm; bf16_t* xcb = (bf16_t*)(sm + 32768); float* aS = (float*)(sm + 49408); float* uS = (float*)(sm + 82176);
    const bf16_t* U = (const bf16_t*)(p.ws + WS_U);
    unsigned* LHA = (unsigned*)(p.ws + WS_LRUH);
    bf16x8 waf[4][2], wxf[4][2];
    { const float* wa = p.wa + ((size_t)l * 8 + wid) * 4096; const float* wx = p.wx + ((size_t)l * 8 + wid) * 4096;
#pragma unroll
      for (int nt = 0; nt < 4; ++nt)
#pragma unroll
          for (int ks = 0; ks < 2; ++ks) { u32x4 ta, tx;
#pragma unroll
              for (int jp = 0; jp < 4; ++jp) { const int d = 32 * ks + 8 * q + 2 * jp, e = 16 * nt + c15;
                  ta[jp] = pack2(wa[d * 64 + e], wa[(d + 1) * 64 + e]); tx[jp] = pack2(wx[d * 64 + e], wx[(d + 1) * 64 + e]); }
              waf[nt][ks] = __builtin_bit_cast(bf16x8, ta); wxf[nt][ks] = __builtin_bit_cast(bf16x8, tx); } }
    float gba[4], gbx[4], gsp[4];
#pragma unroll
    for (int nt = 0; nt < 4; ++nt) { const int ch = wid * 64 + 16 * nt + c15; gba[nt] = p.ba[l * 512 + ch]; gbx[nt] = p.bx[l * 512 + ch]; gsp[nt] = 8.0f * log1pf(expf(-p.lam[l * 512 + ch])); }
    const int ch = tid; float cw0 = p.lconv_w[l * 2048 + ch], cw1 = p.lconv_w[l * 2048 + 512 + ch], cw2 = p.lconv_w[l * 2048 + 1024 + ch], cw3 = p.lconv_w[l * 2048 + 1536 + ch], cb = p.lconv_b[l * 512 + ch];
    float x0 = 0.f, x1 = 0.f, x2 = 0.f;
    if (tseq0 > 0) { x0 = bf2f(U[(size_t)(tok0 - 3) * NU + U_XB + ch]); x1 = bf2f(U[(size_t)(tok0 - 2) * NU + U_XB + ch]); x2 = bf2f(U[(size_t)(tok0 - 1) * NU + U_XB + ch]); }
    float hst = 0.f, Ac = 1.f;
    float xr[16];
#pragma unroll
    for (int tt = 0; tt < 16; ++tt) xr[tt] = bf2f(U[(size_t)(tok0 + tt) * NU + U_XB + ch]);
    for (int sc = 0; sc < 4; ++sc) {
#pragma unroll
        for (int tt = 0; tt < 16; ++tt) { const float x3 = xr[tt]; const float xc = cb + cw0 * x0 + cw1 * x1 + cw2 * x2 + cw3 * x3;
            xcf[tt * 512 + ch] = xc; xcb[tt * 520 + ch] = f2bf(xc); x0 = x1; x1 = x2; x2 = x3; }
        if (sc < 3) {
#pragma unroll
            for (int tt = 0; tt < 16; ++tt) xr[tt] = bf2f(U[(size_t)(tok0 + (sc + 1) * 16 + tt) * NU + U_XB + ch]); }
        __syncthreads();
        { f32x4 accA[4], accX[4];
#pragma unroll
          for (int nt = 0; nt < 4; ++nt) { accA[nt] = (f32x4){0.f, 0.f, 0.f, 0.f}; accX[nt] = (f32x4){0.f, 0.f, 0.f, 0.f}; }
#pragma unroll
          for (int ks = 0; ks < 2; ++ks) { const bf16x8 af = *(const bf16x8*)(xcb + c15 * 520 + wid * 64 + 32 * ks + 8 * q);
#pragma unroll
              for (int nt = 0; nt < 4; ++nt) { accA[nt] = __builtin_amdgcn_mfma_f32_16x16x32_bf16(af, waf[nt][ks], accA[nt], 0, 0, 0); accX[nt] = __builtin_amdgcn_mfma_f32_16x16x32_bf16(af, wxf[nt][ks], accX[nt], 0, 0, 0); } }
#pragma unroll
          for (int nt = 0; nt < 4; ++nt) { const int che = wid * 64 + 16 * nt + c15;
#pragma unroll
              for (int i = 0; i < 4; ++i) { const int t = 4 * q + i; const float rg = sigmoidf_(accA[nt][i] + gba[nt]), ig = sigmoidf_(accX[nt][i] + gbx[nt]);
                  const float la = -rg * gsp[nt]; const float a = fexp_(la); const float mult = __builtin_amdgcn_sqrtf(fmaxf(fmaf(-a, a, 1.0f), 0.f));
                  aS[t * 512 + che] = a; uS[t * 512 + che] = mult * ig * xcf[t * 512 + che]; } } }
        __syncthreads();
#pragma unroll 4
        for (int tt = 0; tt < 16; ++tt) { const float a = aS[tt * 512 + ch], u = uS[tt * 512 + ch]; hst = a * hst + u; Ac *= a; const size_t o = (size_t)(tok0 + sc * 16 + tt) * 512 + ch; LHA[o] = pack2(hst, Ac); }
    }
    __syncthreads();
}
DI void lru_scan(const Params& p) {
    const int gt = blockIdx.x * 512 + opaque_tid(), nth = gridDim.x * 512; const unsigned* LHA = (const unsigned*)(p.ws + WS_LRUH); float* CB = (float*)(p.ws + WS_CARB);
    for (int it = gt; it < 8 * 512; it += nth) { const int b = it >> 9, ch = it & 511; unsigned ha[32];
#pragma unroll
        for (int c = 0; c < 32; ++c) ha[c] = LHA[(size_t)(b * SEQ + c * 64 + 63) * 512 + ch];
        float H = 0.f;
#pragma unroll
        for (int c = 0; c < 32; ++c) { CB[(b * 32 + c) * 512 + ch] = H; H = bfhi(ha[c]) * H + bflo(ha[c]); } }
}
DI void lru_out(const Params& p) {
    const int gt = blockIdx.x * 512 + opaque_tid(), nth = gridDim.x * 512; const unsigned* LHA = (const unsigned*)(p.ws + WS_LRUH); const float* CB = (const float*)(p.ws + WS_CARB);
    const bf16_t* U = (const bf16_t*)(p.ws + WS_U); bf16_t* YB = (bf16_t*)(p.ws + WS_YB);
    for (int it0 = gt; it0 < T * 128; it0 += 8 * nth) {
        u32x4 ha[8]; f32x4 cr[8]; u32x2 zv[8];
#pragma unroll
        for (int k = 0; k < 8; ++k) { const int it = it0 + k * nth; if (it < T * 128) { const int tok = it >> 7, c4 = (it & 127) * 4; const size_t o = (size_t)tok * 512 + c4;
            ha[k] = *(const u32x4*)(LHA + o); cr[k] = *(const f32x4*)(CB + (size_t)(tok >> 6) * 512 + c4); zv[k] = *(const u32x2*)(U + (size_t)tok * NU + U_ZB + c4); } }
#pragma unroll
        for (int k = 0; k < 8; ++k) { const int it = it0 + k * nth; if (it < T * 128) { const int tok = it >> 7, c4 = (it & 127) * 4; const size_t o = (size_t)tok * 512 + c4;
            const float h0 = bflo(ha[k].x) + bfhi(ha[k].x) * cr[k][0], h1 = bflo(ha[k].y) + bfhi(ha[k].y) * cr[k][1], h2 = bflo(ha[k].z) + bfhi(ha[k].z) * cr[k][2], h3 = bflo(ha[k].w) + bfhi(ha[k].w) * cr[k][3];
            u32x2 w; w.x = pack2(h0 * siluf_(bflo(zv[k].x)), h1 * siluf_(bfhi(zv[k].x))); w.y = pack2(h2 * siluf_(bflo(zv[k].y)), h3 * siluf_(bfhi(zv[k].y))); *(u32x2*)(YB + o) = w; } } }
}
#define MFMA32(a, b, c) __builtin_amdgcn_mfma_f32_32x32x16_bf16((a), (b), (c), 0, 0, 0)
DI bf16x8 pack_p(const f32x16& x, int s) {
    u32x4 w; w.x = pack2(x[8 * s], x[8 * s + 1]); w.y = pack2(x[8 * s + 2], x[8 * s + 3]); w.z = pack2(x[8 * s + 4], x[8 * s + 5]); w.w = pack2(x[8 * s + 6], x[8 * s + 7]);
    return __builtin_bit_cast(bf16x8, w);
}
DI bf16x8 vt_frag(const bf16_t* VT, int e, int key0, int hh) {
    const s16x4 lo = *(const s16x4*)(VT + e * 260 + key0 + 4 * hh), hi = *(const s16x4*)(VT + e * 260 + key0 + 8 + 4 * hh);
    return __builtin_shufflevector(lo, hi, 0, 1, 2, 3, 4, 5, 6, 7);
}
DI void swa_unit(const Params& p, int l, int uc, unsigned char* sm) {
    const int tid = opaque_tid(), wid = tid >> 6, lane = tid & 63, r31 = lane & 31, hh = lane >> 5;
    const int b = uc >> 5, nb = (uc >> 1) & 15, kv = uc & 1;
    bf16_t* Ks = (bf16_t*)sm; bf16_t* VT = (bf16_t*)(sm + 36864); int* posk = (int*)(sm + 70656); unsigned* N2 = (unsigned*)(sm + 71680);
    const bf16_t* U = (const bf16_t*)(p.ws + WS_U); bf16_t* YC = (bf16_t*)(p.ws + WS_YC);
#pragma unroll
    for (int i = 0; i < 4; ++i) { const int idx = i * 512 + tid, s = idx >> 3, c8 = idx & 7, tseq = nb * 128 - 128 + s; u32x4 v = {0u, 0u, 0u, 0u};
        if (tseq >= 0) v = *(const u32x4*)(U + (size_t)(b * SEQ + tseq) * NU + U_KC + kv * 64 + c8 * 8);
        *(u32x4*)(Ks + s * 72 + c8 * 8) = v; }
    { unsigned vv[16];
#pragma unroll
      for (int i = 0; i < 16; ++i) { const int idx = i * 512 + tid, s = idx >> 5, ep = idx & 31; int tseq = nb * 128 - 128 + s; tseq = tseq < 0 ? 0 : tseq;
          vv[i] = *(const unsigned*)(U + (size_t)(b * SEQ + tseq) * NU + U_VC + kv * 64 + 2 * ep); }
#pragma unroll
      for (int i = 0; i < 16; ++i) { const int idx = i * 512 + tid, s = idx >> 5, ep = idx & 31; N2[s * 33 + ep] = (nb * 128 - 128 + s >= 0) ? vv[i] : 0u; } }
    if (tid < 256) { const int tseq = nb * 128 - 128 + tid; posk[tid] = tseq >= 0 ? p.pos[b * SEQ + tseq] : 0; }
    const int g = wid >> 1, th = wid & 1, head = kv * 4 + g; const float slope = exp2f(-(float)(head + 1)), sink = p.sinks[l * 8 + head];
    bf16x8 qn[4];
#pragma unroll
    for (int ks = 0; ks < 4; ++ks) qn[ks] = *(const bf16x8*)(U + (size_t)(b * SEQ + nb * 128 + 64 * th + r31) * NU + U_QC + head * 64 + 16 * ks + 8 * hh);
    __syncthreads();
    { const int s = tid & 255, eq = tid >> 8;
#pragma unroll
      for (int i = 0; i < 16; ++i) { const int ep = eq * 16 + i; const unsigned w = N2[s * 33 + ep]; VT[(2 * ep) * 260 + s] = (bf16_t)(w & 0xffffu); VT[(2 * ep + 1) * 260 + s] = (bf16_t)(w >> 16); } }
    __syncthreads();
#pragma unroll 1
    for (int pass = 0; pass < 2; ++pass) {
        const int t0 = 64 * th + 32 * pass, t = t0 + r31; const size_t tok = (size_t)(b * SEQ + nb * 128 + t);
        bf16x8 qf[4];
#pragma unroll
        for (int ks = 0; ks < 4; ++ks) { qf[ks] = qn[ks]; qn[ks] = *(const bf16x8*)(U + (tok + 32 * (1 - pass)) * NU + U_QC + head * 64 + 16 * ks + 8 * hh); }
        u32x2 zpre[2][4];
#pragma unroll
        for (int et = 0; et < 2; ++et)
#pragma unroll
            for (int q4 = 0; q4 < 4; ++q4) zpre[et][q4] = *(const u32x2*)(U + tok * NU + U_ZC + head * 64 + 32 * et + 8 * q4 + 4 * hh);
        f32x16 acc[5];
#pragma unroll
        for (int mt = 0; mt < 5; ++mt) {
#pragma unroll
            for (int i = 0; i < 16; ++i) acc[mt][i] = 0.f;
#pragma unroll
            for (int ks = 0; ks < 4; ++ks) { const bf16x8 kf = *(const bf16x8*)(Ks + (t0 + 32 * mt + r31) * 72 + 16 * ks + 8 * hh); acc[mt] = MFMA32(kf, qf[ks], acc[mt]); } }
        const int pq = posk[128 + t]; float m = -INFINITY;
#pragma unroll
        for (int mt = 0; mt < 5; ++mt)
#pragma unroll
            for (int g4 = 0; g4 < 4; ++g4) { const int cr0 = 8 * g4 + 4 * hh, sb = t0 + 32 * mt + cr0; const u32x4 pk = *(const u32x4*)(posk + sb);
#pragma unroll
                for (int k = 0; k < 4; ++k) { const int i = 4 * g4 + k; bool valid = (nb > 0) || (sb + k >= 128);
                    if (mt == 0) valid = valid && (cr0 + k > r31);
                    if (mt == 4) valid = valid && (cr0 + k <= r31);
                    const float dist = fabsf((float)(pq - (int)pk[k])); const float sc = valid ? acc[mt][i] * 0.125f - slope * dist : -INFINITY; acc[mt][i] = sc; m = fmaxf(m, sc); } }
        m = fmaxf(m, __shfl_xor(m, 32)); m = fmaxf(m, sink);
        float sum = 0.f;
#pragma unroll
        for (int mt = 0; mt < 5; ++mt)
#pragma unroll
            for (int i = 0; i < 16; ++i) { const float pv = fexp_(acc[mt][i] - m); acc[mt][i] = pv; sum += pv; }
        sum += __shfl_xor(sum, 32); sum += fexp_(sink - m); const float inv = __builtin_amdgcn_rcpf(sum);
        f32x16 o[2];
#pragma unroll
        for (int i = 0; i < 16; ++i) { o[0][i] = 0.f; o[1][i] = 0.f; }
#pragma unroll
        for (int mt = 0; mt < 5; ++mt) {
#pragma unroll
            for (int i = 0; i < 16; ++i) acc[mt][i] *= inv;
#pragma unroll
            for (int s2 = 0; s2 < 2; ++s2) { const bf16x8 pf = pack_p(acc[mt], s2);
#pragma unroll
                for (int et = 0; et < 2; ++et) o[et] = MFMA32(vt_frag(VT, 32 * et + r31, t0 + 32 * mt + 16 * s2, hh), pf, o[et]); } }
#pragma unroll
        for (int et = 0; et < 2; ++et)
#pragma unroll
            for (int q4 = 0; q4 < 4; ++q4) { const int e0 = 32 * et + 8 * q4 + 4 * hh; const u32x2 zv = zpre[et][q4];
                u32x2 w; w.x = pack2(o[et][4 * q4] * siluf_(bflo(zv.x)), o[et][4 * q4 + 1] * siluf_(bfhi(zv.x))); w.y = pack2(o[et][4 * q4 + 2] * siluf_(bflo(zv.y)), o[et][4 * q4 + 3] * siluf_(bfhi(zv.y)));
                *(u32x2*)(YC + tok * 512 + head * 64 + e0) = w; }
    }
    __syncthreads();
}
DI void xattn_unit(const Params& p, int l, int ue, unsigned char* sm) {
    const int tid = opaque_tid(), wid = tid >> 6, lane = tid & 63, r31 = lane & 31, hh = lane >> 5;
    const int b = ue >> 5, hd = (ue >> 3) & 3, qt = ue & 7;
    bf16_t* Ks = (bf16_t*)sm; bf16_t* VT = (bf16_t*)(sm + 36864); unsigned* N2 = (unsigned*)(sm + 71680);
    const bf16_t* U = (const bf16_t*)(p.ws + WS_U); const bf16_t* KVM = (const bf16_t*)(p.ws + WS_KVM); bf16_t* YE = (bf16_t*)(p.ws + WS_YE);
#pragma unroll
    for (int i = 0; i < 4; ++i) { const int idx = i * 512 + tid, s = idx >> 3, c8 = idx & 7;
        *(u32x4*)(Ks + s * 72 + c8 * 8) = *(const u32x4*)(KVM + (size_t)(b * 256 + s) * 2048 + l * 512 + hd * 64 + c8 * 8); }
    { unsigned vv[16];
#pragma unroll
      for (int i = 0; i < 16; ++i) { const int idx = i * 512 + tid, s = idx >> 5, ep = idx & 31; vv[i] = *(const unsigned*)(KVM + (size_t)(b * 256 + s) * 2048 + l * 512 + 256 + hd * 64 + 2 * ep); }
#pragma unroll
      for (int i = 0; i < 16; ++i) { const int idx = i * 512 + tid, s = idx >> 5, ep = idx & 31; N2[s * 33 + ep] = vv[i]; } }
    const int t = qt * 256 + 32 * wid + r31; const size_t tok = (size_t)(b * SEQ + t);
    bf16x8 qf[4];
#pragma unroll
    for (int ks = 0; ks < 4; ++ks) qf[ks] = *(const bf16x8*)(U + tok * NU + U_QE + hd * 64 + 16 * ks + 8 * hh);
    u32x2 zpre[2][4];
#pragma unroll
    for (int et = 0; et < 2; ++et)
#pragma unroll
        for (int q4 = 0; q4 < 4; ++q4) zpre[et][q4] = *(const u32x2*)(U + tok * NU + U_ZE + hd * 64 + 32 * et + 8 * q4 + 4 * hh);
    __syncthreads();
    { const int s = tid & 255, eq = tid >> 8;
#pragma unroll
      for (int i = 0; i < 16; ++i) { const int ep = eq * 16 + i; const unsigned w = N2[s * 33 + ep]; VT[(2 * ep) * 260 + s] = (bf16_t)(w & 0xffffu); VT[(2 * ep + 1) * 260 + s] = (bf16_t)(w >> 16); } }
    __syncthreads();
    float m = -INFINITY;
#pragma unroll 1
    for (int half = 0; half < 2; ++half) { f32x16 acc[4];
#pragma unroll
        for (int mt = 0; mt < 4; ++mt) {
#pragma unroll
            for (int i = 0; i < 16; ++i) acc[mt][i] = 0.f;
#pragma unroll
            for (int ks = 0; ks < 4; ++ks) { const bf16x8 kf = *(const bf16x8*)(Ks + (128 * half + 32 * mt + r31) * 72 + 16 * ks + 8 * hh); acc[mt] = MFMA32(kf, qf[ks], acc[mt]); }
#pragma unroll
            for (int i = 0; i < 16; ++i) m = fmaxf(m, acc[mt][i]); } }
    m = fmaxf(m, __shfl_xor(m, 32)) * 0.125f;
    float sum = 0.f; f32x16 o[2];
#pragma unroll
    for (int i = 0; i < 16; ++i) { o[0][i] = 0.f; o[1][i] = 0.f; }
#pragma unroll 1
    for (int half = 0; half < 2; ++half) { f32x16 acc[4];
#pragma unroll
        for (int mt = 0; mt < 4; ++mt) {
#pragma unroll
            for (int i = 0; i < 16; ++i) acc[mt][i] = 0.f;
#pragma unroll
            for (int ks = 0; ks < 4; ++ks) { const bf16x8 kf = *(const bf16x8*)(Ks + (128 * half + 32 * mt + r31) * 72 + 16 * ks + 8 * hh); acc[mt] = MFMA32(kf, qf[ks], acc[mt]); }
#pragma unroll
            for (int i = 0; i < 16; ++i) { const float pv = fexp_(acc[mt][i] * 0.125f - m); acc[mt][i] = pv; sum += pv; }
#pragma unroll
            for (int s2 = 0; s2 < 2; ++s2) { const bf16x8 pf = pack_p(acc[mt], s2);
#pragma unroll
                for (int et = 0; et < 2; ++et) o[et] = MFMA32(vt_frag(VT, 32 * et + r31, 128 * half + 32 * mt + 16 * s2, hh), pf, o[et]); } } }
    sum += __shfl_xor(sum, 32); const float inv = __builtin_amdgcn_rcpf(sum);
#pragma unroll
    for (int et = 0; et < 2; ++et)
#pragma unroll
        for (int q4 = 0; q4 < 4; ++q4) { const int e0 = 32 * et + 8 * q4 + 4 * hh; const u32x2 zv = zpre[et][q4];
            u32x2 w; w.x = pack2(o[et][4 * q4] * inv * siluf_(bflo(zv.x)), o[et][4 * q4 + 1] * inv * siluf_(bfhi(zv.x))); w.y = pack2(o[et][4 * q4 + 2] * inv * siluf_(bflo(zv.y)), o[et][4 * q4 + 3] * inv * siluf_(bfhi(zv.y)));
            *(u32x2*)(YE + tok * 256 + hd * 64 + e0) = w; }
    __syncthreads();
}
#define XB_TMO      128
#define XB_XCNT(j)  (256  + 64 * (j))
#define XB_XSUB(j)  (1280 + 64 * (j))
#define XB_XGEN(j)  (2304 + 64 * (j))
#define XB_TOP      3328
#define XB_TOPGEN   3392
#define XCD_BAR_WORDS 3456
#define XB_SPIN_CAP (1u << 18)
#define LAS __attribute__((address_space(3)))
__device__ __forceinline__ unsigned xb_ld(unsigned* p)              { return __hip_atomic_load(p, __ATOMIC_RELAXED, __HIP_MEMORY_SCOPE_AGENT); }
__device__ __forceinline__ unsigned xb_add(unsigned* p, unsigned v) { return __hip_atomic_fetch_add(p, v, __ATOMIC_RELAXED, __HIP_MEMORY_SCOPE_AGENT); }
__device__ __forceinline__ unsigned xb_xcc_id() { return (unsigned)__builtin_amdgcn_s_getreg((3 << 11) | 20) & 0xFu; }
#define XB_SPIN(cond, bar) do { unsigned _sp = 0; while (cond) { __builtin_amdgcn_s_sleep(1); \
    if ((++_sp & 255u) == 0u) { if (xb_ld(&(bar)[XB_TMO])) break; if (_sp > XB_SPIN_CAP) { atomicAdd(&(bar)[XB_TMO], 1u); break; } } } } while (0)

struct XcdBarrier {
    unsigned* bar; unsigned x;
    volatile LAS unsigned* st;
};

__device__ __forceinline__ XcdBarrier xcd_barrier_post(unsigned* bar, volatile LAS unsigned* st) {
    XcdBarrier b; b.bar = bar; b.x = xb_xcc_id(); b.st = st;
    if (threadIdx.x == 0) (void)xb_add(&bar[XB_XCNT(b.x)], 1u);
    return b;
}
__device__ __forceinline__ void xcd_barrier_complete(unsigned* bar, unsigned x, unsigned& nloc, unsigned& nx) {
    const unsigned G = gridDim.x * gridDim.y * gridDim.z;
    unsigned sum, cnt, mine, sp = 0u;
    for (;;) {
        sum = 0u; cnt = 0u; mine = 0u;
#pragma unroll
        for (unsigned j = 0; j < 16; ++j) { const unsigned c = xb_ld(&bar[XB_XCNT(j)]); sum += c; cnt += (c > 0u) ? 1u : 0u; mine = (j == x) ? c : mine; }
        if (sum == G) break;
        __builtin_amdgcn_s_sleep(1);
        if ((++sp & 255u) == 0u) { if (xb_ld(&bar[XB_TMO])) break; if (sp > XB_SPIN_CAP) { atomicAdd(&bar[XB_TMO], 1u); break; } }
    }
    nloc = mine > 0u ? mine : 1u; nx = cnt > 0u ? cnt : 1u;
}

__device__ __forceinline__ void xcd_barrier(const XcdBarrier& b) {
    asm volatile("s_waitcnt vmcnt(0)" ::: "memory");
    __syncthreads();
    if (threadIdx.x == 0) {
        unsigned* bar = b.bar;
        __builtin_amdgcn_s_waitcnt(0);
        unsigned nloc = b.st[0], nx = b.st[1];
        if (nloc == 0u) { xcd_barrier_complete(bar, b.x, nloc, nx); b.st[0] = nloc; b.st[1] = nx; }
        const unsigned old = xb_add(&bar[XB_XSUB(b.x)], 1u);
        const unsigned gen = old / nloc;
        if (old + 1u == (gen + 1u) * nloc) {
            __builtin_amdgcn_fence(__ATOMIC_RELEASE, "agent");
            asm volatile("s_waitcnt vmcnt(0)" ::: "memory");
            const unsigned og = xb_add(&bar[XB_TOP], 1u);
            const unsigned tg = og / nx;
            if (og + 1u == (tg + 1u) * nx) xb_add(&bar[XB_TOPGEN], 1u);
            else XB_SPIN(xb_ld(&bar[XB_TOPGEN]) == tg, bar);
            __builtin_amdgcn_fence(__ATOMIC_ACQUIRE, "agent");
            xb_add(&bar[XB_XGEN(b.x)], 1u);
            asm volatile("s_waitcnt vmcnt(0)" ::: "memory");
        } else {
            XB_SPIN(xb_ld(&bar[XB_XGEN(b.x)]) == gen, bar);
            __builtin_amdgcn_fence(__ATOMIC_ACQUIRE, "agent");
            asm volatile("s_waitcnt vmcnt(0)" ::: "memory");
        }
    }
    __syncthreads();
}

typedef const __attribute__((address_space(4))) unsigned char* kargp_t;
DI Params load_params(kargp_t kp) { asm volatile("" : "+s"(kp)); Params q; __builtin_memcpy(&q, kp, sizeof(Params)); return q; }
__global__ void __launch_bounds__(512, 2) hybrid_fwd(Params p_unused) {
    const kargp_t kp = (kargp_t)__builtin_amdgcn_kernarg_segment_ptr();
#define p (load_params(kp))
#define GSYNC() do { XcdBarrier b_; b_.bar = (unsigned*)(p.ws + WS_BAR); b_.x = xb_xcc_id(); b_.st = xst; xcd_barrier(b_); } while (0)
    extern __shared__ __attribute__((aligned(16))) unsigned char shm[];
    cg::grid_group grid = cg::this_grid();
    PG8_LAS unsigned char* lds = (PG8_LAS unsigned char*)shm;
    const int G = (int)gridDim.x, bid = (int)blockIdx.x;
#define Ub ((bf16_t*)(p.ws + WS_U))
#define Hb ((bf16_t*)(p.ws + WS_H))
    volatile LAS unsigned* xst = (volatile LAS unsigned*)(lds + (LDS_BYTES - 16));
    if (threadIdx.x == 0) { xst[0] = 0u; xst[1] = 0u; }
    __syncthreads();
    (void)xcd_barrier_post((unsigned*)(p.ws + WS_BAR), xst);
    phase_prologue(p, shm);
    convert_win(p, 0, bid, G, shm);
    if (G == 0x7fffffff) grid.sync();
    GSYNC();
    { pg8::StaticOrder S; S.init(2048, 2048, G, bid); pg8::Gemm g{(const bf16_t*)(p.ws + WS_MEMN), (const bf16_t*)(p.ws + WS_WMEM), 2048, 2048, 1024, 0, 0};
      EpiStoreBf16 E{(bf16_t*)(p.ws + WS_KVM), 2048}; pg8::gemm_phase<EpiStoreBf16, pg8::StaticOrder, false>(lds, g, S, E, nullptr); }
#pragma unroll 1
    for (int l = 0; l < 4; ++l) {
        const float* xin = (l == 0) ? p.x : p.out;
        PREP(9)
        phase_norm(p, l, xin, shm);
        GSYNC();
#pragma unroll 1
        for (int rep = 0; rep < 1 + PROBE_DUP_P2; ++rep)
        { pg8::StaticOrder S; S.init(T, NU, G, bid); pg8::Gemm g{Hb, (const bf16_t*)(p.ws + WS_WIN + (size_t)(l & 1) * SZ_WIN1), T, NU, 1024, 0, 0};
          EpiStoreBf16 E{Ub, NU}; pg8::gemm_phase<EpiStoreBf16, pg8::StaticOrder, false>(lds, g, S, E, nullptr); }
        if (PROBE_DUP_P2 == 0 && l < 3) { const int nrem = 3136 % G; if (bid >= nrem) convert_win(p, l + 1, bid - nrem, G - nrem, shm); }
        GSYNC();
#pragma unroll 1
        for (int rep = 0; rep < 1 + PROBE_DUP_P3; ++rep) {
        PREP(1)
        for (int u = bid; u < 256; u += G) swa_unit(p, l, u, shm);
        PREP(2)
        for (int u = bid; u < 256; u += G) xattn_unit(p, l, u, shm);
        PREP(3)
        for (int u = bid; u < 256; u += G) lru_local_unit(p, l, u, shm);
        if (G == 256 && PROBE_UNIT == 0 && PROBE_DUP_P3 == 0) { HgIn ia, ib; hgrn_issue<false>(p, l, bid, ia); hgrn_issue<false>(p, l, bid + 256, ib);
            for (int u = bid; u < 512; u += G) mlstm_local_unit(p, l, u, shm);
            hgrn_local_unit(p, l, bid, ia, shm);
            hgrn_issue<false>(p, l, bid + 512, ia); hgrn_local_unit(p, l, bid + 256, ib, shm); hgrn_issue<false>(p, l, bid + 768, ib); hgrn_local_unit(p, l, bid + 512, ia, shm); hgrn_local_unit(p, l, bid + 768, ib, shm); }
        else {
        PREP(4)
        for (int u = bid; u < 512; u += G) mlstm_local_unit(p, l, u, shm);
        PREP(5)
        if (G == 256) { HgIn ia, ib; hgrn_issue<false>(p, l, bid, ia); hgrn_issue<false>(p, l, bid + 256, ib); hgrn_local_unit(p, l, bid, ia, shm);
            hgrn_issue<false>(p, l, bid + 512, ia); hgrn_local_unit(p, l, bid + 256, ib, shm); hgrn_issue<false>(p, l, bid + 768, ib); hgrn_local_unit(p, l, bid + 512, ia, shm); hgrn_local_unit(p, l, bid + 768, ib, shm); }
        else for (int u = bid; u < 1024; u += G) { HgIn ia; hgrn_issue<false>(p, l, u, ia); hgrn_local_unit(p, l, u, ia, shm); }
        }
        }
#pragma unroll 1
        for (int i = 0; i < PROBE_SYNCS; ++i) GSYNC();
        GSYNC();
        mlstm_scan(p); hgrn_scan(p); lru_scan(p);
        GSYNC();
#pragma unroll 1
        for (int rep = 0; rep < 1 + PROBE_DUP_P5; ++rep) {
        if (G == 256 && PROBE_UNIT == 0 && PROBE_DUP_P5 == 0) { HgIn ia, ib; hgrn_issue<true>(p, l, bid, ia);
            for (int u = bid; u < 512; u += G) mlstm_out_unit(p, l, u, shm);
            hgrn_issue<true>(p, l, bid + 256, ib); hgrn_out_unit(p, l, bid, ia, shm);
            hgrn_issue<true>(p, l, bid + 512, ia); hgrn_out_unit(p, l, bid + 256, ib, shm); hgrn_issue<true>(p, l, bid + 768, ib); hgrn_out_unit(p, l, bid + 512, ia, shm); hgrn_out_unit(p, l, bid + 768, ib, shm); }
        else {
        PREP(6)
        for (int u = bid; u < 512; u += G) mlstm_out_unit(p, l, u, shm);
        PREP(7)
        if (G == 256) { HgIn ia, ib; hgrn_issue<true>(p, l, bid, ia); hgrn_issue<true>(p, l, bid + 256, ib); hgrn_out_unit(p, l, bid, ia, shm);
            hgrn_issue<true>(p, l, bid + 512, ia); hgrn_out_unit(p, l, bid + 256, ib, shm); hgrn_issue<true>(p, l, bid + 768, ib); hgrn_out_unit(p, l, bid + 512, ia, shm); hgrn_out_unit(p, l, bid + 768, ib, shm); }
        else for (int u = bid; u < 1024; u += G) { HgIn ia; hgrn_issue<true>(p, l, u, ia); hgrn_out_unit(p, l, u, ia, shm); }
        }
        PREP(8)
        lru_out(p);
        }
        GSYNC();
#pragma unroll 1
        for (int rep = 0; rep < 1 + PROBE_DUP_P6; ++rep) {
            bf16_t* Pb = (bf16_t*)(p.ws + WS_YF);
            { GroupOrder S{G, bid}; pg8::Gemm g{(const bf16_t*)(p.ws + WS_YS), (const bf16_t*)(p.ws + WS_WBR) + (size_t)l * 2304 * 1024, T, 1024, 512, (size_t)T * 512 * 2, (size_t)512 * 1024 * 2};
              EpiGateAcc E{Ub + U_G, Pb, Hb, 0}; pg8::gemm_phase<EpiGateAcc, GroupOrder, false>(lds, g, S, E, nullptr); }
            { pg8::StaticOrder S; S.init(T, 1024, G, bid); pg8::Gemm g{(const bf16_t*)(p.ws + WS_YE), (const bf16_t*)(p.ws + WS_WBR) + (size_t)l * 2304 * 1024 + (size_t)4 * 512 * 1024, T, 1024, 256, 0, 0};
              EpiGateAcc E{Ub + U_G, Pb, Hb, 4}; pg8::gemm_phase<EpiGateAcc, pg8::StaticOrder, false>(lds, g, S, E, nullptr); }
        }
        GSYNC();
        { pg8::StaticOrder S; S.init(T, 1024, G, bid); pg8::Gemm g{Hb, (const bf16_t*)(p.ws + WS_WOUT) + (size_t)l * 1024 * 1024, T, 1024, 1024, 0, 0};
          EpiRes E{xin, p.out}; pg8::gemm_phase<EpiRes, pg8::StaticOrder, false>(lds, g, S, E, nullptr); }
        GSYNC();
    }
    phase_final_norm(p);
}
#undef p
#undef GSYNC
#undef Ub
#undef Hb

extern "C" void kernel_launch(void* const* d_in, const int* in_sizes, int n_in, void* d_out, int out_size, void* d_ws, size_t ws_size, hipStream_t stream) {
    static int grid_blocks = 0;
    if (grid_blocks == 0) {
        if (n_in != 23 || ws_size < WS_END) { fprintf(stderr, "kernel_launch: unexpected n_in %d or ws_size %zu (< %zu)\n", n_in, ws_size, (size_t)WS_END); grid_blocks = -1; return; }
        int dev = 0, cus = 0, per_cu = 0;
        hipGetDevice(&dev); hipDeviceGetAttribute(&cus, hipDeviceAttributeMultiprocessorCount, dev);
        if (hipFuncSetAttribute((const void*)hybrid_fwd, hipFuncAttributeMaxDynamicSharedMemorySize, LDS_BYTES) != hipSuccess) { fprintf(stderr, "kernel_launch: hipFuncSetAttribute failed\n"); grid_blocks = -1; return; }
        if (hipOccupancyMaxActiveBlocksPerMultiprocessor(&per_cu, (const void*)hybrid_fwd, 512, LDS_BYTES) != hipSuccess || per_cu < 1) { fprintf(stderr, "kernel_launch: occupancy query failed (%d)\n", per_cu); (void)hipGetLastError(); per_cu = 1; }
        grid_blocks = cus * per_cu;
    }
    if (grid_blocks < 0) return;
    Params p{};
    p.x = (const float*)d_in[0]; p.mem = (const float*)d_in[1]; p.pos = (const int*)d_in[2]; p.norm_g = (const float*)d_in[3]; p.w_in = (const float*)d_in[4];
    p.mconv_w = (const float*)d_in[5]; p.b_if = (const float*)d_in[6]; p.mnorm_g = (const float*)d_in[7]; p.lconv_w = (const float*)d_in[8]; p.lconv_b = (const float*)d_in[9];
    p.wa = (const float*)d_in[10]; p.ba = (const float*)d_in[11]; p.wx = (const float*)d_in[12]; p.bx = (const float*)d_in[13]; p.lam = (const float*)d_in[14];
    p.sinks = (const float*)d_in[15]; p.hlb = (const float*)d_in[16]; p.hnorm_g = (const float*)d_in[17]; p.mem_g = (const float*)d_in[18]; p.w_mem = (const float*)d_in[19];
    p.w_br = (const float*)d_in[20]; p.w_out = (const float*)d_in[21]; p.fin_g = (const float*)d_in[22];
    p.out = (float*)d_out; p.ws = (unsigned char*)d_ws;
    if (hipMemsetAsync((unsigned char*)d_ws + WS_BAR, 0, 16384, stream) != hipSuccess) { fprintf(stderr, "kernel_launch: memset failed\n"); return; }
    void* args[] = {&p};
    hipError_t e = hipLaunchCooperativeKernel((const void*)hybrid_fwd, dim3(grid_blocks), dim3(512), args, LDS_BYTES, stream);
    if (e != hipSuccess) fprintf(stderr, "cooperative launch failed: %s (grid %d)\n", hipGetErrorString(e), grid_blocks);
}
```

```cpp
#include <hip/hip_runtime.h>
#include <hip/hip_cooperative_groups.h>
#include <cstdio>
#define PROBE_DUP_P3 0
#define PROBE_DUP_P5 0
#define PROBE_DUP_P6 0
#define PROBE_DUP_P2 0
#define PROBE_SYNCS 0
#define PROBE_UNIT 0
#define PREP(k) for (int rep_ = 0; rep_ < (PROBE_UNIT == (k) ? 2 : 1); ++rep_)
namespace cg = cooperative_groups;
__device__ __forceinline__ int opaque_tid() { int t = (int)threadIdx.x; asm volatile("" : "+v"(t)); return t; }
namespace pg8 {
#define PG8_LAS __attribute__((address_space(3)))
typedef unsigned short bf16_t;
typedef short bf16x8 __attribute__((ext_vector_type(8)));
typedef float f32x4 __attribute__((ext_vector_type(4)));
typedef unsigned u32x4 __attribute__((ext_vector_type(4)));
constexpr int BM = 256, BK = 64, HALF = 128, HTB = HALF * BK * 2  , STAGE_BYTES = 8 * HTB, NXCD = 8, WGM = 4;

__host__ __device__ __forceinline__ int lds_byte(int r, int c) { const int st = (r >> 4) * 2 + (c >> 5), rr = r & 15, cc = c & 31, ob = rr * 64 + cc * 2; return st * 1024 + (ob ^ (((ob >> 9) & 1) << 5)); }
__host__ __device__ __forceinline__ void stage_rc(int b, int& R, int& C) { const int st = b / 1024, sb = b % 1024, swz = sb ^ (((sb >> 9) & 1) << 5); R = (st >> 1) * 16 + swz / 64; C = (st & 1) * 32 + (swz % 64) / 2; }
__host__ __device__ __forceinline__ int perm32(int rho) { const int n = rho >> 4, i = rho & 15; return 8 * (i >> 2) + 4 * n + (i & 3); }

struct Unit { int pm, pn, g; };
struct Gemm { const bf16_t* A; const bf16_t* Bt; int M, N, K; size_t gsA, gsB; };

struct StaticOrder {
    int nM, nN, nwg, G, c;
    __host__ __device__ void init(int M, int N, int G_, int c_) { nM = M / BM; nN = N / BM; nwg = nM * nN; G = G_; c = c_; }
    __host__ __device__ bool next(int i, Unit& u) const {
        const long L = (long)i * G + c; if (L >= nwg) return false;
        int wgid = (int)L; { const int q = nwg / NXCD, r = nwg % NXCD, xcd = wgid % NXCD, off = wgid / NXCD; wgid = (xcd < r ? xcd * (q + 1) : r * (q + 1) + (xcd - r) * q) + off; }
        const int nig = WGM * nN, gid = wgid / nig, fm = gid * WGM, gsz = (nM - fm) < WGM ? (nM - fm) : WGM;
        u.pm = fm + ((wgid % nig) % gsz); u.pn = (wgid % nig) / gsz; u.g = 0; return true;
    }
    __device__ __forceinline__ void a_ready(const Unit&) const {}
    __device__ __forceinline__ void done(const Unit&) const {}
};
template <class Epi, class Sched, bool STAMP = false>
__device__ __forceinline__ void gemm_phase(PG8_LAS unsigned char* lds, const Gemm g_in, const Sched& S, const Epi& E, unsigned long long* stamps) {
    Gemm g = g_in;
    { unsigned long long v = (unsigned long long)g.A; g.A = (const bf16_t*)(((unsigned long long)(unsigned)__builtin_amdgcn_readfirstlane((int)(v >> 32)) << 32) | (unsigned)__builtin_amdgcn_readfirstlane((int)v));
      v = (unsigned long long)g.Bt; g.Bt = (const bf16_t*)(((unsigned long long)(unsigned)__builtin_amdgcn_readfirstlane((int)(v >> 32)) << 32) | (unsigned)__builtin_amdgcn_readfirstlane((int)v)); }
    const int tid = opaque_tid(), wid = __builtin_amdgcn_readfirstlane(tid >> 6), lane = tid & 63, wr = wid >> 2, wc = wid & 3, fr = lane & 15, fq = lane >> 4;
    int K = g.K; asm volatile("" : "+s"(K));
    const int nt = K / BK;
    int ts_lo = 0, ts_hi = 0, nts = 0; const unsigned long long rt_entry = STAMP ? (unsigned long long)wall_clock64() : 0ull;
#define PG8_STAMP() do { if (STAMP && wid == 0 && nts < 64) { const unsigned long long _c = (unsigned long long)clock64(); \
        ts_lo = (lane == nts) ? (int)(unsigned)_c : ts_lo; ts_hi = (lane == nts) ? (int)(unsigned)(_c >> 32) : ts_hi; ++nts; } } while (0)
    PG8_STAMP();
    unsigned voffA[2], voffB[2];
#pragma unroll
    for (int i = 0; i < 2; ++i) { int R, C; stage_rc(tid * 16 + i * 8192, R, C); const int Rb = Epi::PERM ? ((R & ~31) + perm32(R & 31)) : R;
        voffA[i] = (unsigned)(R * K + C) * 2u; voffB[i] = (unsigned)(Rb * K + C) * 2u; }
    const size_t kstep = (size_t)(BK * 2);
    const size_t hstep = (size_t)HALF * K * 2;
    const size_t tstep = 2 * hstep;
    const unsigned ldsw = (unsigned)wid * 1024u;
    const int aoff = lds_byte(wr * 64 + fr, fq * 8), boff = lds_byte(wc * 32 + fr, fq * 8);
#define PG8_SA(b, h) (((b) * 2 + (h)) * HTB)
#define PG8_SB(b, h) ((4 + (b) * 2 + (h)) * HTB)
#define PG8_STAGE(bufoff, gbase, voff) do { _Pragma("unroll") for (int _i = 0; _i < 2; ++_i) \
        __builtin_amdgcn_global_load_lds((const unsigned*)((const char*)(gbase) + (voff)[_i]), (PG8_LAS unsigned*)(lds + (bufoff) + ldsw + _i * 8192), 16, 0, 0); } while (0)
#define PG8_LDA(dst, b, h) do { _Pragma("unroll") for (int m = 0; m < 4; ++m) _Pragma("unroll") for (int k = 0; k < 2; ++k) dst[m][k] = *(const PG8_LAS bf16x8*)(lds + PG8_SA(b, h) + aoff + m * 2048 + k * 1024); } while (0)
#define PG8_LDB(dst, b, h) do { _Pragma("unroll") for (int n = 0; n < 2; ++n) _Pragma("unroll") for (int k = 0; k < 2; ++k) dst[n][k] = *(const PG8_LAS bf16x8*)(lds + PG8_SB(b, h) + boff + n * 2048 + k * 1024); } while (0)
#define PG8_MMA(ai, bj, At, Bt) do { __builtin_amdgcn_s_setprio(1); _Pragma("unroll") for (int m = 0; m < 4; ++m) _Pragma("unroll") for (int n = 0; n < 2; ++n) _Pragma("unroll") for (int k = 0; k < 2; ++k) \
        acc[ai][bj][m][n] = __builtin_amdgcn_mfma_f32_16x16x32_bf16(Bt[n][k], At[m][k], acc[ai][bj][m][n], 0, 0, 0); __builtin_amdgcn_s_setprio(0); } while (0)
#define PG8_WAIT_V(n) asm volatile("s_waitcnt vmcnt(" #n ")" ::: "memory")
#define PG8_WAIT_L(n) asm volatile("s_waitcnt lgkmcnt(" #n ")" ::: "memory")
#define PG8_BAR __builtin_amdgcn_s_barrier()
#define PG8_SCHED __builtin_amdgcn_sched_barrier(0)
    Unit cur, nxt; int ui = 0;
    if (!S.next(0, cur)) return;
    f32x4 acc[2][2][4][2];
#pragma unroll
    for (int a = 0; a < 2; ++a)
#pragma unroll
        for (int b = 0; b < 2; ++b)
#pragma unroll
            for (int m = 0; m < 4; ++m)
#pragma unroll
                for (int n = 0; n < 2; ++n) acc[a][b][m][n] = (f32x4){0.f, 0.f, 0.f, 0.f};
    bf16x8 At[4][2], B0[2][2], B1[2][2];
    const char* cA = (const char*)g.A + (size_t)cur.pm * tstep + (size_t)cur.g * g.gsA; const char* cB = (const char*)g.Bt + (size_t)cur.pn * tstep + (size_t)cur.g * g.gsB;
    S.a_ready(cur);
    PG8_STAGE(PG8_SB(0, 0), cB, voffB); PG8_STAGE(PG8_SA(0, 0), cA, voffA); PG8_STAGE(PG8_SB(0, 1), cB + hstep, voffB); PG8_STAGE(PG8_SA(0, 1), cA + hstep, voffA);
    if (wr == 1) PG8_BAR;
    PG8_WAIT_V(4); PG8_BAR;
    PG8_STAGE(PG8_SB(1, 0), cB + kstep, voffB); PG8_STAGE(PG8_SA(1, 0), cA + kstep, voffA); PG8_STAGE(PG8_SB(1, 1), cB + hstep + kstep, voffB);
    PG8_WAIT_V(6); PG8_BAR;
    PG8_STAMP();
    for (;;) {
        const bool has_next = S.next(ui + 1, nxt);
        const char* nA = has_next ? (const char*)g.A + (size_t)nxt.pm * tstep + (size_t)nxt.g * g.gsA : cA; const char* nB = has_next ? (const char*)g.Bt + (size_t)nxt.pn * tstep + (size_t)nxt.g * g.gsB : cB;
        for (int t = 0; t < nt; t += 2) {
            const bool last = (t == nt - 2);
            const char* a1 = cA + (size_t)(t + 1) * kstep;
            const char* a2 = last ? nA : cA + (size_t)(t + 2) * kstep; const char* b2 = last ? nB : cB + (size_t)(t + 2) * kstep;
            const char* a3 = a2 + kstep; const char* b3 = b2 + kstep;
            if (last && has_next) S.a_ready(nxt);
            PG8_LDB(B0, 0, 0); PG8_SCHED; PG8_LDA(At, 0, 0); PG8_STAGE(PG8_SA(1, 1), a1 + hstep, voffA);
            PG8_WAIT_L(8); PG8_BAR; PG8_WAIT_L(0); PG8_MMA(0, 0, At, B0); PG8_BAR; PG8_SCHED;
            PG8_LDB(B1, 0, 1); PG8_STAGE(PG8_SB(0, 0), b2, voffB);
            PG8_BAR; PG8_WAIT_L(0); PG8_MMA(0, 1, At, B1); PG8_BAR;
            PG8_LDA(At, 0, 1); PG8_STAGE(PG8_SA(0, 0), a2, voffA);
            PG8_BAR; PG8_WAIT_L(0); PG8_MMA(1, 0, At, B0); PG8_BAR; PG8_SCHED;
            PG8_STAGE(PG8_SB(0, 1), b2 + hstep, voffB);
            PG8_WAIT_V(6); PG8_BAR; PG8_MMA(1, 1, At, B1); PG8_BAR;
            PG8_LDB(B0, 1, 0); PG8_SCHED; PG8_LDA(At, 1, 0); PG8_STAGE(PG8_SA(0, 1), a2 + hstep, voffA);
            PG8_WAIT_L(8); PG8_BAR; PG8_WAIT_L(0); PG8_MMA(0, 0, At, B0); PG8_BAR; PG8_SCHED;
            PG8_LDB(B1, 1, 1); PG8_STAGE(PG8_SB(1, 0), b3, voffB);
            PG8_BAR; PG8_WAIT_L(0); PG8_MMA(0, 1, At, B1); PG8_BAR;
            PG8_LDA(At, 1, 1); PG8_STAGE(PG8_SA(1, 0), a3, voffA);
            PG8_BAR; PG8_WAIT_L(0); PG8_MMA(1, 0, At, B0); PG8_BAR; PG8_SCHED;
            PG8_STAGE(PG8_SB(1, 1), b3 + hstep, voffB);
            PG8_WAIT_V(6); PG8_BAR; PG8_MMA(1, 1, At, B1); PG8_BAR;
        }
        PG8_STAMP();
        if constexpr (!Epi::AFTER_DRAIN) { E(acc, cur, wr, wc, fr, fq); S.done(cur); }
        PG8_STAMP();
        if (!has_next) break;
#pragma unroll
        for (int a = 0; a < 2; ++a)
#pragma unroll
            for (int b = 0; b < 2; ++b)
#pragma unroll
                for (int m = 0; m < 4; ++m)
#pragma unroll
                    for (int n = 0; n < 2; ++n) acc[a][b][m][n] = (f32x4){0.f, 0.f, 0.f, 0.f};
        cur = nxt; cA = nA; cB = nB; ++ui;
    }
    PG8_WAIT_V(0);
    if (wr == 0) PG8_BAR;
    PG8_BAR;
    if constexpr (Epi::AFTER_DRAIN) { E.fused(acc, cur, wr, wc, fr, fq, lds, wid, lane); S.done(cur); }
    PG8_STAMP();
    if (STAMP && wid == 0) { stamps[lane] = lane < nts ? (((unsigned long long)(unsigned)ts_hi << 32) | (unsigned)ts_lo) : 0ull;
        if (lane == 62) stamps[62] = rt_entry; if (lane == 63) stamps[63] = (unsigned long long)wall_clock64(); }
#undef PG8_STAMP
#undef PG8_SA
#undef PG8_SB
#undef PG8_STAGE
#undef PG8_LDA
#undef PG8_LDB
#undef PG8_MMA
#undef PG8_WAIT_V
#undef PG8_WAIT_L
#undef PG8_BAR
#undef PG8_SCHED
}
}
using pg8::bf16_t; using pg8::bf16x8; using pg8::f32x4; using pg8::u32x4;
#define DI __device__ __forceinline__
typedef float f32x16 __attribute__((ext_vector_type(16)));
typedef float f32x2 __attribute__((ext_vector_type(2)));
typedef short s16x4 __attribute__((ext_vector_type(4)));
typedef unsigned u32x2 __attribute__((ext_vector_type(2)));
typedef __bf16 bfv2 __attribute__((ext_vector_type(2)));

constexpr int T = 16384, SEQ = 2048, DM = 1024, NIN = 12552, NU = 12544;
constexpr float EPS = 1e-6f, LOG2E = 1.4426950408889634f;
constexpr int U_QA = 0, U_KA = 512, U_VA = 1024, U_OA = 1536, U_ZA = 2048, U_XB = 2560, U_ZB = 3072, U_QC = 3584, U_KC = 4096, U_VC = 4224, U_ZC = 4352,
              U_QD = 4864, U_FD = 5376, U_ID = 5888, U_ZD = 6400, U_QE = 6912, U_ZE = 7168, U_G = 7424;
constexpr size_t WS_WIN = 0, SZ_WIN1 = (size_t)NU * 1024 * 2, SZ_WIN = 2 * SZ_WIN1;
constexpr size_t WS_WBR = WS_WIN + SZ_WIN, SZ_WBR = (size_t)4 * 2304 * 1024 * 2;
constexpr size_t WS_WOUT = WS_WBR + SZ_WBR, SZ_WOUT = (size_t)4 * 1024 * 1024 * 2;
constexpr size_t WS_KVM = WS_WOUT + SZ_WOUT, SZ_KVM = (size_t)2048 * 2048 * 2;
constexpr size_t WS_H = WS_KVM + SZ_KVM, SZ_H = (size_t)T * 1024 * 2;
constexpr size_t WS_IF = WS_H + SZ_H, SZ_IF = (size_t)T * 8 * 4;
constexpr size_t WS_LB = WS_IF + SZ_IF, SZ_LB = 4 * 512 * 4;
constexpr size_t WS_NA = WS_LB + SZ_LB, SZ_NA = 512 * 128 * 4;
constexpr size_t WS_GA = WS_NA + SZ_NA, SZ_GA = 512 * 4;
constexpr size_t WS_DECD = WS_GA + SZ_GA, SZ_DECD = 1024 * 128 * 4;
constexpr size_t WS_CARB = WS_DECD + SZ_DECD, SZ_CARB = 256 * 512 * 4;
constexpr size_t WS_U = WS_CARB + SZ_CARB, SZ_U = (size_t)T * NU * 2;
constexpr size_t WS_MEMN = WS_U, WS_WMEM = WS_U + (size_t)2048 * 1024 * 2;
constexpr size_t WS_YS = WS_U + SZ_U;
constexpr size_t WS_YA = WS_YS, WS_YB = WS_YA + (size_t)T * 512 * 2, WS_YC = WS_YB + (size_t)T * 512 * 2, WS_YD = WS_YC + (size_t)T * 512 * 2, WS_YE = WS_YD + (size_t)T * 512 * 2;
constexpr size_t WS_ST = WS_YE + (size_t)T * 256 * 2;
constexpr size_t WS_STA = WS_ST, WS_STD = WS_STA + (size_t)512 * 16384 * 4, WS_LRUH = WS_STD + (size_t)1024 * 16384 * 4, WS_LRUA = WS_LRUH + (size_t)T * 512 * 4;
constexpr size_t WS_YF = WS_ST;
constexpr size_t WS_BAR = WS_LRUA + (size_t)T * 512 * 4;
constexpr size_t WS_END = WS_BAR + 16384;
constexpr int LDS_BYTES = 155648;

struct Params {
    const float* x; const float* mem; const int* pos; const float* norm_g; const float* w_in; const float* mconv_w; const float* b_if; const float* mnorm_g;
    const float* lconv_w; const float* lconv_b; const float* wa; const float* ba; const float* wx; const float* bx; const float* lam; const float* sinks;
    const float* hlb; const float* hnorm_g; const float* mem_g; const float* w_mem; const float* w_br; const float* w_out; const float* fin_g;
    float* out; unsigned char* ws;
};

DI size_t uoff(size_t tok, int col) { return (((tok >> 8) * 49 + (size_t)(col >> 8)) << 16) + ((tok & 255) << 8) + (size_t)(col & 255); }
DI float bf2f(bf16_t b) { return __uint_as_float(((unsigned)b) << 16); }
DI float bflo(unsigned v) { return __uint_as_float(v << 16); }
DI float bfhi(unsigned v) { return __uint_as_float(v & 0xffff0000u); }
DI unsigned pack2(float lo, float hi) { f32x2 v = {lo, hi}; bfv2 b = __builtin_convertvector(v, bfv2); return __builtin_bit_cast(unsigned, b); }
DI bf16_t f2bf(float f) { return (bf16_t)(pack2(f, 0.f) & 0xffffu); }
DI float fexp_(float x) { return __builtin_amdgcn_exp2f(x * LOG2E); }
DI float sigmoidf_(float x) { return __builtin_amdgcn_rcpf(1.0f + fexp_(-x)); }
DI float siluf_(float x) { return x * sigmoidf_(x); }
DI float logsigf_(float x) { return fminf(x, 0.f) - log1pf(fexp_(-fabsf(x))); }
DI float wave_sum(float v) {
    int x = __float_as_int(v);
    x = __float_as_int(__int_as_float(x) + __int_as_float(__builtin_amdgcn_update_dpp(0, x, 0x128, 0xf, 0xf, false)));
    x = __float_as_int(__int_as_float(x) + __int_as_float(__builtin_amdgcn_update_dpp(0, x, 0x124, 0xf, 0xf, false)));
    x = __float_as_int(__int_as_float(x) + __int_as_float(__builtin_amdgcn_update_dpp(0, x, 0x122, 0xf, 0xf, false)));
    x = __float_as_int(__int_as_float(x) + __int_as_float(__builtin_amdgcn_update_dpp(0, x, 0x121, 0xf, 0xf, false)));
    const float r0 = __int_as_float(__builtin_amdgcn_readlane(x, 0)), r1 = __int_as_float(__builtin_amdgcn_readlane(x, 16)), r2 = __int_as_float(__builtin_amdgcn_readlane(x, 32)), r3 = __int_as_float(__builtin_amdgcn_readlane(x, 48));
    return (r0 + r1) + (r2 + r3);
}
DI int crow(int i, int h) { return (i & 3) + 8 * (i >> 2) + 4 * h; }

template <int MT, int NT> DI void mma_lds(f32x16 (&acc)[MT][NT], const bf16_t* A, int lda, const bf16_t* B, int ldb, int K, int lane) {
    const int r = lane & 31, h = lane >> 5;
    for (int k0 = 0; k0 < K; k0 += 16) {
        bf16x8 a[MT], b[NT];
#pragma unroll
        for (int mt = 0; mt < MT; ++mt) a[mt] = *(const bf16x8*)(A + (32 * mt + r) * lda + k0 + 8 * h);
#pragma unroll
        for (int nt = 0; nt < NT; ++nt) b[nt] = *(const bf16x8*)(B + (32 * nt + r) * ldb + k0 + 8 * h);
#pragma unroll
        for (int mt = 0; mt < MT; ++mt)
#pragma unroll
            for (int nt = 0; nt < NT; ++nt) acc[mt][nt] = __builtin_amdgcn_mfma_f32_32x32x16_bf16(a[mt], b[nt], acc[mt][nt], 0, 0, 0);
    }
}
template <int MT, int NT> DI void zero_acc(f32x16 (&acc)[MT][NT]) {
#pragma unroll
    for (int mt = 0; mt < MT; ++mt)
#pragma unroll
        for (int nt = 0; nt < NT; ++nt)
#pragma unroll
            for (int i = 0; i < 16; ++i) acc[mt][nt][i] = 0.f;
}

struct EpiStoreBf16 {
    static constexpr bool PERM = true, AFTER_DRAIN = false;
    bf16_t* O; int ldc; int blocked;
    DI void operator()(const f32x4 (&acc)[2][2][4][2], const pg8::Unit& u, int wr, int wc, int fr, int fq) const {
        const int row0 = u.pm * 256 + wr * 64 + fr, col0 = u.pn * 256 + wc * 32 + 8 * fq;
#pragma unroll
        for (int ai = 0; ai < 2; ++ai)
#pragma unroll
            for (int m = 0; m < 4; ++m) { bf16_t* rowp = blocked ? O + ((size_t)(u.pm * 49 + u.pn) << 16) + (size_t)(wr * 64 + fr + ai * 128 + m * 16) * 256 + wc * 32 + 8 * fq : O + (size_t)(row0 + ai * 128 + m * 16) * ldc + col0;
#pragma unroll
                for (int bj = 0; bj < 2; ++bj) { const f32x4 v0 = acc[ai][bj][m][0], v1 = acc[ai][bj][m][1];
                    u32x4 w; w.x = pack2(v0[0], v0[1]); w.y = pack2(v0[2], v0[3]); w.z = pack2(v1[0], v1[1]); w.w = pack2(v1[2], v1[3]);
                    __builtin_nontemporal_store(w, (u32x4*)(rowp + bj * 128)); } }
    }
};
struct EpiRes {
    static constexpr bool PERM = false, AFTER_DRAIN = false;
    const float* xres; float* out;
    DI void operator()(const f32x4 (&acc)[2][2][4][2], const pg8::Unit& u, int wr, int wc, int fr, int fq) const {
        const int row0 = u.pm * 256 + wr * 64 + fr, col0 = u.pn * 256 + wc * 32 + 4 * fq;
#pragma unroll
        for (int am = 0; am < 4; ++am) { const int ai = am >> 1, m0 = (am & 1) * 2; f32x4 xv[2][2][2];
#pragma unroll
            for (int mm = 0; mm < 2; ++mm) { const size_t r = (size_t)(row0 + ai * 128 + (m0 + mm) * 16);
#pragma unroll
                for (int bj = 0; bj < 2; ++bj)
#pragma unroll
                    for (int n = 0; n < 2; ++n) xv[mm][bj][n] = *(const f32x4*)(xres + r * 1024 + col0 + bj * 128 + n * 16); }
            __builtin_amdgcn_sched_barrier(0);
#pragma unroll
            for (int mm = 0; mm < 2; ++mm) { const size_t r = (size_t)(row0 + ai * 128 + (m0 + mm) * 16);
#pragma unroll
                for (int bj = 0; bj < 2; ++bj)
#pragma unroll
                    for (int n = 0; n < 2; ++n) *(f32x4*)(out + r * 1024 + col0 + bj * 128 + n * 16) = xv[mm][bj][n] + acc[ai][bj][m0 + mm][n]; }
            __builtin_amdgcn_sched_barrier(0); }
    }
};
struct GroupOrder {
    int G, c;
    __device__ bool next(int i, pg8::Unit& u) const { const int tile = c + (i >> 2) * G; if (tile >= 256) return false; pg8::StaticOrder t; t.init(T, 1024, 256, tile); t.next(0, u); u.g = i & 3; return true; }
    DI void a_ready(const pg8::Unit&) const {}
    DI void done(const pg8::Unit&) const {}
};
struct EpiGateAcc {
    static constexpr bool PERM = true, AFTER_DRAIN = false;
    const bf16_t* gates; bf16_t* P; bf16_t* Y16; int goff;
    DI void operator()(const f32x4 (&acc)[2][2][4][2], const pg8::Unit& u, int wr, int wc, int fr, int fq) const {
        const int row0 = u.pm * 256 + wr * 64 + fr, col0 = u.pn * 256 + wc * 32 + 8 * fq, j = u.g + goff;
        const bf16_t* gp = gates + ((size_t)(u.pm * 49 + 29 + 4 * j + u.pn) << 16) + wc * 32 + 8 * fq;   bf16_t* dst = ((j == 4) ? Y16 : P) + col0; const bf16_t* pp = P + col0;
#pragma unroll
        for (int am = 0; am < 4; ++am) { const int ai = am >> 1, m0 = (am & 1) * 2;
            u32x4 gv[4][2], pv[4][2];
#pragma unroll
            for (int m = m0; m < m0 + 2; ++m) { const size_t r = (size_t)(row0 + ai * 128 + m * 16);
#pragma unroll
                for (int bj = 0; bj < 2; ++bj) { gv[m][bj] = *(const u32x4*)(gp + (r & 255) * 256 + bj * 128); pv[m][bj] = (u32x4){0u, 0u, 0u, 0u}; if (j > 0) pv[m][bj] = *(const u32x4*)(pp + r * 1024 + bj * 128); } }
            __builtin_amdgcn_sched_barrier(0);
#pragma unroll
            for (int m = m0; m < m0 + 2; ++m) { const size_t r = (size_t)(row0 + ai * 128 + m * 16);
#pragma unroll
                for (int bj = 0; bj < 2; ++bj) { const u32x4 g4 = gv[m][bj], p4 = pv[m][bj]; const f32x4 a0 = acc[ai][bj][m][0], a1 = acc[ai][bj][m][1]; float o[8];
                    o[0] = a0[0] * sigmoidf_(bflo(g4.x)) + bflo(p4.x); o[1] = a0[1] * sigmoidf_(bfhi(g4.x)) + bfhi(p4.x); o[2] = a0[2] * sigmoidf_(bflo(g4.y)) + bflo(p4.y); o[3] = a0[3] * sigmoidf_(bfhi(g4.y)) + bfhi(p4.y);
                    o[4] = a1[0] * sigmoidf_(bflo(g4.z)) + bflo(p4.z); o[5] = a1[1] * sigmoidf_(bfhi(g4.z)) + bfhi(p4.z); o[6] = a1[2] * sigmoidf_(bflo(g4.w)) + bflo(p4.w); o[7] = a1[3] * sigmoidf_(bfhi(g4.w)) + bfhi(p4.w);
                    u32x4 w; w.x = pack2(o[0], o[1]); w.y = pack2(o[2], o[3]); w.z = pack2(o[4], o[5]); w.w = pack2(o[6], o[7]); *(u32x4*)(dst + r * 1024 + bj * 128) = w; } }
            __builtin_amdgcn_sched_barrier(0);
        }
    }
};
DI void conv_tile(const float* src, int ld_src, int gap_at, int gap_len, const float* scale, bf16_t* dst, int K, int n0, int k0, unsigned char* sm) {
    bf16_t* tl = (bf16_t*)sm;
    const int tid = opaque_tid();
    float vld[16];
#pragma unroll
    for (int i = 0; i < 16; ++i) { const int idx = i * 512 + tid, kk = idx >> 7, nn = idx & 127, n = n0 + nn, col = n + (n >= gap_at ? gap_len : 0);
        vld[i] = src[(size_t)(k0 + kk) * ld_src + col]; }
#pragma unroll
    for (int i = 0; i < 16; ++i) { const int idx = i * 512 + tid, kk = idx >> 7, nn = idx & 127;
        float v = vld[i]; if (scale) v *= scale[k0 + kk];
        tl[nn * 72 + kk] = f2bf(v); }
    __syncthreads();
#pragma unroll
    for (int i = 0; i < 2; ++i) { const int idx = i * 512 + tid, nn = idx >> 3, kc = idx & 7;
        *(u32x4*)(dst + (size_t)(n0 + nn) * K + k0 + kc * 8) = *(const u32x4*)(tl + nn * 72 + kc * 8); }
    __syncthreads();
}
DI void phase_prologue(const Params& p, unsigned char* sm) {
    const int tid = opaque_tid(), wid = tid >> 6, lane = tid & 63;
    bf16_t* WBR = (bf16_t*)(p.ws + WS_WBR); bf16_t* WOUT = (bf16_t*)(p.ws + WS_WOUT); bf16_t* WMEM = (bf16_t*)(p.ws + WS_WMEM); bf16_t* MEMN = (bf16_t*)(p.ws + WS_MEMN);
    for (int t = blockIdx.x; t < 4 * 480; t += gridDim.x) {
        const int l = t / 480, r = t % 480;
        if (r < 288) { int j, tt, Kj; if (r < 256) { j = r >> 6; tt = r & 63; Kj = 512; } else { j = 4; tt = r - 256; Kj = 256; }
            const int nkt = Kj / 64, nt = tt / nkt, kt = tt % nkt; const size_t off = (size_t)l * 2304 * 1024 + (size_t)j * 512 * 1024;
            conv_tile(p.w_br + off, 1024, 1 << 30, 0, nullptr, WBR + off, Kj, nt * 128, kt * 64, sm); }
        else if (r < 416) { const int tt = r - 288, nt = tt >> 4, kt = tt & 15; const size_t off = (size_t)l * 1024 * 1024;
            conv_tile(p.w_out + off, 1024, 1 << 30, 0, nullptr, WOUT + off, 1024, nt * 128, kt * 64, sm); }
        else { const int tt = r - 416, nt = tt >> 4, kt = tt & 15;
            conv_tile(p.w_mem + (size_t)l * 1024 * 512, 512, 1 << 30, 0, p.mem_g + l * 1024, WMEM + (size_t)l * 512 * 1024, 1024, nt * 128, kt * 64, sm); }
    }
    for (int row = blockIdx.x * 8 + wid; row < 2048; row += gridDim.x * 8) {
        const float* xr = p.mem + (size_t)row * 1024; f32x4 v[4]; float ss = 0.f;
#pragma unroll
        for (int i = 0; i < 4; ++i) { v[i] = *(const f32x4*)(xr + i * 256 + lane * 4); ss += v[i][0] * v[i][0] + v[i][1] * v[i][1] + v[i][2] * v[i][2] + v[i][3] * v[i][3]; }
        ss = wave_sum(ss); const float rs = rsqrtf(ss * (1.0f / 1024.0f) + EPS);
#pragma unroll
        for (int i = 0; i < 4; ++i) { u32x2 w; w.x = pack2(v[i][0] * rs, v[i][1] * rs); w.y = pack2(v[i][2] * rs, v[i][3] * rs); *(u32x2*)(MEMN + (size_t)row * 1024 + i * 256 + lane * 4) = w; }
    }
    if (blockIdx.x == 0) { float* LB = (float*)(p.ws + WS_LB); const int ch = tid;
        const float v0 = p.hlb[ch], v1 = p.hlb[512 + ch], v2 = p.hlb[1024 + ch], v3 = p.hlb[1536 + ch];
        const float mx = fmaxf(fmaxf(v0, v1), fmaxf(v2, v3)); const float e0 = expf(v0 - mx), e1 = expf(v1 - mx), e2 = expf(v2 - mx), e3 = expf(v3 - mx); const float inv = 1.0f / (e0 + e1 + e2 + e3);
        LB[ch] = 0.f; LB[512 + ch] = e1 * inv; LB[1024 + ch] = (e1 + e2) * inv; LB[1536 + ch] = (e1 + e2 + e3) * inv; }
}
DI void convert_win(const Params& p, int l, int first, int stride, unsigned char* sm) {
    bf16_t* WIN = (bf16_t*)(p.ws + WS_WIN + (size_t)(l & 1) * SZ_WIN1); const float* wl = p.w_in + (size_t)l * 1024 * NIN;
    for (int t = first; t < 98 * 16; t += stride) conv_tile(wl, NIN, 2560, 8, nullptr, WIN, 1024, (t >> 4) * 128, (t & 15) * 64, sm);
}
DI void phase_norm(const Params& p, int l, const float* xin, unsigned char* sm) {
    const int tid = opaque_tid(), wid = tid >> 6, lane = tid & 63;
    const float* wl = p.w_in + (size_t)l * 1024 * NIN;
    float* wif = (float*)sm;
    for (int i = tid; i < 8192; i += 512) wif[i] = wl[(size_t)(i >> 3) * NIN + 2560 + (i & 7)];
    __syncthreads();
    bf16_t* H = (bf16_t*)(p.ws + WS_H); float* IFp = (float*)(p.ws + WS_IF); const float* g = p.norm_g + l * 1024;
    f32x4 vn[4];
    { const int tok = blockIdx.x * 8 + wid; if (tok < T) {
#pragma unroll
        for (int i = 0; i < 4; ++i) vn[i] = *(const f32x4*)(xin + (size_t)tok * 1024 + i * 256 + lane * 4); } }
    for (int tok = blockIdx.x * 8 + wid; tok < T; tok += gridDim.x * 8) {
        f32x4 v[4]; float ss = 0.f;
#pragma unroll
        for (int i = 0; i < 4; ++i) { v[i] = vn[i]; ss += v[i][0] * v[i][0] + v[i][1] * v[i][1] + v[i][2] * v[i][2] + v[i][3] * v[i][3]; }
        { const int tn = tok + gridDim.x * 8; if (tn < T) {
#pragma unroll
            for (int i = 0; i < 4; ++i) vn[i] = *(const f32x4*)(xin + (size_t)tn * 1024 + i * 256 + lane * 4); } }
        ss = wave_sum(ss); const float rs = rsqrtf(ss * (1.0f / 1024.0f) + EPS);
        float d0 = 0.f, d1 = 0.f, d2 = 0.f, d3 = 0.f, d4 = 0.f, d5 = 0.f, d6 = 0.f, d7 = 0.f;
#pragma unroll
        for (int i = 0; i < 4; ++i) { const int c0 = i * 256 + lane * 4; const f32x4 gv = *(const f32x4*)(g + c0); f32x4 hv;
#pragma unroll
            for (int j = 0; j < 4; ++j) { hv[j] = v[i][j] * rs * gv[j]; const f32x4 wa_ = *(const f32x4*)(wif + (c0 + j) * 8), wb_ = *(const f32x4*)(wif + (c0 + j) * 8 + 4);
                d0 += hv[j] * wa_[0]; d1 += hv[j] * wa_[1]; d2 += hv[j] * wa_[2]; d3 += hv[j] * wa_[3]; d4 += hv[j] * wb_[0]; d5 += hv[j] * wb_[1]; d6 += hv[j] * wb_[2]; d7 += hv[j] * wb_[3]; }
            u32x2 w; w.x = pack2(hv[0], hv[1]); w.y = pack2(hv[2], hv[3]); *(u32x2*)(H + (size_t)tok * 1024 + c0) = w; }
        d0 = wave_sum(d0); d1 = wave_sum(d1); d2 = wave_sum(d2); d3 = wave_sum(d3); d4 = wave_sum(d4); d5 = wave_sum(d5); d6 = wave_sum(d6); d7 = wave_sum(d7);
        if (lane == 0) { f32x4 a = {d0, d1, d2, d3}, b = {d4, d5, d6, d7}; *(f32x4*)(IFp + (size_t)tok * 8) = a; *(f32x4*)(IFp + (size_t)tok * 8 + 4) = b; }
    }
    __syncthreads();
}
DI void phase_final_norm(const Params& p) {
    const int tid = opaque_tid(), wid = tid >> 6, lane = tid & 63;
    for (int tok = blockIdx.x * 8 + wid; tok < T; tok += gridDim.x * 8) {
        float* xr = p.out + (size_t)tok * 1024; f32x4 v[4]; float ss = 0.f;
#pragma unroll
        for (int i = 0; i < 4; ++i) { v[i] = *(const f32x4*)(xr + i * 256 + lane * 4); ss += v[i][0] * v[i][0] + v[i][1] * v[i][1] + v[i][2] * v[i][2] + v[i][3] * v[i][3]; }
        ss = wave_sum(ss); const float rs = rsqrtf(ss * (1.0f / 1024.0f) + EPS);
#pragma unroll
        for (int i = 0; i < 4; ++i) { const f32x4 gv = *(const f32x4*)(p.fin_g + i * 256 + lane * 4); f32x4 o = v[i] * rs * gv; *(f32x4*)(xr + i * 256 + lane * 4) = o; }
    }
}
template <int R> DI void transpose_pairs(const unsigned* N, int ldn, bf16_t* Tt, int ldt, int tid) {
    constexpr int CPT = 64 * R / 512; const int r = tid & (R - 1), cq = tid / R;
#pragma unroll
    for (int i = 0; i < CPT; ++i) { const int c = cq * CPT + i; const unsigned w = N[r * ldn + c]; Tt[(2 * c) * ldt + r] = (bf16_t)(w & 0xffffu); Tt[(2 * c + 1) * ldt + r] = (bf16_t)(w >> 16); }
}
DI void mlstm_gates(const Params& p, int l, int h, int tok0, float* sg, float* sig, float* stmp) {
    const int tid = opaque_tid(); const float* IFp = (const float*)(p.ws + WS_IF);
    float lf = 0.f;
    if (tid < 128) { const size_t tok = (size_t)(tok0 + tid);
        sig[tid] = IFp[tok * 8 + h] + p.b_if[l * 8 + h];
        lf = logsigf_(IFp[tok * 8 + 4 + h] + p.b_if[l * 8 + 4 + h]);
#pragma unroll
        for (int o = 1; o < 64; o <<= 1) { const float n = __shfl_up(lf, o); if ((tid & 63) >= o) lf += n; }
        if (tid == 63) stmp[0] = lf; }
    __syncthreads();
    if (tid < 128) { if (tid >= 64) lf += stmp[0]; sg[tid] = lf; }
    __syncthreads();
}
DI void load_win19(const bf16_t* U, int b, int tseq0, int ch, unsigned (&xs)[19]) {
    const size_t t0 = (size_t)(b * SEQ + tseq0);
    const bool has_prev = tseq0 >= 3;
    xs[0] = 0u; xs[1] = 0u; xs[2] = 0u;
    if (has_prev) { xs[0] = *(const unsigned*)(U + uoff(t0 - 3, ch)); xs[1] = *(const unsigned*)(U + uoff(t0 - 2, ch)); xs[2] = *(const unsigned*)(U + uoff(t0 - 1, ch)); }
    const bf16_t* pb = U + uoff(t0, ch);
#pragma unroll
    for (int m = 3; m < 19; ++m) xs[m] = *(const unsigned*)(pb + (m - 3) * 256);
}
DI void conv_win(const unsigned (&xs)[19], int i, const float (&w0)[4], const float (&w1)[4], float& y0, float& y1) {
    float a0 = 0.f, a1 = 0.f;
#pragma unroll
    for (int k = 0; k < 4; ++k) { a0 += w0[k] * bflo(xs[i + k]); a1 += w1[k] * bfhi(xs[i + k]); }
    y0 = siluf_(a0); y1 = siluf_(a1);
}
DI void mlstm_local_unit(const Params& p, int l, int ua, unsigned char* sm) {
    const int tid = opaque_tid(), wid = tid >> 6, lane = tid & 63;
    const int bh = ua >> 4, c = ua & 15, b = bh >> 2, h = bh & 3, tok0 = b * SEQ + c * 128;
    float* sg = (float*)sm; float* sig = sg + 128; float* stmp = sg + 256;
    bf16_t* KwT = (bf16_t*)(sm + 2048); bf16_t* VT = (bf16_t*)(sm + 2048 + 34816);
    const bf16_t* U = (const bf16_t*)(p.ws + WS_U);
    unsigned* N1 = (unsigned*)(sm + 71680); unsigned* N2 = (unsigned*)(sm + 104960);
    { const int dp = tid & 63, d = 2 * dp, ch = 512 + h * 128 + d; float w0[4], w1[4];
#pragma unroll
      for (int k = 0; k < 4; ++k) { w0[k] = p.mconv_w[(size_t)l * 4096 + k * 1024 + ch]; w1[k] = p.mconv_w[(size_t)l * 4096 + k * 1024 + ch + 1]; }
      unsigned xs[19]; load_win19(U, b, c * 128 + 16 * wid, ch, xs);
      unsigned vv[16];
#pragma unroll
      for (int i = 0; i < 16; ++i) vv[i] = *(const unsigned*)(U + uoff((size_t)(tok0 + 16 * wid), U_VA + h * 128 + d) + i * 256);
      mlstm_gates(p, l, h, tok0, sg, sig, stmp);
      const float G_ = sg[127];
#pragma unroll
      for (int i = 0; i < 16; ++i) { const int r = 16 * wid + i; float y0, y1; conv_win(xs, i, w0, w1, y0, y1);
          const float wr_ = fexp_(G_ - sg[r] + sig[r]);
          N1[r * 65 + dp] = pack2(y0 * wr_, y1 * wr_); N2[r * 65 + dp] = vv[i]; } }
    const float G = sg[127];
    __syncthreads();
    transpose_pairs<128>(N1, 65, KwT, 136, tid); transpose_pairs<128>(N2, 65, VT, 136, tid);
    __syncthreads();
    f32x16 acc[1][2]; zero_acc<1, 2>(acc);
    const int dt = wid & 3, eh = wid >> 2;
    mma_lds<1, 2>(acc, KwT + 32 * dt * 136, 136, VT + 64 * eh * 136, 136, 128, lane);
    bf16_t* ST = (bf16_t*)(p.ws + WS_STA) + (size_t)ua * 16384;
    { const int r31 = lane & 31, hh = lane >> 5;
#pragma unroll
      for (int nt = 0; nt < 2; ++nt) { const int e = 64 * eh + 32 * nt + r31;
#pragma unroll
          for (int q4 = 0; q4 < 4; ++q4) { const int d0 = 32 * dt + 8 * q4 + 4 * hh; f32x4 v = {acc[0][nt][4 * q4], acc[0][nt][4 * q4 + 1], acc[0][nt][4 * q4 + 2], acc[0][nt][4 * q4 + 3]};
              u32x2 w; w.x = pack2(v[0], v[1]); w.y = pack2(v[2], v[3]); *(u32x2*)(ST + e * 128 + d0) = w; } } }
    { const int d = tid >> 2, qd = tid & 3; float s = 0.f;
#pragma unroll
      for (int i = 0; i < 4; ++i) { const u32x4 v = *(const u32x4*)(KwT + d * 136 + 32 * qd + 8 * i); s += bflo(v.x) + bfhi(v.x) + bflo(v.y) + bfhi(v.y) + bflo(v.z) + bfhi(v.z) + bflo(v.w) + bfhi(v.w); }
      s += __shfl_xor(s, 1); s += __shfl_xor(s, 2);
      if (qd == 0) ((float*)(p.ws + WS_NA))[ua * 128 + d] = s; }
    if (tid == 0) ((float*)(p.ws + WS_GA))[ua] = G;
    __syncthreads();
}
DI void mlstm_scan(const Params& p) {
    const int gt = blockIdx.x * 512 + opaque_tid(), nth = gridDim.x * 512; const float* GA = (const float*)(p.ws + WS_GA);
    for (int it = gt; it < 32 * 4096; it += nth) { const int bh = it >> 12, v = it & 4095; u32x2* base = (u32x2*)((bf16_t*)(p.ws + WS_STA) + (size_t)bh * 16 * 16384) + v;
        u32x2 tmp[16]; float eg[16];
#pragma unroll
        for (int c = 0; c < 16; ++c) { tmp[c] = base[(size_t)c * 4096]; eg[c] = fexp_(GA[bh * 16 + c]); }
        f32x4 S = {0.f, 0.f, 0.f, 0.f};
#pragma unroll
        for (int c = 0; c < 16; ++c) { u32x2 w; w.x = pack2(S[0], S[1]); w.y = pack2(S[2], S[3]); base[(size_t)c * 4096] = w;
            const f32x4 t = {bflo(tmp[c].x), bfhi(tmp[c].x), bflo(tmp[c].y), bfhi(tmp[c].y)}; S = S * eg[c] + t; } }
    for (int it = gt; it < 32 * 32; it += nth) { const int bh = it >> 5, v = it & 31; f32x4* base = (f32x4*)((float*)(p.ws + WS_NA) + (size_t)bh * 16 * 128) + v;
        f32x4 tmp[16]; float eg[16];
#pragma unroll
        for (int c = 0; c < 16; ++c) { tmp[c] = base[c * 32]; eg[c] = fexp_(GA[bh * 16 + c]); }
        f32x4 S = {0.f, 0.f, 0.f, 0.f};
#pragma unroll
        for (int c = 0; c < 16; ++c) { base[c * 32] = S; S = S * eg[c] + tmp[c]; } }
}
DI void mlstm_out_unit(const Params& p, int l, int ua, unsigned char* sm) {
    const int tid = opaque_tid(), wid = tid >> 6, lane = tid & 63, r31 = lane & 31, hh = lane >> 5;
    const int bh = ua >> 4, c = ua & 15, b = bh >> 2, h = bh & 3, tok0 = b * SEQ + c * 128;
    float* sg = (float*)sm; float* sig = sg + 128; float* sden = sg + 256; float* snp = sg + 384;
    bf16_t* Q = (bf16_t*)(sm + 2048); bf16_t* KP = (bf16_t*)(sm + 36864); bf16_t* VT = (bf16_t*)(sm + 71680); bf16_t* STs = (bf16_t*)(sm + 106496);
    float* Hs = (float*)(sm + 2048);
    const bf16_t* U = (const bf16_t*)(p.ws + WS_U);
    unsigned* N2 = (unsigned*)(sm + 106496);
    unsigned fov[16], fzv[16];
#pragma unroll
    for (int jj = 0; jj < 16; ++jj) { const size_t tk = (size_t)(tok0 + wid * 16); fov[jj] = *(const unsigned*)(U + uoff(tk, U_OA + h * 128 + 2 * lane) + jj * 256); fzv[jj] = *(const unsigned*)(U + uoff(tk, U_ZA + h * 128 + 2 * lane) + jj * 256); }
    u32x4 stv[4];
    { const bf16_t* ST = (const bf16_t*)(p.ws + WS_STA) + (size_t)ua * 16384;
#pragma unroll
      for (int i = 0; i < 4; ++i) { const int idx = i * 512 + tid, e = idx >> 4, d8 = (idx & 15) * 8; stv[i] = *(const u32x4*)(ST + e * 128 + d8); } }
    { const int dp = tid & 63, d = 2 * dp, chq = h * 128 + d, chk = 512 + chq; float wq0[4], wq1[4], wk0[4], wk1[4];
#pragma unroll
      for (int k = 0; k < 4; ++k) { wq0[k] = p.mconv_w[(size_t)l * 4096 + k * 1024 + chq]; wq1[k] = p.mconv_w[(size_t)l * 4096 + k * 1024 + chq + 1];
                                    wk0[k] = p.mconv_w[(size_t)l * 4096 + k * 1024 + chk]; wk1[k] = p.mconv_w[(size_t)l * 4096 + k * 1024 + chk + 1]; }
      unsigned xq[19], xk[19]; load_win19(U, b, c * 128 + 16 * wid, chq, xq); load_win19(U, b, c * 128 + 16 * wid, chk, xk);
      unsigned vv[16];
#pragma unroll
      for (int i = 0; i < 16; ++i) vv[i] = *(const unsigned*)(U + uoff((size_t)(tok0 + 16 * wid), U_VA + h * 128 + d) + i * 256);
      mlstm_gates(p, l, h, tok0, sg, sig, sden);
      __builtin_amdgcn_sched_barrier(0);
#pragma unroll
      for (int i = 0; i < 16; ++i) { const int r = 16 * wid + i; float y0, y1;
          conv_win(xq, i, wq0, wq1, y0, y1); *(unsigned*)(Q + r * 136 + d) = pack2(y0 * 0.08838834764831845f, y1 * 0.08838834764831845f);
          if ((i & 3) == 3) __builtin_amdgcn_sched_barrier(0); }
#pragma unroll
      for (int i = 0; i < 16; ++i) { const int r = 16 * wid + i; float y0, y1;
          conv_win(xk, i, wk0, wk1, y0, y1); *(unsigned*)(KP + r * 136 + d) = pack2(y0, y1);
          if ((i & 3) == 3) __builtin_amdgcn_sched_barrier(0); }
#pragma unroll
      for (int i = 0; i < 16; ++i) N2[(16 * wid + i) * 65 + dp] = vv[i];
      __builtin_amdgcn_sched_barrier(0); }
    if (tid < 128) snp[tid] = ((const float*)(p.ws + WS_NA))[ua * 128 + tid];
    __syncthreads();
    const int jt = wid & 3, ch2 = wid >> 2;
    f32x16 acc[1][2]; zero_acc<1, 2>(acc);
    mma_lds<1, 2>(acc, Q + 32 * jt * 136, 136, KP + 64 * ch2 * 136, 136, 128, lane);
    transpose_pairs<128>(N2, 65, VT, 136, tid);
    __syncthreads();
#pragma unroll
    for (int i = 0; i < 4; ++i) { const int idx = i * 512 + tid, e = idx >> 4, d8 = (idx & 15) * 8; *(u32x4*)(STs + e * 136 + d8) = stv[i]; }
#pragma unroll
    for (int nt = 0; nt < 2; ++nt) { const int r = 64 * ch2 + 32 * nt + r31; const float gr = sg[r], ir = sig[r];
#pragma unroll
        for (int i = 0; i < 16; ++i) { const int j = 32 * jt + crow(i, hh); const float val = (r <= j) ? acc[0][nt][i] * fexp_(sg[j] - gr + ir) : 0.f; KP[j * 136 + r] = f2bf(val); } }
    __syncthreads();
    f32x16 apv[1][2], aqs[1][2]; zero_acc<1, 2>(apv); zero_acc<1, 2>(aqs);
    mma_lds<1, 2>(apv, KP + 32 * jt * 136, 136, VT + 64 * ch2 * 136, 136, 128, lane);
    mma_lds<1, 2>(aqs, Q + 32 * jt * 136, 136, STs + 64 * ch2 * 136, 136, 128, lane);
    { const int j = tid >> 2, qd = tid & 3; float s1 = 0.f, s2 = 0.f;
#pragma unroll
      for (int i = 0; i < 4; ++i) { const u32x4 pv = *(const u32x4*)(KP + j * 136 + 32 * qd + 8 * i), qv = *(const u32x4*)(Q + j * 136 + 32 * qd + 8 * i);
          const f32x4 n0 = *(const f32x4*)(snp + 32 * qd + 8 * i), n1 = *(const f32x4*)(snp + 32 * qd + 8 * i + 4);
          s1 += bflo(pv.x) + bfhi(pv.x) + bflo(pv.y) + bfhi(pv.y) + bflo(pv.z) + bfhi(pv.z) + bflo(pv.w) + bfhi(pv.w);
          s2 += bflo(qv.x) * n0[0] + bfhi(qv.x) * n0[1] + bflo(qv.y) * n0[2] + bfhi(qv.y) * n0[3] + bflo(qv.z) * n1[0] + bfhi(qv.z) * n1[1] + bflo(qv.w) * n1[2] + bfhi(qv.w) * n1[3]; }
      s1 += __shfl_xor(s1, 1); s1 += __shfl_xor(s1, 2); s2 += __shfl_xor(s2, 1); s2 += __shfl_xor(s2, 2);
      if (qd == 0) sden[j] = s1 + fexp_(sg[j]) * s2; }
    __syncthreads();
#pragma unroll
    for (int nt = 0; nt < 2; ++nt) { const int e = 64 * ch2 + 32 * nt + r31;
#pragma unroll
        for (int i = 0; i < 16; ++i) { const int j = 32 * jt + crow(i, hh); const float num = apv[0][nt][i] + fexp_(sg[j]) * aqs[0][nt][i]; Hs[j * 132 + e] = num * __builtin_amdgcn_rcpf(fmaxf(fabsf(sden[j]), 1.0f)); } }
    __syncthreads();
    { bf16_t* YA = (bf16_t*)(p.ws + WS_YA); const int e = 2 * lane; const float g0 = p.mnorm_g[l * 512 + h * 128 + e], g1 = p.mnorm_g[l * 512 + h * 128 + e + 1];
#pragma unroll
      for (int jj = 0; jj < 16; ++jj) { const int j = wid * 16 + jj; const f32x2 v = *(const f32x2*)(Hs + j * 132 + e); const float ss = wave_sum(v[0] * v[0] + v[1] * v[1]); const float rs = rsqrtf(ss * (1.0f / 128.0f) + EPS);
          const size_t tok = (size_t)(tok0 + j);
          *(unsigned*)(YA + tok * 512 + h * 128 + e) = pack2(v[0] * rs * g0 * sigmoidf_(bflo(fov[jj])) * siluf_(bflo(fzv[jj])), v[1] * rs * g1 * sigmoidf_(bfhi(fov[jj])) * siluf_(bfhi(fzv[jj]))); } }
    __syncthreads();
}
struct HgIn { unsigned fv[8], qv[8], vv[8], zv[8]; float lb0, lb1; };
template <bool WITH_Q> DI void hgrn_issue(const Params& p, int l, int ud, HgIn& in) {
    const int tid = opaque_tid(), wid = tid >> 6; const int bh = ud >> 5, c = ud & 31, b = bh >> 2, h = bh & 3, tok0 = b * SEQ + c * 64, d = 2 * (tid & 63);
    const bf16_t* U = (const bf16_t*)(p.ws + WS_U); const float* LB = (const float*)(p.ws + WS_LB);
    in.lb0 = LB[l * 512 + h * 128 + d]; in.lb1 = LB[l * 512 + h * 128 + d + 1];
#pragma unroll
    for (int i = 0; i < 8; ++i) { const size_t tk = (size_t)(tok0 + 8 * wid); const int cb = h * 128 + d; in.fv[i] = *(const unsigned*)(U + uoff(tk, U_FD + cb) + i * 256); in.qv[i] = 0u; in.zv[i] = 0u; if (WITH_Q) { in.qv[i] = *(const unsigned*)(U + uoff(tk, U_QD + cb) + i * 256); in.zv[i] = *(const unsigned*)(U + uoff(tk, U_ZD + cb) + i * 256); } in.vv[i] = *(const unsigned*)(U + uoff(tk, U_ID + cb) + i * 256); }
}
DI void hgrn_local_unit(const Params& p, int l, int ud, const HgIn& in, unsigned char* sm) {
    const int tid = opaque_tid(), wid = tid >> 6, lane = tid & 63;
    const int bh = ud >> 5, c = ud & 31, b = bh >> 2, h = bh & 3, tok0 = b * SEQ + c * 64;
    float* bS = (float*)sm; float* kS = (float*)(sm + 33024);
    bf16_t* KwT = (bf16_t*)(sm + 66048); bf16_t* VT = (bf16_t*)(sm + 84480); unsigned* N2 = (unsigned*)(sm + 102912);
    const bf16_t* U = (const bf16_t*)(p.ws + WS_U); const float* LB = (const float*)(p.ws + WS_LB);
    { const int dp = tid & 63, d = 2 * dp; const float lb0 = in.lb0, lb1 = in.lb1;
#pragma unroll
      for (int i = 0; i < 8; ++i) { const int r = 8 * wid + i; const float f0 = bflo(in.fv[i]), f1 = bfhi(in.fv[i]);
          bS[r * 129 + d] = __builtin_amdgcn_logf(lb0 + (1.0f - lb0) * sigmoidf_(f0)); bS[r * 129 + d + 1] = __builtin_amdgcn_logf(lb1 + (1.0f - lb1) * sigmoidf_(f1));
          kS[r * 129 + d] = (1.0f - lb0) * sigmoidf_(-f0); kS[r * 129 + d + 1] = (1.0f - lb1) * sigmoidf_(-f1);
          N2[r * 65 + dp] = in.vv[i]; } }
    __syncthreads();
    float* tot = (float*)(sm + 119552);
    { const int dd = tid & 127, J = tid >> 7; float s = 0.f;
#pragma unroll
      for (int rr = 0; rr < 16; ++rr) { s += bS[(16 * J + rr) * 129 + dd]; bS[(16 * J + rr) * 129 + dd] = s; }
      tot[J * 128 + dd] = s; }
    transpose_pairs<64>(N2, 65, VT, 72, tid);
    __syncthreads();
#pragma unroll
    for (int i = 0; i < 16; ++i) { const int idx = i * 512 + tid, r = idx & 63, d = idx >> 6, J = r >> 4;
        const float t0 = tot[d], t1 = tot[128 + d], t2 = tot[256 + d], t3 = tot[384 + d];
        const float rest = J == 0 ? t0 + t1 + t2 + t3 : (J == 1 ? t1 + t2 + t3 : (J == 2 ? t2 + t3 : t3));
        KwT[d * 72 + r] = f2bf(kS[r * 129 + d] * __builtin_amdgcn_exp2f(rest - bS[r * 129 + d])); }
    if (tid < 128) ((float*)(p.ws + WS_DECD))[ud * 128 + tid] = __builtin_amdgcn_exp2f(tot[tid] + tot[128 + tid] + tot[256 + tid] + tot[384 + tid]);
    __syncthreads();
    f32x16 acc[1][2]; zero_acc<1, 2>(acc);
    const int dt = wid & 3, eh = wid >> 2;
    mma_lds<1, 2>(acc, KwT + 32 * dt * 72, 72, VT + 64 * eh * 72, 72, 64, lane);
    bf16_t* ST = (bf16_t*)(p.ws + WS_STD) + (size_t)ud * 16384;
    { const int r31 = lane & 31, hh = lane >> 5;
#pragma unroll
      for (int nt = 0; nt < 2; ++nt) { const int e = 64 * eh + 32 * nt + r31;
#pragma unroll
          for (int q4 = 0; q4 < 4; ++q4) { const int d0 = 32 * dt + 8 * q4 + 4 * hh; f32x4 v = {acc[0][nt][4 * q4], acc[0][nt][4 * q4 + 1], acc[0][nt][4 * q4 + 2], acc[0][nt][4 * q4 + 3]};
              u32x2 w; w.x = pack2(v[0], v[1]); w.y = pack2(v[2], v[3]); *(u32x2*)(ST + e * 128 + d0) = w; } } }
    __syncthreads();
}
DI void hgrn_scan(const Params& p) {
    const int gt = blockIdx.x * 512 + opaque_tid(), nth = gridDim.x * 512; const float* DEC = (const float*)(p.ws + WS_DECD);
    for (int it = gt; it < 32 * 4096; it += nth) { const int bh = it >> 12, v = it & 4095, d4 = (v & 31) * 4; f32x4 S = {0.f, 0.f, 0.f, 0.f};
#pragma unroll 1
        for (int half = 0; half < 2; ++half) { u32x2* base = (u32x2*)((bf16_t*)(p.ws + WS_STD) + (size_t)(bh * 32 + half * 16) * 16384) + v; const float* db = DEC + (bh * 32 + half * 16) * 128 + d4;
            u32x2 tmp[16]; f32x4 dec[16];
#pragma unroll
            for (int c = 0; c < 16; ++c) { tmp[c] = base[(size_t)c * 4096]; dec[c] = *(const f32x4*)(db + c * 128); }
#pragma unroll
            for (int c = 0; c < 16; ++c) { u32x2 w; w.x = pack2(S[0], S[1]); w.y = pack2(S[2], S[3]); base[(size_t)c * 4096] = w;
                const f32x4 t = {bflo(tmp[c].x), bfhi(tmp[c].x), bflo(tmp[c].y), bfhi(tmp[c].y)}; S = S * dec[c] + t; } } }
}
DI void hgrn_out_unit(const Params& p, int l, int ud, const HgIn& in, unsigned char* sm) {
    const int tid = opaque_tid(), wid = tid >> 6, lane = tid & 63, r31 = lane & 31, hh = lane >> 5;
    const int bh = ud >> 5, c = ud & 31, b = bh >> 2, h = bh & 3, tok0 = b * SEQ + c * 64;
    float* bS = (float*)sm; bf16_t* STs = (bf16_t*)sm; float* tot = (float*)(sm + 32768);
    bf16_t* Qh = (bf16_t*)(sm + 34816); bf16_t* Qb = (bf16_t*)(sm + 52224); bf16_t* KK = (bf16_t*)(sm + 69632); float* Hs = (float*)(sm + 69632);
    bf16_t* VT = (bf16_t*)(sm + 113152); bf16_t* aS = (bf16_t*)(sm + 131584); unsigned* N2 = (unsigned*)(sm + 69632);
    const bf16_t* U = (const bf16_t*)(p.ws + WS_U); const float* LB = (const float*)(p.ws + WS_LB);
    const int dp = tid & 63, d = 2 * dp, R = wid >> 1;
    float q0[8], q1[8], k0[8], k1[8];
    { const float lb0 = in.lb0, lb1 = in.lb1;
#pragma unroll
      for (int i = 0; i < 8; ++i) { const int r = 8 * wid + i; const float f0 = bflo(in.fv[i]), f1 = bfhi(in.fv[i]);
          bS[r * 128 + d] = __builtin_amdgcn_logf(lb0 + (1.0f - lb0) * sigmoidf_(f0)); bS[r * 128 + d + 1] = __builtin_amdgcn_logf(lb1 + (1.0f - lb1) * sigmoidf_(f1));
          k0[i] = (1.0f - lb0) * sigmoidf_(-f0); k1[i] = (1.0f - lb1) * sigmoidf_(-f1);
          q0[i] = siluf_(bflo(in.qv[i])) * 0.08838834764831845f; q1[i] = siluf_(bfhi(in.qv[i])) * 0.08838834764831845f;
          N2[r * 65 + dp] = in.vv[i]; } }
    __syncthreads();
    transpose_pairs<64>(N2, 65, VT, 72, tid);
    { const int dd = tid & 127, J = tid >> 7; float s = 0.f;
#pragma unroll
      for (int rr = 0; rr < 16; ++rr) { s += bS[(16 * J + rr) * 128 + dd]; bS[(16 * J + rr) * 128 + dd] = s; }
      tot[J * 128 + dd] = s; }
    __syncthreads();
    { const f32x2 t0 = *(const f32x2*)(tot + d), t1 = *(const f32x2*)(tot + 128 + d), t2 = *(const f32x2*)(tot + 256 + d);
      float offa[4], offb[4]; offa[0] = 0.f; offb[0] = 0.f; offa[1] = t0[0]; offb[1] = t0[1]; offa[2] = t0[0] + t1[0]; offb[2] = t0[1] + t1[1]; offa[3] = offa[2] + t2[0]; offb[3] = offb[2] + t2[1];
      const float oRa = R == 0 ? offa[0] : (R == 1 ? offa[1] : (R == 2 ? offa[2] : offa[3])), oRb = R == 0 ? offb[0] : (R == 1 ? offb[1] : (R == 2 ? offb[2] : offb[3]));
#pragma unroll
      for (int i = 0; i < 8; ++i) { const int r = 8 * wid + i; const f32x2 lc = *(const f32x2*)(bS + r * 128 + d);
          *(unsigned*)(Qh + r * 136 + d) = pack2(q0[i] * __builtin_amdgcn_exp2f(lc[0]), q1[i] * __builtin_amdgcn_exp2f(lc[1]));
          *(unsigned*)(Qb + r * 136 + d) = pack2(q0[i] * __builtin_amdgcn_exp2f(lc[0] + oRa), q1[i] * __builtin_amdgcn_exp2f(lc[1] + oRb));
#pragma unroll
          for (int J = 0; J < 4; ++J) if (J >= R) { const int rowoff = 8 * J * (J + 1);
              *(unsigned*)(KK + (rowoff + r) * 136 + d) = pack2(k0[i] * __builtin_amdgcn_exp2f(fminf(offa[J] - oRa - lc[0], 100.f)), k1[i] * __builtin_amdgcn_exp2f(fminf(offb[J] - oRb - lc[1], 100.f))); } } }
    __syncthreads();
    { const bf16_t* ST = (const bf16_t*)(p.ws + WS_STD) + (size_t)ud * 16384;
#pragma unroll
      for (int i = 0; i < 4; ++i) { const int idx = i * 512 + tid, e = idx >> 4, d8 = (idx & 15) * 8; *(u32x4*)(STs + e * 136 + d8) = *(const u32x4*)(ST + e * 128 + d8); } }
    { const int c15 = lane & 15, q4 = lane >> 4;
#pragma unroll
      for (int sl = 0; sl < 2; ++sl) { const int slot = 2 * wid + sl, J = slot >> 2, Rt = slot & 3; f32x4 acc = {0.f, 0.f, 0.f, 0.f};
          if (Rt <= J) { const int rowoff = 8 * J * (J + 1);
#pragma unroll
              for (int ks = 0; ks < 4; ++ks) { const bf16x8 af = *(const bf16x8*)(Qh + (16 * J + c15) * 136 + 32 * ks + 8 * q4), bfr = *(const bf16x8*)(KK + (rowoff + 16 * Rt + c15) * 136 + 32 * ks + 8 * q4);
                  acc = __builtin_amdgcn_mfma_f32_16x16x32_bf16(af, bfr, acc, 0, 0, 0); } }
#pragma unroll
          for (int i = 0; i < 4; ++i) { const int jj = 16 * J + 4 * q4 + i, rr = 16 * Rt + c15; aS[jj * 72 + rr] = f2bf((Rt <= J && rr <= jj) ? acc[i] : 0.f); } } }
    __syncthreads();
    const int jt = wid & 1, et = wid >> 1;
    f32x16 acc[1][1]; zero_acc<1, 1>(acc);
    mma_lds<1, 1>(acc, aS + 32 * jt * 72, 72, VT + 32 * et * 72, 72, 64, lane);
    mma_lds<1, 1>(acc, Qb + 32 * jt * 136, 136, STs + 32 * et * 136, 136, 128, lane);
#pragma unroll
    for (int i = 0; i < 16; ++i) Hs[(32 * jt + crow(i, hh)) * 132 + 32 * et + r31] = acc[0][0][i];
    __syncthreads();
    { bf16_t* YD = (bf16_t*)(p.ws + WS_YD); const int e = 2 * lane; const float g0 = p.hnorm_g[l * 512 + h * 128 + e], g1 = p.hnorm_g[l * 512 + h * 128 + e + 1];
#pragma unroll
      for (int jj = 0; jj < 8; ++jj) { const int j = wid * 8 + jj; const f32x2 v = *(const f32x2*)(Hs + j * 132 + e); const float ss = wave_sum(v[0] * v[0] + v[1] * v[1]); const float rs = rsqrtf(ss * (1.0f / 128.0f) + EPS);
          const size_t tok = (size_t)(tok0 + j);
          *(unsigned*)(YD + tok * 512 + h * 128 + e) = pack2(v[0] * rs * g0 * siluf_(bflo(in.zv[jj])), v[1] * rs * g1 * siluf_(bfhi(in.zv[jj]))); } }
    __syncthreads();
}
DI void lru_local_unit(const Params& p, int l, int ub, unsigned char* sm) {
    const int tid = opaque_tid(), wid = tid >> 6, lane = tid & 63, c15 = lane & 15, q = lane >> 4;
    const int b = ub >> 5, c = ub & 31, tseq0 = c * 64, tok0 = b * SEQ + tseq0;
    float* xcf = (float*)sm; bf16_t* xcb = (bf16_t*)(sm + 32768); float* aS = (float*)(sm + 49408); float* uS = (float*)(sm + 82176);
    const bf16_t* U = (const bf16_t*)(p.ws + WS_U);
    unsigned* LHA = (unsigned*)(p.ws + WS_LRUH);
    bf16x8 waf[4][2], wxf[4][2];
    { const float* wa = p.wa + ((size_t)l * 8 + wid) * 4096; const float* wx = p.wx + ((size_t)l * 8 + wid) * 4096;
#pragma unroll
      for (int nt = 0; nt < 4; ++nt)
#pragma unroll
          for (int ks = 0; ks < 2; ++ks) { u32x4 ta, tx;
#pragma unroll
              for (int jp = 0; jp < 4; ++jp) { const int d = 32 * ks + 8 * q + 2 * jp, e = 16 * nt + c15;
                  ta[jp] = pack2(wa[d * 64 + e], wa[(d + 1) * 64 + e]); tx[jp] = pack2(wx[d * 64 + e], wx[(d + 1) * 64 + e]); }
              waf[nt][ks] = __builtin_bit_cast(bf16x8, ta); wxf[nt][ks] = __builtin_bit_cast(bf16x8, tx); } }
    float gba[4], gbx[4], gsp[4];
#pragma unroll
    for (int nt = 0; nt < 4; ++nt) { const int ch = wid * 64 + 16 * nt + c15; gba[nt] = p.ba[l * 512 + ch]; gbx[nt] = p.bx[l * 512 + ch]; gsp[nt] = 8.0f * log1pf(expf(-p.lam[l * 512 + ch])); }
    const int ch = tid; float cw0 = p.lconv_w[l * 2048 + ch], cw1 = p.lconv_w[l * 2048 + 512 + ch], cw2 = p.lconv_w[l * 2048 + 1024 + ch], cw3 = p.lconv_w[l * 2048 + 1536 + ch], cb = p.lconv_b[l * 512 + ch];
    float x0 = 0.f, x1 = 0.f, x2 = 0.f;
    if (tseq0 > 0) { x0 = bf2f(U[uoff((size_t)(tok0 - 3), U_XB + ch)]); x1 = bf2f(U[uoff((size_t)(tok0 - 2), U_XB + ch)]); x2 = bf2f(U[uoff((size_t)(tok0 - 1), U_XB + ch)]); }
    float hst = 0.f, Ac = 1.f;
    float xr[16];
#pragma unroll
    for (int tt = 0; tt < 16; ++tt) xr[tt] = bf2f(U[uoff((size_t)tok0, U_XB + ch) + tt * 256]);
    for (int sc = 0; sc < 4; ++sc) {
#pragma unroll
        for (int tt = 0; tt < 16; ++tt) { const float x3 = xr[tt]; const float xc = cb + cw0 * x0 + cw1 * x1 + cw2 * x2 + cw3 * x3;
            xcf[tt * 512 + ch] = xc; xcb[tt * 520 + ch] = f2bf(xc); x0 = x1; x1 = x2; x2 = x3; }
        if (sc < 3) {
#pragma unroll
            for (int tt = 0; tt < 16; ++tt) xr[tt] = bf2f(U[uoff((size_t)(tok0 + (sc + 1) * 16), U_XB + ch) + tt * 256]); }
        __syncthreads();
        { f32x4 accA[4], accX[4];
#pragma unroll
          for (int nt = 0; nt < 4; ++nt) { accA[nt] = (f32x4){0.f, 0.f, 0.f, 0.f}; accX[nt] = (f32x4){0.f, 0.f, 0.f, 0.f}; }
#pragma unroll
          for (int ks = 0; ks < 2; ++ks) { const bf16x8 af = *(const bf16x8*)(xcb + c15 * 520 + wid * 64 + 32 * ks + 8 * q);
#pragma unroll
              for (int nt = 0; nt < 4; ++nt) { accA[nt] = __builtin_amdgcn_mfma_f32_16x16x32_bf16(af, waf[nt][ks], accA[nt], 0, 0, 0); accX[nt] = __builtin_amdgcn_mfma_f32_16x16x32_bf16(af, wxf[nt][ks], accX[nt], 0, 0, 0); } }
#pragma unroll
          for (int nt = 0; nt < 4; ++nt) { const int che = wid * 64 + 16 * nt + c15;
#pragma unroll
              for (int i = 0; i < 4; ++i) { const int t = 4 * q + i; const float rg = sigmoidf_(accA[nt][i] + gba[nt]), ig = sigmoidf_(accX[nt][i] + gbx[nt]);
                  const float la = -rg * gsp[nt]; const float a = fexp_(la); const float mult = __builtin_amdgcn_sqrtf(fmaxf(fmaf(-a, a, 1.0f), 0.f));
                  aS[t * 512 + che] = a; uS[t * 512 + che] = mult * ig * xcf[t * 512 + che]; } } }
        __syncthreads();
#pragma unroll 4
        for (int tt = 0; tt < 16; ++tt) { const float a = aS[tt * 512 + ch], u = uS[tt * 512 + ch]; hst = a * hst + u; Ac *= a; const size_t o = (size_t)(tok0 + sc * 16 + tt) * 512 + ch; LHA[o] = pack2(hst, Ac); }
    }
    __syncthreads();
}
DI void lru_scan(const Params& p) {
    const int gt = blockIdx.x * 512 + opaque_tid(), nth = gridDim.x * 512; const unsigned* LHA = (const unsigned*)(p.ws + WS_LRUH); float* CB = (float*)(p.ws + WS_CARB);
    for (int it = gt; it < 8 * 512; it += nth) { const int b = it >> 9, ch = it & 511; unsigned ha[32];
#pragma unroll
        for (int c = 0; c < 32; ++c) ha[c] = LHA[(size_t)(b * SEQ + c * 64 + 63) * 512 + ch];
        float H = 0.f;
#pragma unroll
        for (int c = 0; c < 32; ++c) { CB[(b * 32 + c) * 512 + ch] = H; H = bfhi(ha[c]) * H + bflo(ha[c]); } }
}
DI void lru_out(const Params& p) {
    const int gt = blockIdx.x * 512 + opaque_tid(), nth = gridDim.x * 512; const unsigned* LHA = (const unsigned*)(p.ws + WS_LRUH); const float* CB = (const float*)(p.ws + WS_CARB);
    const bf16_t* U = (const bf16_t*)(p.ws + WS_U); bf16_t* YB = (bf16_t*)(p.ws + WS_YB);
    for (int it0 = gt; it0 < T * 128; it0 += 8 * nth) {
        u32x4 ha[8]; f32x4 cr[8]; u32x2 zv[8];
#pragma unroll
        for (int k = 0; k < 8; ++k) { const int it = it0 + k * nth; if (it < T * 128) { const int tok = it >> 7, c4 = (it & 127) * 4; const size_t o = (size_t)tok * 512 + c4;
            ha[k] = *(const u32x4*)(LHA + o); cr[k] = *(const f32x4*)(CB + (size_t)(tok >> 6) * 512 + c4); zv[k] = *(const u32x2*)(U + uoff((size_t)tok, U_ZB + c4)); } }
#pragma unroll
        for (int k = 0; k < 8; ++k) { const int it = it0 + k * nth; if (it < T * 128) { const int tok = it >> 7, c4 = (it & 127) * 4; const size_t o = (size_t)tok * 512 + c4;
            const float h0 = bflo(ha[k].x) + bfhi(ha[k].x) * cr[k][0], h1 = bflo(ha[k].y) + bfhi(ha[k].y) * cr[k][1], h2 = bflo(ha[k].z) + bfhi(ha[k].z) * cr[k][2], h3 = bflo(ha[k].w) + bfhi(ha[k].w) * cr[k][3];
            u32x2 w; w.x = pack2(h0 * siluf_(bflo(zv[k].x)), h1 * siluf_(bfhi(zv[k].x))); w.y = pack2(h2 * siluf_(bflo(zv[k].y)), h3 * siluf_(bfhi(zv[k].y))); *(u32x2*)(YB + o) = w; } } }
}
#define MFMA32(a, b, c) __builtin_amdgcn_mfma_f32_32x32x16_bf16((a), (b), (c), 0, 0, 0)
DI bf16x8 pack_p(const f32x16& x, int s) {
    u32x4 w; w.x = pack2(x[8 * s], x[8 * s + 1]); w.y = pack2(x[8 * s + 2], x[8 * s + 3]); w.z = pack2(x[8 * s + 4], x[8 * s + 5]); w.w = pack2(x[8 * s + 6], x[8 * s + 7]);
    return __builtin_bit_cast(bf16x8, w);
}
DI bf16x8 vt_frag(const bf16_t* VT, int e, int key0, int hh) {
    const s16x4 lo = *(const s16x4*)(VT + e * 260 + key0 + 4 * hh), hi = *(const s16x4*)(VT + e * 260 + key0 + 8 + 4 * hh);
    return __builtin_shufflevector(lo, hi, 0, 1, 2, 3, 4, 5, 6, 7);
}
DI void swa_unit(const Params& p, int l, int uc, unsigned char* sm) {
    const int tid = opaque_tid(), wid = tid >> 6, lane = tid & 63, r31 = lane & 31, hh = lane >> 5;
    const int b = uc >> 5, nb = (uc >> 1) & 15, kv = uc & 1;
    bf16_t* Ks = (bf16_t*)sm; bf16_t* VT = (bf16_t*)(sm + 36864); int* posk = (int*)(sm + 70656); unsigned* N2 = (unsigned*)(sm + 71680);
    const bf16_t* U = (const bf16_t*)(p.ws + WS_U); bf16_t* YC = (bf16_t*)(p.ws + WS_YC);
#pragma unroll
    for (int i = 0; i < 4; ++i) { const int idx = i * 512 + tid, s = idx >> 3, c8 = idx & 7, tseq = nb * 128 - 128 + s; u32x4 v = {0u, 0u, 0u, 0u};
        if (tseq >= 0) v = *(const u32x4*)(U + uoff((size_t)(b * SEQ + tseq), U_KC + kv * 64 + c8 * 8));
        *(u32x4*)(Ks + s * 72 + c8 * 8) = v; }
    { unsigned vv[16];
#pragma unroll
      for (int i = 0; i < 16; ++i) { const int idx = i * 512 + tid, s = idx >> 5, ep = idx & 31; int tseq = nb * 128 - 128 + s; tseq = tseq < 0 ? 0 : tseq;
          vv[i] = *(const unsigned*)(U + uoff((size_t)(b * SEQ + tseq), U_VC + kv * 64 + 2 * ep)); }
#pragma unroll
      for (int i = 0; i < 16; ++i) { const int idx = i * 512 + tid, s = idx >> 5, ep = idx & 31; N2[s * 33 + ep] = (nb * 128 - 128 + s >= 0) ? vv[i] : 0u; } }
    if (tid < 256) { const int tseq = nb * 128 - 128 + tid; posk[tid] = tseq >= 0 ? p.pos[b * SEQ + tseq] : 0; }
    const int g = wid >> 1, th = wid & 1, head = kv * 4 + g; const float slope = exp2f(-(float)(head + 1)), sink = p.sinks[l * 8 + head];
    bf16x8 qn[4];
#pragma unroll
    for (int ks = 0; ks < 4; ++ks) qn[ks] = *(const bf16x8*)(U + uoff((size_t)(b * SEQ + nb * 128 + 64 * th + r31), U_QC + head * 64 + 16 * ks + 8 * hh));
    __syncthreads();
    { const int s = tid & 255, eq = tid >> 8;
#pragma unroll
      for (int i = 0; i < 16; ++i) { const int ep = eq * 16 + i; const unsigned w = N2[s * 33 + ep]; VT[(2 * ep) * 260 + s] = (bf16_t)(w & 0xffffu); VT[(2 * ep + 1) * 260 + s] = (bf16_t)(w >> 16); } }
    __syncthreads();
#pragma unroll 1
    for (int pass = 0; pass < 2; ++pass) {
        const int t0 = 64 * th + 32 * pass, t = t0 + r31; const size_t tok = (size_t)(b * SEQ + nb * 128 + t);
        bf16x8 qf[4];
#pragma unroll
        for (int ks = 0; ks < 4; ++ks) { qf[ks] = qn[ks]; qn[ks] = *(const bf16x8*)(U + uoff(tok + 32 * (1 - pass), U_QC + head * 64 + 16 * ks + 8 * hh)); }
        u32x2 zpre[2][4];
#pragma unroll
        for (int et = 0; et < 2; ++et)
#pragma unroll
            for (int q4 = 0; q4 < 4; ++q4) zpre[et][q4] = *(const u32x2*)(U + uoff(tok, U_ZC + head * 64 + 32 * et + 8 * q4 + 4 * hh));
        f32x16 acc[5];
#pragma unroll
        for (int mt = 0; mt < 5; ++mt) {
#pragma unroll
            for (int i = 0; i < 16; ++i) acc[mt][i] = 0.f;
#pragma unroll
            for (int ks = 0; ks < 4; ++ks) { const bf16x8 kf = *(const bf16x8*)(Ks + (t0 + 32 * mt + r31) * 72 + 16 * ks + 8 * hh); acc[mt] = MFMA32(kf, qf[ks], acc[mt]); } }
        const int pq = posk[128 + t]; float m = -INFINITY;
#pragma unroll
        for (int mt = 0; mt < 5; ++mt)
#pragma unroll
            for (int g4 = 0; g4 < 4; ++g4) { const int cr0 = 8 * g4 + 4 * hh, sb = t0 + 32 * mt + cr0; const u32x4 pk = *(const u32x4*)(posk + sb);
#pragma unroll
                for (int k = 0; k < 4; ++k) { const int i = 4 * g4 + k; bool valid = (nb > 0) || (sb + k >= 128);
                    if (mt == 0) valid = valid && (cr0 + k > r31);
                    if (mt == 4) valid = valid && (cr0 + k <= r31);
                    const float dist = fabsf((float)(pq - (int)pk[k])); const float sc = valid ? acc[mt][i] * 0.125f - slope * dist : -INFINITY; acc[mt][i] = sc; m = fmaxf(m, sc); } }
        m = fmaxf(m, __shfl_xor(m, 32)); m = fmaxf(m, sink);
        float sum = 0.f;
#pragma unroll
        for (int mt = 0; mt < 5; ++mt)
#pragma unroll
            for (int i = 0; i < 16; ++i) { const float pv = fexp_(acc[mt][i] - m); acc[mt][i] = pv; sum += pv; }
        sum += __shfl_xor(sum, 32); sum += fexp_(sink - m); const float inv = __builtin_amdgcn_rcpf(sum);
        f32x16 o[2];
#pragma unroll
        for (int i = 0; i < 16; ++i) { o[0][i] = 0.f; o[1][i] = 0.f; }
#pragma unroll
        for (int mt = 0; mt < 5; ++mt) {
#pragma unroll
            for (int i = 0; i < 16; ++i) acc[mt][i] *= inv;
#pragma unroll
            for (int s2 = 0; s2 < 2; ++s2) { const bf16x8 pf = pack_p(acc[mt], s2);
#pragma unroll
                for (int et = 0; et < 2; ++et) o[et] = MFMA32(vt_frag(VT, 32 * et + r31, t0 + 32 * mt + 16 * s2, hh), pf, o[et]); } }
#pragma unroll
        for (int et = 0; et < 2; ++et)
#pragma unroll
            for (int q4 = 0; q4 < 4; ++q4) { const int e0 = 32 * et + 8 * q4 + 4 * hh; const u32x2 zv = zpre[et][q4];
                u32x2 w; w.x = pack2(o[et][4 * q4] * siluf_(bflo(zv.x)), o[et][4 * q4 + 1] * siluf_(bfhi(zv.x))); w.y = pack2(o[et][4 * q4 + 2] * siluf_(bflo(zv.y)), o[et][4 * q4 + 3] * siluf_(bfhi(zv.y)));
                *(u32x2*)(YC + tok * 512 + head * 64 + e0) = w; }
    }
    __syncthreads();
}
DI void xattn_unit(const Params& p, int l, int ue, unsigned char* sm) {
    const int tid = opaque_tid(), wid = tid >> 6, lane = tid & 63, r31 = lane & 31, hh = lane >> 5;
    const int b = ue >> 5, hd = (ue >> 3) & 3, qt = ue & 7;
    bf16_t* Ks = (bf16_t*)sm; bf16_t* VT = (bf16_t*)(sm + 36864); unsigned* N2 = (unsigned*)(sm + 71680);
    const bf16_t* U = (const bf16_t*)(p.ws + WS_U); const bf16_t* KVM = (const bf16_t*)(p.ws + WS_KVM); bf16_t* YE = (bf16_t*)(p.ws + WS_YE);
#pragma unroll
    for (int i = 0; i < 4; ++i) { const int idx = i * 512 + tid, s = idx >> 3, c8 = idx & 7;
        *(u32x4*)(Ks + s * 72 + c8 * 8) = *(const u32x4*)(KVM + (size_t)(b * 256 + s) * 2048 + l * 512 + hd * 64 + c8 * 8); }
    { unsigned vv[16];
#pragma unroll
      for (int i = 0; i < 16; ++i) { const int idx = i * 512 + tid, s = idx >> 5, ep = idx & 31; vv[i] = *(const unsigned*)(KVM + (size_t)(b * 256 + s) * 2048 + l * 512 + 256 + hd * 64 + 2 * ep); }
#pragma unroll
      for (int i = 0; i < 16; ++i) { const int idx = i * 512 + tid, s = idx >> 5, ep = idx & 31; N2[s * 33 + ep] = vv[i]; } }
    const int t = qt * 256 + 32 * wid + r31; const size_t tok = (size_t)(b * SEQ + t);
    bf16x8 qf[4];
#pragma unroll
    for (int ks = 0; ks < 4; ++ks) qf[ks] = *(const bf16x8*)(U + uoff(tok, U_QE + hd * 64 + 16 * ks + 8 * hh));
    u32x2 zpre[2][4];
#pragma unroll
    for (int et = 0; et < 2; ++et)
#pragma unroll
        for (int q4 = 0; q4 < 4; ++q4) zpre[et][q4] = *(const u32x2*)(U + uoff(tok, U_ZE + hd * 64 + 32 * et + 8 * q4 + 4 * hh));
    __syncthreads();
    { const int s = tid & 255, eq = tid >> 8;
#pragma unroll
      for (int i = 0; i < 16; ++i) { const int ep = eq * 16 + i; const unsigned w = N2[s * 33 + ep]; VT[(2 * ep) * 260 + s] = (bf16_t)(w & 0xffffu); VT[(2 * ep + 1) * 260 + s] = (bf16_t)(w >> 16); } }
    __syncthreads();
    float m = -INFINITY;
#pragma unroll 1
    for (int half = 0; half < 2; ++half) { f32x16 acc[4];
#pragma unroll
        for (int mt = 0; mt < 4; ++mt) {
#pragma unroll
            for (int i = 0; i < 16; ++i) acc[mt][i] = 0.f;
#pragma unroll
            for (int ks = 0; ks < 4; ++ks) { const bf16x8 kf = *(const bf16x8*)(Ks + (128 * half + 32 * mt + r31) * 72 + 16 * ks + 8 * hh); acc[mt] = MFMA32(kf, qf[ks], acc[mt]); }
#pragma unroll
            for (int i = 0; i < 16; ++i) m = fmaxf(m, acc[mt][i]); } }
    m = fmaxf(m, __shfl_xor(m, 32)) * 0.125f;
    float sum = 0.f; f32x16 o[2];
#pragma unroll
    for (int i = 0; i < 16; ++i) { o[0][i] = 0.f; o[1][i] = 0.f; }
#pragma unroll 1
    for (int half = 0; half < 2; ++half) { f32x16 acc[4];
#pragma unroll
        for (int mt = 0; mt < 4; ++mt) {
#pragma unroll
            for (int i = 0; i < 16; ++i) acc[mt][i] = 0.f;
#pragma unroll
            for (int ks = 0; ks < 4; ++ks) { const bf16x8 kf = *(const bf16x8*)(Ks + (128 * half + 32 * mt + r31) * 72 + 16 * ks + 8 * hh); acc[mt] = MFMA32(kf, qf[ks], acc[mt]); }
#pragma unroll
            for (int i = 0; i < 16; ++i) { const float pv = fexp_(acc[mt][i] * 0.125f - m); acc[mt][i] = pv; sum += pv; }
#pragma unroll
            for (int s2 = 0; s2 < 2; ++s2) { const bf16x8 pf = pack_p(acc[mt], s2);
#pragma unroll
                for (int et = 0; et < 2; ++et) o[et] = MFMA32(vt_frag(VT, 32 * et + r31, 128 * half + 32 * mt + 16 * s2, hh), pf, o[et]); } } }
    sum += __shfl_xor(sum, 32); const float inv = __builtin_amdgcn_rcpf(sum);
#pragma unroll
    for (int et = 0; et < 2; ++et)
#pragma unroll
        for (int q4 = 0; q4 < 4; ++q4) { const int e0 = 32 * et + 8 * q4 + 4 * hh; const u32x2 zv = zpre[et][q4];
            u32x2 w; w.x = pack2(o[et][4 * q4] * inv * siluf_(bflo(zv.x)), o[et][4 * q4 + 1] * inv * siluf_(bfhi(zv.x))); w.y = pack2(o[et][4 * q4 + 2] * inv * siluf_(bflo(zv.y)), o[et][4 * q4 + 3] * inv * siluf_(bfhi(zv.y)));
            *(u32x2*)(YE + tok * 256 + hd * 64 + e0) = w; }
    __syncthreads();
}
#define XB_TMO      128
#define XB_XCNT(j)  (256  + 64 * (j))
#define XB_XSUB(j)  (1280 + 64 * (j))
#define XB_XGEN(j)  (2304 + 64 * (j))
#define XB_TOP      3328
#define XB_TOPGEN   3392
#define XCD_BAR_WORDS 3456
#define XB_SPIN_CAP (1u << 18)
#define LAS __attribute__((address_space(3)))
__device__ __forceinline__ unsigned xb_ld(unsigned* p)              { return __hip_atomic_load(p, __ATOMIC_RELAXED, __HIP_MEMORY_SCOPE_AGENT); }
__device__ __forceinline__ unsigned xb_add(unsigned* p, unsigned v) { return __hip_atomic_fetch_add(p, v, __ATOMIC_RELAXED, __HIP_MEMORY_SCOPE_AGENT); }
__device__ __forceinline__ unsigned xb_xcc_id() { return (unsigned)__builtin_amdgcn_s_getreg((3 << 11) | 20) & 0xFu; }
#define XB_SPIN(cond, bar) do { unsigned _sp = 0; while (cond) { __builtin_amdgcn_s_sleep(1); \
    if ((++_sp & 255u) == 0u) { if (xb_ld(&(bar)[XB_TMO])) break; if (_sp > XB_SPIN_CAP) { atomicAdd(&(bar)[XB_TMO], 1u); break; } } } } while (0)

struct XcdBarrier {
    unsigned* bar; unsigned x;
    volatile LAS unsigned* st;
};

__device__ __forceinline__ XcdBarrier xcd_barrier_post(unsigned* bar, volatile LAS unsigned* st) {
    XcdBarrier b; b.bar = bar; b.x = xb_xcc_id(); b.st = st;
    if (threadIdx.x == 0) (void)xb_add(&bar[XB_XCNT(b.x)], 1u);
    return b;
}
__device__ __forceinline__ void xcd_barrier_complete(unsigned* bar, unsigned x, unsigned& nloc, unsigned& nx) {
    const unsigned G = gridDim.x * gridDim.y * gridDim.z;
    unsigned sum, cnt, mine, sp = 0u;
    for (;;) {
        sum = 0u; cnt = 0u; mine = 0u;
#pragma unroll
        for (unsigned j = 0; j < 16; ++j) { const unsigned c = xb_ld(&bar[XB_XCNT(j)]); sum += c; cnt += (c > 0u) ? 1u : 0u; mine = (j == x) ? c : mine; }
        if (sum == G) break;
        __builtin_amdgcn_s_sleep(1);
        if ((++sp & 255u) == 0u) { if (xb_ld(&bar[XB_TMO])) break; if (sp > XB_SPIN_CAP) { atomicAdd(&bar[XB_TMO], 1u); break; } }
    }
    nloc = mine > 0u ? mine : 1u; nx = cnt > 0u ? cnt : 1u;
}

__device__ __forceinline__ void xcd_barrier(const XcdBarrier& b) {
    asm volatile("s_waitcnt vmcnt(0)" ::: "memory");
    __syncthreads();
    if (threadIdx.x == 0) {
        unsigned* bar = b.bar;
        __builtin_amdgcn_s_waitcnt(0);
        unsigned nloc = b.st[0], nx = b.st[1];
        if (nloc == 0u) { xcd_barrier_complete(bar, b.x, nloc, nx); b.st[0] = nloc; b.st[1] = nx; }
        const unsigned old = xb_add(&bar[XB_XSUB(b.x)], 1u);
        const unsigned gen = old / nloc;
        if (old + 1u == (gen + 1u) * nloc) {
            __builtin_amdgcn_fence(__ATOMIC_RELEASE, "agent");
            asm volatile("s_waitcnt vmcnt(0)" ::: "memory");
            const unsigned og = xb_add(&bar[XB_TOP], 1u);
            const unsigned tg = og / nx;
            if (og + 1u == (tg + 1u) * nx) xb_add(&bar[XB_TOPGEN], 1u);
            else XB_SPIN(xb_ld(&bar[XB_TOPGEN]) == tg, bar);
            __builtin_amdgcn_fence(__ATOMIC_ACQUIRE, "agent");
            xb_add(&bar[XB_XGEN(b.x)], 1u);
            asm volatile("s_waitcnt vmcnt(0)" ::: "memory");
        } else {
            XB_SPIN(xb_ld(&bar[XB_XGEN(b.x)]) == gen, bar);
            __builtin_amdgcn_fence(__ATOMIC_ACQUIRE, "agent");
            asm volatile("s_waitcnt vmcnt(0)" ::: "memory");
        }
    }
    __syncthreads();
}

typedef const __attribute__((address_space(4))) unsigned char* kargp_t;
DI Params load_params(kargp_t kp) { asm volatile("" : "+s"(kp)); Params q; __builtin_memcpy(&q, kp, sizeof(Params)); return q; }
__global__ void __launch_bounds__(512, 2) hybrid_fwd(Params p_unused) {
    const kargp_t kp = (kargp_t)__builtin_amdgcn_kernarg_segment_ptr();
#define p (load_params(kp))
#define GSYNC() do { XcdBarrier b_; b_.bar = (unsigned*)(p.ws + WS_BAR); b_.x = xb_xcc_id(); b_.st = xst; xcd_barrier(b_); } while (0)
    extern __shared__ __attribute__((aligned(16))) unsigned char shm[];
    cg::grid_group grid = cg::this_grid();
    PG8_LAS unsigned char* lds = (PG8_LAS unsigned char*)shm;
    const int G = (int)gridDim.x, bid = (int)blockIdx.x;
#define Ub ((bf16_t*)(p.ws + WS_U))
#define Hb ((bf16_t*)(p.ws + WS_H))
    volatile LAS unsigned* xst = (volatile LAS unsigned*)(lds + (LDS_BYTES - 16));
    if (threadIdx.x == 0) { xst[0] = 0u; xst[1] = 0u; }
    __syncthreads();
    (void)xcd_barrier_post((unsigned*)(p.ws + WS_BAR), xst);
    phase_prologue(p, shm);
    convert_win(p, 0, bid, G, shm);
    if (G == 0x7fffffff) grid.sync();
    GSYNC();
    { pg8::StaticOrder S; S.init(2048, 2048, G, bid); pg8::Gemm g{(const bf16_t*)(p.ws + WS_MEMN), (const bf16_t*)(p.ws + WS_WMEM), 2048, 2048, 1024, 0, 0};
      EpiStoreBf16 E{(bf16_t*)(p.ws + WS_KVM), 2048, 0}; pg8::gemm_phase<EpiStoreBf16, pg8::StaticOrder, false>(lds, g, S, E, nullptr); }
#pragma unroll 1
    for (int l = 0; l < 4; ++l) {
        const float* xin = (l == 0) ? p.x : p.out;
        PREP(9)
        phase_norm(p, l, xin, shm);
        GSYNC();
#pragma unroll 1
        for (int rep = 0; rep < 1 + PROBE_DUP_P2; ++rep)
        { pg8::StaticOrder S; S.init(T, NU, G, bid); pg8::Gemm g{Hb, (const bf16_t*)(p.ws + WS_WIN + (size_t)(l & 1) * SZ_WIN1), T, NU, 1024, 0, 0};
          EpiStoreBf16 E{Ub, NU, 1}; pg8::gemm_phase<EpiStoreBf16, pg8::StaticOrder, false>(lds, g, S, E, nullptr); }
        if (PROBE_DUP_P2 == 0 && l < 3) { const int nrem = 3136 % G; if (bid >= nrem) convert_win(p, l + 1, bid - nrem, G - nrem, shm); }
        GSYNC();
#pragma unroll 1
        for (int rep = 0; rep < 1 + PROBE_DUP_P3; ++rep) {
        PREP(1)
        for (int u = bid; u < 256; u += G) swa_unit(p, l, u, shm);
        PREP(2)
        for (int u = bid; u < 256; u += G) xattn_unit(p, l, u, shm);
        PREP(3)
        for (int u = bid; u < 256; u += G) lru_local_unit(p, l, u, shm);
        if (G == 256 && PROBE_UNIT == 0 && PROBE_DUP_P3 == 0) { HgIn ia, ib; hgrn_issue<false>(p, l, bid, ia); hgrn_issue<false>(p, l, bid + 256, ib);
            for (int u = bid; u < 512; u += G) mlstm_local_unit(p, l, u, shm);
            hgrn_local_unit(p, l, bid, ia, shm);
            hgrn_issue<false>(p, l, bid + 512, ia); hgrn_local_unit(p, l, bid + 256, ib, shm); hgrn_issue<false>(p, l, bid + 768, ib); hgrn_local_unit(p, l, bid + 512, ia, shm); hgrn_local_unit(p, l, bid + 768, ib, shm); }
        else {
        PREP(4)
        for (int u = bid; u < 512; u += G) mlstm_local_unit(p, l, u, shm);
        PREP(5)
        if (G == 256) { HgIn ia, ib; hgrn_issue<false>(p, l, bid, ia); hgrn_issue<false>(p, l, bid + 256, ib); hgrn_local_unit(p, l, bid, ia, shm);
            hgrn_issue<false>(p, l, bid + 512, ia); hgrn_local_unit(p, l, bid + 256, ib, shm); hgrn_issue<false>(p, l, bid + 768, ib); hgrn_local_unit(p, l, bid + 512, ia, shm); hgrn_local_unit(p, l, bid + 768, ib, shm); }
        else for (int u = bid; u < 1024; u += G) { HgIn ia; hgrn_issue<false>(p, l, u, ia); hgrn_local_unit(p, l, u, ia, shm); }
        }
        }
#pragma unroll 1
        for (int i = 0; i < PROBE_SYNCS; ++i) GSYNC();
        GSYNC();
        mlstm_scan(p); hgrn_scan(p); lru_scan(p);
        GSYNC();
#pragma unroll 1
        for (int rep = 0; rep < 1 + PROBE_DUP_P5; ++rep) {
        if (G == 256 && PROBE_UNIT == 0 && PROBE_DUP_P5 == 0) { HgIn ia, ib; hgrn_issue<true>(p, l, bid, ia);
            for (int u = bid; u < 512; u += G) mlstm_out_unit(p, l, u, shm);
            hgrn_issue<true>(p, l, bid + 256, ib); hgrn_out_unit(p, l, bid, ia, shm);
            hgrn_issue<true>(p, l, bid + 512, ia); hgrn_out_unit(p, l, bid + 256, ib, shm); hgrn_issue<true>(p, l, bid + 768, ib); hgrn_out_unit(p, l, bid + 512, ia, shm); hgrn_out_unit(p, l, bid + 768, ib, shm); }
        else {
        PREP(6)
        for (int u = bid; u < 512; u += G) mlstm_out_unit(p, l, u, shm);
        PREP(7)
        if (G == 256) { HgIn ia, ib; hgrn_issue<true>(p, l, bid, ia); hgrn_issue<true>(p, l, bid + 256, ib); hgrn_out_unit(p, l, bid, ia, shm);
            hgrn_issue<true>(p, l, bid + 512, ia); hgrn_out_unit(p, l, bid + 256, ib, shm); hgrn_issue<true>(p, l, bid + 768, ib); hgrn_out_unit(p, l, bid + 512, ia, shm); hgrn_out_unit(p, l, bid + 768, ib, shm); }
        else for (int u = bid; u < 1024; u += G) { HgIn ia; hgrn_issue<true>(p, l, u, ia); hgrn_out_unit(p, l, u, ia, shm); }
        }
        PREP(8)
        lru_out(p);
        }
        GSYNC();
#pragma unroll 1
        for (int rep = 0; rep < 1 + PROBE_DUP_P6; ++rep) {
            bf16_t* Pb = (bf16_t*)(p.ws + WS_YF);
            { GroupOrder S{G, bid}; pg8::Gemm g{(const bf16_t*)(p.ws + WS_YS), (const bf16_t*)(p.ws + WS_WBR) + (size_t)l * 2304 * 1024, T, 1024, 512, (size_t)T * 512 * 2, (size_t)512 * 1024 * 2};
              EpiGateAcc E{Ub, Pb, Hb, 0}; pg8::gemm_phase<EpiGateAcc, GroupOrder, false>(lds, g, S, E, nullptr); }
            { pg8::StaticOrder S; S.init(T, 1024, G, bid); pg8::Gemm g{(const bf16_t*)(p.ws + WS_YE), (const bf16_t*)(p.ws + WS_WBR) + (size_t)l * 2304 * 1024 + (size_t)4 * 512 * 1024, T, 1024, 256, 0, 0};
              EpiGateAcc E{Ub, Pb, Hb, 4}; pg8::gemm_phase<EpiGateAcc, pg8::StaticOrder, false>(lds, g, S, E, nullptr); }
        }
        GSYNC();
        { pg8::StaticOrder S; S.init(T, 1024, G, bid); pg8::Gemm g{Hb, (const bf16_t*)(p.ws + WS_WOUT) + (size_t)l * 1024 * 1024, T, 1024, 1024, 0, 0};
          EpiRes E{xin, p.out}; pg8::gemm_phase<EpiRes, pg8::StaticOrder, false>(lds, g, S, E, nullptr); }
        GSYNC();
    }
    phase_final_norm(p);
}
#undef p
#undef GSYNC
#undef Ub
#undef Hb

extern "C" void kernel_launch(void* const* d_in, const int* in_sizes, int n_in, void* d_out, int out_size, void* d_ws, size_t ws_size, hipStream_t stream) {
    static int grid_blocks = 0;
    if (grid_blocks == 0) {
        if (n_in != 23 || ws_size < WS_END) { fprintf(stderr, "kernel_launch: unexpected n_in %d or ws_size %zu (< %zu)\n", n_in, ws_size, (size_t)WS_END); grid_blocks = -1; return; }
        int dev = 0, cus = 0, per_cu = 0;
        hipGetDevice(&dev); hipDeviceGetAttribute(&cus, hipDeviceAttributeMultiprocessorCount, dev);
        if (hipFuncSetAttribute((const void*)hybrid_fwd, hipFuncAttributeMaxDynamicSharedMemorySize, LDS_BYTES) != hipSuccess) { fprintf(stderr, "kernel_launch: hipFuncSetAttribute failed\n"); grid_blocks = -1; return; }
        if (hipOccupancyMaxActiveBlocksPerMultiprocessor(&per_cu, (const void*)hybrid_fwd, 512, LDS_BYTES) != hipSuccess || per_cu < 1) { fprintf(stderr, "kernel_launch: occupancy query failed (%d)\n", per_cu); (void)hipGetLastError(); per_cu = 1; }
        grid_blocks = cus * per_cu;
    }
    if (grid_blocks < 0) return;
    Params p{};
    p.x = (const float*)d_in[0]; p.mem = (const float*)d_in[1]; p.pos = (const int*)d_in[2]; p.norm_g = (const float*)d_in[3]; p.w_in = (const float*)d_in[4];
    p.mconv_w = (const float*)d_in[5]; p.b_if = (const float*)d_in[6]; p.mnorm_g = (const float*)d_in[7]; p.lconv_w = (const float*)d_in[8]; p.lconv_b = (const float*)d_in[9];
    p.wa = (const float*)d_in[10]; p.ba = (const float*)d_in[11]; p.wx = (const float*)d_in[12]; p.bx = (const float*)d_in[13]; p.lam = (const float*)d_in[14];
    p.sinks = (const float*)d_in[15]; p.hlb = (const float*)d_in[16]; p.hnorm_g = (const float*)d_in[17]; p.mem_g = (const float*)d_in[18]; p.w_mem = (const float*)d_in[19];
    p.w_br = (const float*)d_in[20]; p.w_out = (const float*)d_in[21]; p.fin_g = (const float*)d_in[22];
    p.out = (float*)d_out; p.ws = (unsigned char*)d_ws;
    if (hipMemsetAsync((unsigned char*)d_ws + WS_BAR, 0, 16384, stream) != hipSuccess) { fprintf(stderr, "kernel_launch: memset failed\n"); return; }
    void* args[] = {&p};
    hipError_t e = hipLaunchCooperativeKernel((const void*)hybrid_fwd, dim3(grid_blocks), dim3(512), args, LDS_BYTES, stream);
    if (e != hipSuccess) fprintf(stderr, "cooperative launch failed: %s (grid %d)\n", hipGetErrorString(e), grid_blocks);
}
```

```cpp
#include <hip/hip_runtime.h>
#include <hip/hip_cooperative_groups.h>
#include <cstdio>
#define PROBE_DUP_P3 0
#define PROBE_DUP_P5 0
#define PROBE_DUP_P6 0
#define PROBE_DUP_P2 0
#define PROBE_SYNCS 0
#define PROBE_UNIT 0
#define PREP(k) for (int rep_ = 0; rep_ < (PROBE_UNIT == (k) ? 2 : 1); ++rep_)
namespace cg = cooperative_groups;
__device__ __forceinline__ int opaque_tid() { int t = (int)threadIdx.x; asm volatile("" : "+v"(t)); return t; }
namespace pg8 {
#define PG8_LAS __attribute__((address_space(3)))
typedef unsigned short bf16_t;
typedef short bf16x8 __attribute__((ext_vector_type(8)));
typedef float f32x4 __attribute__((ext_vector_type(4)));
typedef unsigned u32x4 __attribute__((ext_vector_type(4)));
constexpr int BM = 256, BK = 64, HALF = 128, HTB = HALF * BK * 2  , STAGE_BYTES = 8 * HTB, NXCD = 8, WGM = 4;

__host__ __device__ __forceinline__ int lds_byte(int r, int c) { const int st = (r >> 4) * 2 + (c >> 5), rr = r & 15, cc = c & 31, ob = rr * 64 + cc * 2; return st * 1024 + (ob ^ (((ob >> 9) & 1) << 5)); }
__host__ __device__ __forceinline__ void stage_rc(int b, int& R, int& C) { const int st = b / 1024, sb = b % 1024, swz = sb ^ (((sb >> 9) & 1) << 5); R = (st >> 1) * 16 + swz / 64; C = (st & 1) * 32 + (swz % 64) / 2; }
__host__ __device__ __forceinline__ int perm32(int rho) { const int n = rho >> 4, i = rho & 15; return 8 * (i >> 2) + 4 * n + (i & 3); }

struct Unit { int pm, pn, g; };
struct Gemm { const bf16_t* A; const bf16_t* Bt; int M, N, K; size_t gsA, gsB; };

struct StaticOrder {
    int nM, nN, nwg, G, c;
    __host__ __device__ void init(int M, int N, int G_, int c_) { nM = M / BM; nN = N / BM; nwg = nM * nN; G = G_; c = c_; }
    __host__ __device__ bool next(int i, Unit& u) const {
        const long L = (long)i * G + c; if (L >= nwg) return false;
        int wgid = (int)L; { const int q = nwg / NXCD, r = nwg % NXCD, xcd = wgid % NXCD, off = wgid / NXCD; wgid = (xcd < r ? xcd * (q + 1) : r * (q + 1) + (xcd - r) * q) + off; }
        const int nig = WGM * nN, gid = wgid / nig, fm = gid * WGM, gsz = (nM - fm) < WGM ? (nM - fm) : WGM;
        u.pm = fm + ((wgid % nig) % gsz); u.pn = (wgid % nig) / gsz; u.g = 0; return true;
    }
    __device__ __forceinline__ void a_ready(const Unit&) const {}
    __device__ __forceinline__ void done(const Unit&) const {}
};
template <class Epi, class Sched, bool STAMP = false>
__device__ __forceinline__ void gemm_phase(PG8_LAS unsigned char* lds, const Gemm g_in, const Sched& S, const Epi& E, unsigned long long* stamps) {
    Gemm g = g_in;
    { unsigned long long v = (unsigned long long)g.A; g.A = (const bf16_t*)(((unsigned long long)(unsigned)__builtin_amdgcn_readfirstlane((int)(v >> 32)) << 32) | (unsigned)__builtin_amdgcn_readfirstlane((int)v));
      v = (unsigned long long)g.Bt; g.Bt = (const bf16_t*)(((unsigned long long)(unsigned)__builtin_amdgcn_readfirstlane((int)(v >> 32)) << 32) | (unsigned)__builtin_amdgcn_readfirstlane((int)v)); }
    const int tid = opaque_tid(), wid = __builtin_amdgcn_readfirstlane(tid >> 6), lane = tid & 63, wr = wid >> 2, wc = wid & 3, fr = lane & 15, fq = lane >> 4;
    int K = g.K; asm volatile("" : "+s"(K));
    const int nt = K / BK;
    int ts_lo = 0, ts_hi = 0, nts = 0; const unsigned long long rt_entry = STAMP ? (unsigned long long)wall_clock64() : 0ull;
#define PG8_STAMP() do { if (STAMP && wid == 0 && nts < 64) { const unsigned long long _c = (unsigned long long)clock64(); \
        ts_lo = (lane == nts) ? (int)(unsigned)_c : ts_lo; ts_hi = (lane == nts) ? (int)(unsigned)(_c >> 32) : ts_hi; ++nts; } } while (0)
    PG8_STAMP();
    unsigned voffA[2], voffB[2];
#pragma unroll
    for (int i = 0; i < 2; ++i) { int R, C; stage_rc(tid * 16 + i * 8192, R, C); const int Rb = Epi::PERM ? ((R & ~31) + perm32(R & 31)) : R;
        voffA[i] = (unsigned)(R * K + C) * 2u; voffB[i] = (unsigned)(Rb * K + C) * 2u; }
    const size_t kstep = (size_t)(BK * 2);
    const size_t hstep = (size_t)HALF * K * 2;
    const size_t tstep = 2 * hstep;
    const unsigned ldsw = (unsigned)wid * 1024u;
    const int aoff = lds_byte(wr * 64 + fr, fq * 8), boff = lds_byte(wc * 32 + fr, fq * 8);
#define PG8_SA(b, h) (((b) * 2 + (h)) * HTB)
#define PG8_SB(b, h) ((4 + (b) * 2 + (h)) * HTB)
#define PG8_STAGE(bufoff, gbase, voff) do { _Pragma("unroll") for (int _i = 0; _i < 2; ++_i) \
        __builtin_amdgcn_global_load_lds((const unsigned*)((const char*)(gbase) + (voff)[_i]), (PG8_LAS unsigned*)(lds + (bufoff) + ldsw + _i * 8192), 16, 0, 0); } while (0)
#define PG8_LDA(dst, b, h) do { _Pragma("unroll") for (int m = 0; m < 4; ++m) _Pragma("unroll") for (int k = 0; k < 2; ++k) dst[m][k] = *(const PG8_LAS bf16x8*)(lds + PG8_SA(b, h) + aoff + m * 2048 + k * 1024); } while (0)
#define PG8_LDB(dst, b, h) do { _Pragma("unroll") for (int n = 0; n < 2; ++n) _Pragma("unroll") for (int k = 0; k < 2; ++k) dst[n][k] = *(const PG8_LAS bf16x8*)(lds + PG8_SB(b, h) + boff + n * 2048 + k * 1024); } while (0)
#define PG8_MMA(ai, bj, At, Bt) do { __builtin_amdgcn_s_setprio(1); _Pragma("unroll") for (int m = 0; m < 4; ++m) _Pragma("unroll") for (int n = 0; n < 2; ++n) _Pragma("unroll") for (int k = 0; k < 2; ++k) \
        acc[ai][bj][m][n] = __builtin_amdgcn_mfma_f32_16x16x32_bf16(Bt[n][k], At[m][k], acc[ai][bj][m][n], 0, 0, 0); __builtin_amdgcn_s_setprio(0); } while (0)
#define PG8_WAIT_V(n) asm volatile("s_waitcnt vmcnt(" #n ")" ::: "memory")
#define PG8_WAIT_L(n) asm volatile("s_waitcnt lgkmcnt(" #n ")" ::: "memory")
#define PG8_BAR __builtin_amdgcn_s_barrier()
#define PG8_SCHED __builtin_amdgcn_sched_barrier(0)
    Unit cur, nxt; int ui = 0;
    if (!S.next(0, cur)) return;
    f32x4 acc[2][2][4][2];
#pragma unroll
    for (int a = 0; a < 2; ++a)
#pragma unroll
        for (int b = 0; b < 2; ++b)
#pragma unroll
            for (int m = 0; m < 4; ++m)
#pragma unroll
                for (int n = 0; n < 2; ++n) acc[a][b][m][n] = (f32x4){0.f, 0.f, 0.f, 0.f};
    bf16x8 At[4][2], B0[2][2], B1[2][2];
    const char* cA = (const char*)g.A + (size_t)cur.pm * tstep + (size_t)cur.g * g.gsA; const char* cB = (const char*)g.Bt + (size_t)cur.pn * tstep + (size_t)cur.g * g.gsB;
    S.a_ready(cur);
    PG8_STAGE(PG8_SB(0, 0), cB, voffB); PG8_STAGE(PG8_SA(0, 0), cA, voffA); PG8_STAGE(PG8_SB(0, 1), cB + hstep, voffB); PG8_STAGE(PG8_SA(0, 1), cA + hstep, voffA);
    if (wr == 1) PG8_BAR;
    PG8_WAIT_V(4); PG8_BAR;
    PG8_STAGE(PG8_SB(1, 0), cB + kstep, voffB); PG8_STAGE(PG8_SA(1, 0), cA + kstep, voffA); PG8_STAGE(PG8_SB(1, 1), cB + hstep + kstep, voffB);
    PG8_WAIT_V(6); PG8_BAR;
    PG8_STAMP();
    for (;;) {
        const bool has_next = S.next(ui + 1, nxt);
        const char* nA = has_next ? (const char*)g.A + (size_t)nxt.pm * tstep + (size_t)nxt.g * g.gsA : cA; const char* nB = has_next ? (const char*)g.Bt + (size_t)nxt.pn * tstep + (size_t)nxt.g * g.gsB : cB;
        for (int t = 0; t < nt; t += 2) {
            const bool last = (t == nt - 2);
            const char* a1 = cA + (size_t)(t + 1) * kstep;
            const char* a2 = last ? nA : cA + (size_t)(t + 2) * kstep; const char* b2 = last ? nB : cB + (size_t)(t + 2) * kstep;
            const char* a3 = a2 + kstep; const char* b3 = b2 + kstep;
            if (last && has_next) S.a_ready(nxt);
            PG8_LDB(B0, 0, 0); PG8_SCHED; PG8_LDA(At, 0, 0); PG8_STAGE(PG8_SA(1, 1), a1 + hstep, voffA);
            PG8_WAIT_L(8); PG8_BAR; PG8_WAIT_L(0); PG8_MMA(0, 0, At, B0); PG8_BAR; PG8_SCHED;
            PG8_LDB(B1, 0, 1); PG8_STAGE(PG8_SB(0, 0), b2, voffB);
            PG8_BAR; PG8_WAIT_L(0); PG8_MMA(0, 1, At, B1); PG8_BAR;
            PG8_LDA(At, 0, 1); PG8_STAGE(PG8_SA(0, 0), a2, voffA);
            PG8_BAR; PG8_WAIT_L(0); PG8_MMA(1, 0, At, B0); PG8_BAR; PG8_SCHED;
            PG8_STAGE(PG8_SB(0, 1), b2 + hstep, voffB);
            PG8_WAIT_V(6); PG8_BAR; PG8_MMA(1, 1, At, B1); PG8_BAR;
            PG8_LDB(B0, 1, 0); PG8_SCHED; PG8_LDA(At, 1, 0); PG8_STAGE(PG8_SA(0, 1), a2 + hstep, voffA);
            PG8_WAIT_L(8); PG8_BAR; PG8_WAIT_L(0); PG8_MMA(0, 0, At, B0); PG8_BAR; PG8_SCHED;
            PG8_LDB(B1, 1, 1); PG8_STAGE(PG8_SB(1, 0), b3, voffB);
            PG8_BAR; PG8_WAIT_L(0); PG8_MMA(0, 1, At, B1); PG8_BAR;
            PG8_LDA(At, 1, 1); PG8_STAGE(PG8_SA(1, 0), a3, voffA);
            PG8_BAR; PG8_WAIT_L(0); PG8_MMA(1, 0, At, B0); PG8_BAR; PG8_SCHED;
            PG8_STAGE(PG8_SB(1, 1), b3 + hstep, voffB);
            PG8_WAIT_V(6); PG8_BAR; PG8_MMA(1, 1, At, B1); PG8_BAR;
        }
        PG8_STAMP();
        if constexpr (!Epi::AFTER_DRAIN) { E(acc, cur, wr, wc, fr, fq); S.done(cur); }
        PG8_STAMP();
        if (!has_next) break;
#pragma unroll
        for (int a = 0; a < 2; ++a)
#pragma unroll
            for (int b = 0; b < 2; ++b)
#pragma unroll
                for (int m = 0; m < 4; ++m)
#pragma unroll
                    for (int n = 0; n < 2; ++n) acc[a][b][m][n] = (f32x4){0.f, 0.f, 0.f, 0.f};
        cur = nxt; cA = nA; cB = nB; ++ui;
    }
    PG8_WAIT_V(0);
    if (wr == 0) PG8_BAR;
    PG8_BAR;
    if constexpr (Epi::AFTER_DRAIN) { E.fused(acc, cur, wr, wc, fr, fq, lds, wid, lane); S.done(cur); }
    PG8_STAMP();
    if (STAMP && wid == 0) { stamps[lane] = lane < nts ? (((unsigned long long)(unsigned)ts_hi << 32) | (unsigned)ts_lo) : 0ull;
        if (lane == 62) stamps[62] = rt_entry; if (lane == 63) stamps[63] = (unsigned long long)wall_clock64(); }
#undef PG8_STAMP
#undef PG8_SA
#undef PG8_SB
#undef PG8_STAGE
#undef PG8_LDA
#undef PG8_LDB
#undef PG8_MMA
#undef PG8_WAIT_V
#undef PG8_WAIT_L
#undef PG8_BAR
#undef PG8_SCHED
}
}
using pg8::bf16_t; using pg8::bf16x8; using pg8::f32x4; using pg8::u32x4;
#define DI __device__ __forceinline__
typedef float f32x16 __attribute__((ext_vector_type(16)));
typedef float f32x2 __attribute__((ext_vector_type(2)));
typedef short s16x4 __attribute__((ext_vector_type(4)));
typedef unsigned u32x2 __attribute__((ext_vector_type(2)));
typedef __bf16 bfv2 __attribute__((ext_vector_type(2)));

constexpr int T = 16384, SEQ = 2048, DM = 1024, NIN = 12552, NU = 12544;
constexpr float EPS = 1e-6f, LOG2E = 1.4426950408889634f;
constexpr int U_QA = 0, U_KA = 512, U_VA = 1024, U_OA = 1536, U_ZA = 2048, U_XB = 2560, U_ZB = 3072, U_QC = 3584, U_KC = 4096, U_VC = 4224, U_ZC = 4352,
              U_QD = 4864, U_FD = 5376, U_ID = 5888, U_ZD = 6400, U_QE = 6912, U_ZE = 7168, U_G = 7424;
constexpr size_t WS_WIN = 0, SZ_WIN1 = (size_t)NU * 1024 * 2, SZ_WIN = 2 * SZ_WIN1;
constexpr size_t WS_WBR = WS_WIN + SZ_WIN, SZ_WBR = (size_t)4 * 2304 * 1024 * 2;
constexpr size_t WS_WOUT = WS_WBR + SZ_WBR, SZ_WOUT = (size_t)4 * 1024 * 1024 * 2;
constexpr size_t WS_KVM = WS_WOUT + SZ_WOUT, SZ_KVM = (size_t)2048 * 2048 * 2;
constexpr size_t WS_H = WS_KVM + SZ_KVM, SZ_H = (size_t)T * 1024 * 2;
constexpr size_t WS_IF = WS_H + SZ_H, SZ_IF = (size_t)T * 8 * 4;
constexpr size_t WS_LB = WS_IF + SZ_IF, SZ_LB = 4 * 512 * 4;
constexpr size_t WS_NA = WS_LB + SZ_LB, SZ_NA = 512 * 128 * 4;
constexpr size_t WS_GA = WS_NA + SZ_NA, SZ_GA = 512 * 4;
constexpr size_t WS_DECD = WS_GA + SZ_GA, SZ_DECD = 1024 * 128 * 4;
constexpr size_t WS_CARB = WS_DECD + SZ_DECD, SZ_CARB = 256 * 512 * 4;
constexpr size_t WS_U = WS_CARB + SZ_CARB, SZ_U = (size_t)T * NU * 2;
constexpr size_t WS_MEMN = WS_U, WS_WMEM = WS_U + (size_t)2048 * 1024 * 2;
constexpr size_t WS_YS = WS_U + SZ_U;
constexpr size_t WS_YA = WS_YS, WS_YB = WS_YA + (size_t)T * 512 * 2, WS_YC = WS_YB + (size_t)T * 512 * 2, WS_YD = WS_YC + (size_t)T * 512 * 2, WS_YE = WS_YD + (size_t)T * 512 * 2;
constexpr size_t WS_ST = WS_YE + (size_t)T * 256 * 2;
constexpr size_t WS_STA = WS_ST, WS_STD = WS_STA + (size_t)512 * 16384 * 4, WS_LRUH = WS_STD + (size_t)1024 * 16384 * 4, WS_LRUA = WS_LRUH + (size_t)T * 512 * 4;
constexpr size_t WS_YF = WS_ST;
constexpr size_t WS_BAR = WS_LRUA + (size_t)T * 512 * 4;
constexpr size_t WS_END = WS_BAR + 16384;
constexpr int LDS_BYTES = 155648;

struct Params {
    const float* x; const float* mem; const int* pos; const float* norm_g; const float* w_in; const float* mconv_w; const float* b_if; const float* mnorm_g;
    const float* lconv_w; const float* lconv_b; const float* wa; const float* ba; const float* wx; const float* bx; const float* lam; const float* sinks;
    const float* hlb; const float* hnorm_g; const float* mem_g; const float* w_mem; const float* w_br; const float* w_out; const float* fin_g;
    float* out; unsigned char* ws;
};

DI size_t uoff(size_t tok, int col) { return (((tok >> 8) * 49 + (size_t)(col >> 8)) << 16) + ((tok & 255) << 8) + (size_t)(col & 255); }
DI float bf2f(bf16_t b) { return __uint_as_float(((unsigned)b) << 16); }
DI float bflo(unsigned v) { return __uint_as_float(v << 16); }
DI float bfhi(unsigned v) { return __uint_as_float(v & 0xffff0000u); }
DI unsigned pack2(float lo, float hi) { f32x2 v = {lo, hi}; bfv2 b = __builtin_convertvector(v, bfv2); return __builtin_bit_cast(unsigned, b); }
DI bf16_t f2bf(float f) { return (bf16_t)(pack2(f, 0.f) & 0xffffu); }
DI float fexp_(float x) { return __builtin_amdgcn_exp2f(x * LOG2E); }
DI float sigmoidf_(float x) { return __builtin_amdgcn_rcpf(1.0f + fexp_(-x)); }
DI float siluf_(float x) { return x * sigmoidf_(x); }
DI float logsigf_(float x) { return fminf(x, 0.f) - log1pf(fexp_(-fabsf(x))); }
DI float wave_sum(float v) {
    int x = __float_as_int(v);
    x = __float_as_int(__int_as_float(x) + __int_as_float(__builtin_amdgcn_update_dpp(0, x, 0x128, 0xf, 0xf, false)));
    x = __float_as_int(__int_as_float(x) + __int_as_float(__builtin_amdgcn_update_dpp(0, x, 0x124, 0xf, 0xf, false)));
    x = __float_as_int(__int_as_float(x) + __int_as_float(__builtin_amdgcn_update_dpp(0, x, 0x122, 0xf, 0xf, false)));
    x = __float_as_int(__int_as_float(x) + __int_as_float(__builtin_amdgcn_update_dpp(0, x, 0x121, 0xf, 0xf, false)));
    const float r0 = __int_as_float(__builtin_amdgcn_readlane(x, 0)), r1 = __int_as_float(__builtin_amdgcn_readlane(x, 16)), r2 = __int_as_float(__builtin_amdgcn_readlane(x, 32)), r3 = __int_as_float(__builtin_amdgcn_readlane(x, 48));
    return (r0 + r1) + (r2 + r3);
}
DI int crow(int i, int h) { return (i & 3) + 8 * (i >> 2) + 4 * h; }

template <int MT, int NT> DI void mma_lds(f32x16 (&acc)[MT][NT], const bf16_t* A, int lda, const bf16_t* B, int ldb, int K, int lane) {
    const int r = lane & 31, h = lane >> 5;
    for (int k0 = 0; k0 < K; k0 += 16) {
        bf16x8 a[MT], b[NT];
#pragma unroll
        for (int mt = 0; mt < MT; ++mt) a[mt] = *(const bf16x8*)(A + (32 * mt + r) * lda + k0 + 8 * h);
#pragma unroll
        for (int nt = 0; nt < NT; ++nt) b[nt] = *(const bf16x8*)(B + (32 * nt + r) * ldb + k0 + 8 * h);
#pragma unroll
        for (int mt = 0; mt < MT; ++mt)
#pragma unroll
            for (int nt = 0; nt < NT; ++nt) acc[mt][nt] = __builtin_amdgcn_mfma_f32_32x32x16_bf16(a[mt], b[nt], acc[mt][nt], 0, 0, 0);
    }
}
template <int MT, int NT> DI void zero_acc(f32x16 (&acc)[MT][NT]) {
#pragma unroll
    for (int mt = 0; mt < MT; ++mt)
#pragma unroll
        for (int nt = 0; nt < NT; ++nt)
#pragma unroll
            for (int i = 0; i < 16; ++i) acc[mt][nt][i] = 0.f;
}

struct EpiStoreBf16 {
    static constexpr bool PERM = true, AFTER_DRAIN = false;
    bf16_t* O; int ldc; int blocked;
    DI void operator()(const f32x4 (&acc)[2][2][4][2], const pg8::Unit& u, int wr, int wc, int fr, int fq) const {
        const int row0 = u.pm * 256 + wr * 64 + fr, col0 = u.pn * 256 + wc * 32 + 8 * fq;
#pragma unroll
        for (int ai = 0; ai < 2; ++ai)
#pragma unroll
            for (int m = 0; m < 4; ++m) { bf16_t* rowp = blocked ? O + ((size_t)(u.pm * 49 + u.pn) << 16) + (size_t)(wr * 64 + fr + ai * 128 + m * 16) * 256 + wc * 32 + 8 * fq : O + (size_t)(row0 + ai * 128 + m * 16) * ldc + col0;
#pragma unroll
                for (int bj = 0; bj < 2; ++bj) { const f32x4 v0 = acc[ai][bj][m][0], v1 = acc[ai][bj][m][1];
                    u32x4 w; w.x = pack2(v0[0], v0[1]); w.y = pack2(v0[2], v0[3]); w.z = pack2(v1[0], v1[1]); w.w = pack2(v1[2], v1[3]);
                    __builtin_nontemporal_store(w, (u32x4*)(rowp + bj * 128)); } }
    }
};
struct EpiRes {
    static constexpr bool PERM = false, AFTER_DRAIN = false;
    const float* xres; float* out;
    DI void operator()(const f32x4 (&acc)[2][2][4][2], const pg8::Unit& u, int wr, int wc, int fr, int fq) const {
        const int row0 = u.pm * 256 + wr * 64 + fr, col0 = u.pn * 256 + wc * 32 + 4 * fq;
#pragma unroll
        for (int am = 0; am < 4; ++am) { const int ai = am >> 1, m0 = (am & 1) * 2; f32x4 xv[2][2][2];
#pragma unroll
            for (int mm = 0; mm < 2; ++mm) { const size_t r = (size_t)(row0 + ai * 128 + (m0 + mm) * 16);
#pragma unroll
                for (int bj = 0; bj < 2; ++bj)
#pragma unroll
                    for (int n = 0; n < 2; ++n) xv[mm][bj][n] = *(const f32x4*)(xres + r * 1024 + col0 + bj * 128 + n * 16); }
            __builtin_amdgcn_sched_barrier(0);
#pragma unroll
            for (int mm = 0; mm < 2; ++mm) { const size_t r = (size_t)(row0 + ai * 128 + (m0 + mm) * 16);
#pragma unroll
                for (int bj = 0; bj < 2; ++bj)
#pragma unroll
                    for (int n = 0; n < 2; ++n) *(f32x4*)(out + r * 1024 + col0 + bj * 128 + n * 16) = xv[mm][bj][n] + acc[ai][bj][m0 + mm][n]; }
            __builtin_amdgcn_sched_barrier(0); }
    }
};
struct GroupOrder {
    int G, c;
    __device__ bool next(int i, pg8::Unit& u) const { const int tile = c + (i >> 2) * G; if (tile >= 256) return false; pg8::StaticOrder t; t.init(T, 1024, 256, tile); t.next(0, u); u.g = i & 3; return true; }
    DI void a_ready(const pg8::Unit&) const {}
    DI void done(const pg8::Unit&) const {}
};
struct EpiGateAcc {
    static constexpr bool PERM = true, AFTER_DRAIN = false;
    const bf16_t* gates; bf16_t* P; bf16_t* Y16; int goff;
    DI void operator()(const f32x4 (&acc)[2][2][4][2], const pg8::Unit& u, int wr, int wc, int fr, int fq) const {
        const int row0 = u.pm * 256 + wr * 64 + fr, col0 = u.pn * 256 + wc * 32 + 8 * fq, j = u.g + goff;
        const bf16_t* gp = gates + ((size_t)(u.pm * 49 + 29 + 4 * j + u.pn) << 16) + wc * 32 + 8 * fq;   const size_t pt = ((size_t)(u.pm * 4 + u.pn) << 16) + wc * 32 + 8 * fq;
        bf16_t* dst = (j == 4) ? Y16 + col0 : P + pt; const bf16_t* pp = P + pt;
#pragma unroll
        for (int am = 0; am < 4; ++am) { const int ai = am >> 1, m0 = (am & 1) * 2;
            u32x4 gv[4][2], pv[4][2];
#pragma unroll
            for (int m = m0; m < m0 + 2; ++m) { const size_t r = (size_t)(row0 + ai * 128 + m * 16);
#pragma unroll
                for (int bj = 0; bj < 2; ++bj) { gv[m][bj] = *(const u32x4*)(gp + (r & 255) * 256 + bj * 128); pv[m][bj] = (u32x4){0u, 0u, 0u, 0u}; if (j > 0) pv[m][bj] = *(const u32x4*)(pp + (r & 255) * 256 + bj * 128); } }
            __builtin_amdgcn_sched_barrier(0);
#pragma unroll
            for (int m = m0; m < m0 + 2; ++m) { const size_t r = (size_t)(row0 + ai * 128 + m * 16);
#pragma unroll
                for (int bj = 0; bj < 2; ++bj) { const u32x4 g4 = gv[m][bj], p4 = pv[m][bj]; const f32x4 a0 = acc[ai][bj][m][0], a1 = acc[ai][bj][m][1]; float o[8];
                    o[0] = a0[0] * sigmoidf_(bflo(g4.x)) + bflo(p4.x); o[1] = a0[1] * sigmoidf_(bfhi(g4.x)) + bfhi(p4.x); o[2] = a0[2] * sigmoidf_(bflo(g4.y)) + bflo(p4.y); o[3] = a0[3] * sigmoidf_(bfhi(g4.y)) + bfhi(p4.y);
                    o[4] = a1[0] * sigmoidf_(bflo(g4.z)) + bflo(p4.z); o[5] = a1[1] * sigmoidf_(bfhi(g4.z)) + bfhi(p4.z); o[6] = a1[2] * sigmoidf_(bflo(g4.w)) + bflo(p4.w); o[7] = a1[3] * sigmoidf_(bfhi(g4.w)) + bfhi(p4.w);
                    u32x4 w; w.x = pack2(o[0], o[1]); w.y = pack2(o[2], o[3]); w.z = pack2(o[4], o[5]); w.w = pack2(o[6], o[7]); *(u32x4*)(dst + ((j == 4) ? r * 1024 : (r & 255) * 256) + bj * 128) = w; } }
            __builtin_amdgcn_sched_barrier(0);
        }
    }
};
DI void conv_tile(const float* src, int ld_src, int gap_at, int gap_len, const float* scale, bf16_t* dst, int K, int n0, int k0, unsigned char* sm) {
    bf16_t* tl = (bf16_t*)sm;
    const int tid = opaque_tid();
    float vld[16];
#pragma unroll
    for (int i = 0; i < 16; ++i) { const int idx = i * 512 + tid, kk = idx >> 7, nn = idx & 127, n = n0 + nn, col = n + (n >= gap_at ? gap_len : 0);
        vld[i] = src[(size_t)(k0 + kk) * ld_src + col]; }
#pragma unroll
    for (int i = 0; i < 16; ++i) { const int idx = i * 512 + tid, kk = idx >> 7, nn = idx & 127;
        float v = vld[i]; if (scale) v *= scale[k0 + kk];
        tl[nn * 72 + kk] = f2bf(v); }
    __syncthreads();
#pragma unroll
    for (int i = 0; i < 2; ++i) { const int idx = i * 512 + tid, nn = idx >> 3, kc = idx & 7;
        *(u32x4*)(dst + (size_t)(n0 + nn) * K + k0 + kc * 8) = *(const u32x4*)(tl + nn * 72 + kc * 8); }
    __syncthreads();
}
DI void phase_prologue(const Params& p, unsigned char* sm) {
    const int tid = opaque_tid(), wid = tid >> 6, lane = tid & 63;
    bf16_t* WBR = (bf16_t*)(p.ws + WS_WBR); bf16_t* WOUT = (bf16_t*)(p.ws + WS_WOUT); bf16_t* WMEM = (bf16_t*)(p.ws + WS_WMEM); bf16_t* MEMN = (bf16_t*)(p.ws + WS_MEMN);
    for (int t = blockIdx.x; t < 4 * 480; t += gridDim.x) {
        const int l = t / 480, r = t % 480;
        if (r < 288) { int j, tt, Kj; if (r < 256) { j = r >> 6; tt = r & 63; Kj = 512; } else { j = 4; tt = r - 256; Kj = 256; }
            const int nkt = Kj / 64, nt = tt / nkt, kt = tt % nkt; const size_t off = (size_t)l * 2304 * 1024 + (size_t)j * 512 * 1024;
            conv_tile(p.w_br + off, 1024, 1 << 30, 0, nullptr, WBR + off, Kj, nt * 128, kt * 64, sm); }
        else if (r < 416) { const int tt = r - 288, nt = tt >> 4, kt = tt & 15; const size_t off = (size_t)l * 1024 * 1024;
            conv_tile(p.w_out + off, 1024, 1 << 30, 0, nullptr, WOUT + off, 1024, nt * 128, kt * 64, sm); }
        else { const int tt = r - 416, nt = tt >> 4, kt = tt & 15;
            conv_tile(p.w_mem + (size_t)l * 1024 * 512, 512, 1 << 30, 0, p.mem_g + l * 1024, WMEM + (size_t)l * 512 * 1024, 1024, nt * 128, kt * 64, sm); }
    }
    for (int row = blockIdx.x * 8 + wid; row < 2048; row += gridDim.x * 8) {
        const float* xr = p.mem + (size_t)row * 1024; f32x4 v[4]; float ss = 0.f;
#pragma unroll
        for (int i = 0; i < 4; ++i) { v[i] = *(const f32x4*)(xr + i * 256 + lane * 4); ss += v[i][0] * v[i][0] + v[i][1] * v[i][1] + v[i][2] * v[i][2] + v[i][3] * v[i][3]; }
        ss = wave_sum(ss); const float rs = rsqrtf(ss * (1.0f / 1024.0f) + EPS);
#pragma unroll
        for (int i = 0; i < 4; ++i) { u32x2 w; w.x = pack2(v[i][0] * rs, v[i][1] * rs); w.y = pack2(v[i][2] * rs, v[i][3] * rs); *(u32x2*)(MEMN + (size_t)row * 1024 + i * 256 + lane * 4) = w; }
    }
    if (blockIdx.x == 0) { float* LB = (float*)(p.ws + WS_LB); const int ch = tid;
        const float v0 = p.hlb[ch], v1 = p.hlb[512 + ch], v2 = p.hlb[1024 + ch], v3 = p.hlb[1536 + ch];
        const float mx = fmaxf(fmaxf(v0, v1), fmaxf(v2, v3)); const float e0 = expf(v0 - mx), e1 = expf(v1 - mx), e2 = expf(v2 - mx), e3 = expf(v3 - mx); const float inv = 1.0f / (e0 + e1 + e2 + e3);
        LB[ch] = 0.f; LB[512 + ch] = e1 * inv; LB[1024 + ch] = (e1 + e2) * inv; LB[1536 + ch] = (e1 + e2 + e3) * inv; }
}
DI void convert_win(const Params& p, int l, int first, int stride, unsigned char* sm) {
    bf16_t* WIN = (bf16_t*)(p.ws + WS_WIN + (size_t)(l & 1) * SZ_WIN1); const float* wl = p.w_in + (size_t)l * 1024 * NIN;
    for (int t = first; t < 98 * 16; t += stride) conv_tile(wl, NIN, 2560, 8, nullptr, WIN, 1024, (t >> 4) * 128, (t & 15) * 64, sm);
}
DI void phase_norm(const Params& p, int l, const float* xin, unsigned char* sm) {
    const int tid = opaque_tid(), wid = tid >> 6, lane = tid & 63;
    const float* wl = p.w_in + (size_t)l * 1024 * NIN;
    float* wif = (float*)sm;
    for (int i = tid; i < 8192; i += 512) wif[i] = wl[(size_t)(i >> 3) * NIN + 2560 + (i & 7)];
    __syncthreads();
    bf16_t* H = (bf16_t*)(p.ws + WS_H); float* IFp = (float*)(p.ws + WS_IF); const float* g = p.norm_g + l * 1024;
    f32x4 vn[4];
    { const int tok = blockIdx.x * 8 + wid; if (tok < T) {
#pragma unroll
        for (int i = 0; i < 4; ++i) vn[i] = *(const f32x4*)(xin + (size_t)tok * 1024 + i * 256 + lane * 4); } }
    for (int tok = blockIdx.x * 8 + wid; tok < T; tok += gridDim.x * 8) {
        f32x4 v[4]; float ss = 0.f;
#pragma unroll
        for (int i = 0; i < 4; ++i) { v[i] = vn[i]; ss += v[i][0] * v[i][0] + v[i][1] * v[i][1] + v[i][2] * v[i][2] + v[i][3] * v[i][3]; }
        { const int tn = tok + gridDim.x * 8; if (tn < T) {
#pragma unroll
            for (int i = 0; i < 4; ++i) vn[i] = *(const f32x4*)(xin + (size_t)tn * 1024 + i * 256 + lane * 4); } }
        ss = wave_sum(ss); const float rs = rsqrtf(ss * (1.0f / 1024.0f) + EPS);
        float d0 = 0.f, d1 = 0.f, d2 = 0.f, d3 = 0.f, d4 = 0.f, d5 = 0.f, d6 = 0.f, d7 = 0.f;
#pragma unroll
        for (int i = 0; i < 4; ++i) { const int c0 = i * 256 + lane * 4; const f32x4 gv = *(const f32x4*)(g + c0); f32x4 hv;
#pragma unroll
            for (int j = 0; j < 4; ++j) { hv[j] = v[i][j] * rs * gv[j]; const f32x4 wa_ = *(const f32x4*)(wif + (c0 + j) * 8), wb_ = *(const f32x4*)(wif + (c0 + j) * 8 + 4);
                d0 += hv[j] * wa_[0]; d1 += hv[j] * wa_[1]; d2 += hv[j] * wa_[2]; d3 += hv[j] * wa_[3]; d4 += hv[j] * wb_[0]; d5 += hv[j] * wb_[1]; d6 += hv[j] * wb_[2]; d7 += hv[j] * wb_[3]; }
            u32x2 w; w.x = pack2(hv[0], hv[1]); w.y = pack2(hv[2], hv[3]); *(u32x2*)(H + (size_t)tok * 1024 + c0) = w; }
        d0 = wave_sum(d0); d1 = wave_sum(d1); d2 = wave_sum(d2); d3 = wave_sum(d3); d4 = wave_sum(d4); d5 = wave_sum(d5); d6 = wave_sum(d6); d7 = wave_sum(d7);
        if (lane == 0) { f32x4 a = {d0, d1, d2, d3}, b = {d4, d5, d6, d7}; *(f32x4*)(IFp + (size_t)tok * 8) = a; *(f32x4*)(IFp + (size_t)tok * 8 + 4) = b; }
    }
    __syncthreads();
}
DI void phase_final_norm(const Params& p) {
    const int tid = opaque_tid(), wid = tid >> 6, lane = tid & 63;
    for (int tok = blockIdx.x * 8 + wid; tok < T; tok += gridDim.x * 8) {
        float* xr = p.out + (size_t)tok * 1024; f32x4 v[4]; float ss = 0.f;
#pragma unroll
        for (int i = 0; i < 4; ++i) { v[i] = *(const f32x4*)(xr + i * 256 + lane * 4); ss += v[i][0] * v[i][0] + v[i][1] * v[i][1] + v[i][2] * v[i][2] + v[i][3] * v[i][3]; }
        ss = wave_sum(ss); const float rs = rsqrtf(ss * (1.0f / 1024.0f) + EPS);
#pragma unroll
        for (int i = 0; i < 4; ++i) { const f32x4 gv = *(const f32x4*)(p.fin_g + i * 256 + lane * 4); f32x4 o = v[i] * rs * gv; *(f32x4*)(xr + i * 256 + lane * 4) = o; }
    }
}
template <int R> DI void transpose_pairs(const unsigned* N, int ldn, bf16_t* Tt, int ldt, int tid) {
    constexpr int CPT = 64 * R / 512; const int r = tid & (R - 1), cq = tid / R;
#pragma unroll
    for (int i = 0; i < CPT; ++i) { const int c = cq * CPT + i; const unsigned w = N[r * ldn + c]; Tt[(2 * c) * ldt + r] = (bf16_t)(w & 0xffffu); Tt[(2 * c + 1) * ldt + r] = (bf16_t)(w >> 16); }
}
DI void mlstm_gates(const Params& p, int l, int h, int tok0, float* sg, float* sig, float* stmp) {
    const int tid = opaque_tid(); const float* IFp = (const float*)(p.ws + WS_IF);
    float lf = 0.f;
    if (tid < 128) { const size_t tok = (size_t)(tok0 + tid);
        sig[tid] = IFp[tok * 8 + h] + p.b_if[l * 8 + h];
        lf = logsigf_(IFp[tok * 8 + 4 + h] + p.b_if[l * 8 + 4 + h]);
#pragma unroll
        for (int o = 1; o < 64; o <<= 1) { const float n = __shfl_up(lf, o); if ((tid & 63) >= o) lf += n; }
        if (tid == 63) stmp[0] = lf; }
    __syncthreads();
    if (tid < 128) { if (tid >= 64) lf += stmp[0]; sg[tid] = lf; }
    __syncthreads();
}
DI void load_win19(const bf16_t* U, int b, int tseq0, int ch, unsigned (&xs)[19]) {
    const size_t t0 = (size_t)(b * SEQ + tseq0);
    const bool has_prev = tseq0 >= 3;
    xs[0] = 0u; xs[1] = 0u; xs[2] = 0u;
    if (has_prev) { xs[0] = *(const unsigned*)(U + uoff(t0 - 3, ch)); xs[1] = *(const unsigned*)(U + uoff(t0 - 2, ch)); xs[2] = *(const unsigned*)(U + uoff(t0 - 1, ch)); }
    const bf16_t* pb = U + uoff(t0, ch);
#pragma unroll
    for (int m = 3; m < 19; ++m) xs[m] = *(const unsigned*)(pb + (m - 3) * 256);
}
DI void conv_win(const unsigned (&xs)[19], int i, const float (&w0)[4], const float (&w1)[4], float& y0, float& y1) {
    float a0 = 0.f, a1 = 0.f;
#pragma unroll
    for (int k = 0; k < 4; ++k) { a0 += w0[k] * bflo(xs[i + k]); a1 += w1[k] * bfhi(xs[i + k]); }
    y0 = siluf_(a0); y1 = siluf_(a1);
}
DI void mlstm_local_unit(const Params& p, int l, int ua, unsigned char* sm) {
    const int tid = opaque_tid(), wid = tid >> 6, lane = tid & 63;
    const int bh = ua >> 4, c = ua & 15, b = bh >> 2, h = bh & 3, tok0 = b * SEQ + c * 128;
    float* sg = (float*)sm; float* sig = sg + 128; float* stmp = sg + 256;
    bf16_t* KwT = (bf16_t*)(sm + 2048); bf16_t* VT = (bf16_t*)(sm + 2048 + 34816);
    const bf16_t* U = (const bf16_t*)(p.ws + WS_U);
    unsigned* N1 = (unsigned*)(sm + 71680); unsigned* N2 = (unsigned*)(sm + 104960);
    { const int dp = tid & 63, d = 2 * dp, ch = 512 + h * 128 + d; float w0[4], w1[4];
#pragma unroll
      for (int k = 0; k < 4; ++k) { w0[k] = p.mconv_w[(size_t)l * 4096 + k * 1024 + ch]; w1[k] = p.mconv_w[(size_t)l * 4096 + k * 1024 + ch + 1]; }
      unsigned xs[19]; load_win19(U, b, c * 128 + 16 * wid, ch, xs);
      unsigned vv[16];
#pragma unroll
      for (int i = 0; i < 16; ++i) vv[i] = *(const unsigned*)(U + uoff((size_t)(tok0 + 16 * wid), U_VA + h * 128 + d) + i * 256);
      mlstm_gates(p, l, h, tok0, sg, sig, stmp);
      const float G_ = sg[127];
#pragma unroll
      for (int i = 0; i < 16; ++i) { const int r = 16 * wid + i; float y0, y1; conv_win(xs, i, w0, w1, y0, y1);
          const float wr_ = fexp_(G_ - sg[r] + sig[r]);
          N1[r * 65 + dp] = pack2(y0 * wr_, y1 * wr_); N2[r * 65 + dp] = vv[i]; } }
    const float G = sg[127];
    __syncthreads();
    transpose_pairs<128>(N1, 65, KwT, 136, tid); transpose_pairs<128>(N2, 65, VT, 136, tid);
    __syncthreads();
    f32x16 acc[1][2]; zero_acc<1, 2>(acc);
    const int dt = wid & 3, eh = wid >> 2;
    mma_lds<1, 2>(acc, KwT + 32 * dt * 136, 136, VT + 64 * eh * 136, 136, 128, lane);
    bf16_t* ST = (bf16_t*)(p.ws + WS_STA) + (size_t)ua * 16384;
    { const int r31 = lane & 31, hh = lane >> 5;
#pragma unroll
      for (int nt = 0; nt < 2; ++nt) { const int e = 64 * eh + 32 * nt + r31;
#pragma unroll
          for (int q4 = 0; q4 < 4; ++q4) { const int d0 = 32 * dt + 8 * q4 + 4 * hh; f32x4 v = {acc[0][nt][4 * q4], acc[0][nt][4 * q4 + 1], acc[0][nt][4 * q4 + 2], acc[0][nt][4 * q4 + 3]};
              u32x2 w; w.x = pack2(v[0], v[1]); w.y = pack2(v[2], v[3]); *(u32x2*)(ST + e * 128 + d0) = w; } } }
    { const int d = tid >> 2, qd = tid & 3; float s = 0.f;
#pragma unroll
      for (int i = 0; i < 4; ++i) { const u32x4 v = *(const u32x4*)(KwT + d * 136 + 32 * qd + 8 * i); s += bflo(v.x) + bfhi(v.x) + bflo(v.y) + bfhi(v.y) + bflo(v.z) + bfhi(v.z) + bflo(v.w) + bfhi(v.w); }
      s += __shfl_xor(s, 1); s += __shfl_xor(s, 2);
      if (qd == 0) ((float*)(p.ws + WS_NA))[ua * 128 + d] = s; }
    if (tid == 0) ((float*)(p.ws + WS_GA))[ua] = G;
    __syncthreads();
}
DI void mlstm_scan(const Params& p) {
    const int gt = blockIdx.x * 512 + opaque_tid(), nth = gridDim.x * 512; const float* GA = (const float*)(p.ws + WS_GA);
    for (int it = gt; it < 32 * 4096; it += nth) { const int bh = it >> 12, v = it & 4095; u32x2* base = (u32x2*)((bf16_t*)(p.ws + WS_STA) + (size_t)bh * 16 * 16384) + v;
        u32x2 tmp[16]; float eg[16];
#pragma unroll
        for (int c = 0; c < 16; ++c) { tmp[c] = base[(size_t)c * 4096]; eg[c] = fexp_(GA[bh * 16 + c]); }
        f32x4 S = {0.f, 0.f, 0.f, 0.f};
#pragma unroll
        for (int c = 0; c < 16; ++c) { u32x2 w; w.x = pack2(S[0], S[1]); w.y = pack2(S[2], S[3]); base[(size_t)c * 4096] = w;
            const f32x4 t = {bflo(tmp[c].x), bfhi(tmp[c].x), bflo(tmp[c].y), bfhi(tmp[c].y)}; S = S * eg[c] + t; } }
    for (int it = gt; it < 32 * 32; it += nth) { const int bh = it >> 5, v = it & 31; f32x4* base = (f32x4*)((float*)(p.ws + WS_NA) + (size_t)bh * 16 * 128) + v;
        f32x4 tmp[16]; float eg[16];
#pragma unroll
        for (int c = 0; c < 16; ++c) { tmp[c] = base[c * 32]; eg[c] = fexp_(GA[bh * 16 + c]); }
        f32x4 S = {0.f, 0.f, 0.f, 0.f};
#pragma unroll
        for (int c = 0; c < 16; ++c) { base[c * 32] = S; S = S * eg[c] + tmp[c]; } }
}
DI void mlstm_out_unit(const Params& p, int l, int ua, unsigned char* sm) {
    const int tid = opaque_tid(), wid = tid >> 6, lane = tid & 63, r31 = lane & 31, hh = lane >> 5;
    const int bh = ua >> 4, c = ua & 15, b = bh >> 2, h = bh & 3, tok0 = b * SEQ + c * 128;
    float* sg = (float*)sm; float* sig = sg + 128; float* sden = sg + 256; float* snp = sg + 384;
    bf16_t* Q = (bf16_t*)(sm + 2048); bf16_t* KP = (bf16_t*)(sm + 36864); bf16_t* VT = (bf16_t*)(sm + 71680); bf16_t* STs = (bf16_t*)(sm + 106496);
    float* Hs = (float*)(sm + 2048);
    const bf16_t* U = (const bf16_t*)(p.ws + WS_U);
    unsigned* N2 = (unsigned*)(sm + 106496);
    unsigned fov[16], fzv[16];
#pragma unroll
    for (int jj = 0; jj < 16; ++jj) { const size_t tk = (size_t)(tok0 + wid * 16); fov[jj] = *(const unsigned*)(U + uoff(tk, U_OA + h * 128 + 2 * lane) + jj * 256); fzv[jj] = *(const unsigned*)(U + uoff(tk, U_ZA + h * 128 + 2 * lane) + jj * 256); }
    u32x4 stv[4];
    { const bf16_t* ST = (const bf16_t*)(p.ws + WS_STA) + (size_t)ua * 16384;
#pragma unroll
      for (int i = 0; i < 4; ++i) { const int idx = i * 512 + tid, e = idx >> 4, d8 = (idx & 15) * 8; stv[i] = *(const u32x4*)(ST + e * 128 + d8); } }
    { const int dp = tid & 63, d = 2 * dp, chq = h * 128 + d, chk = 512 + chq; float wq0[4], wq1[4], wk0[4], wk1[4];
#pragma unroll
      for (int k = 0; k < 4; ++k) { wq0[k] = p.mconv_w[(size_t)l * 4096 + k * 1024 + chq]; wq1[k] = p.mconv_w[(size_t)l * 4096 + k * 1024 + chq + 1];
                                    wk0[k] = p.mconv_w[(size_t)l * 4096 + k * 1024 + chk]; wk1[k] = p.mconv_w[(size_t)l * 4096 + k * 1024 + chk + 1]; }
      unsigned xq[19], xk[19]; load_win19(U, b, c * 128 + 16 * wid, chq, xq); load_win19(U, b, c * 128 + 16 * wid, chk, xk);
      unsigned vv[16];
#pragma unroll
      for (int i = 0; i < 16; ++i) vv[i] = *(const unsigned*)(U + uoff((size_t)(tok0 + 16 * wid), U_VA + h * 128 + d) + i * 256);
      mlstm_gates(p, l, h, tok0, sg, sig, sden);
      __builtin_amdgcn_sched_barrier(0);
#pragma unroll
      for (int i = 0; i < 16; ++i) { const int r = 16 * wid + i; float y0, y1;
          conv_win(xq, i, wq0, wq1, y0, y1); *(unsigned*)(Q + r * 136 + d) = pack2(y0 * 0.08838834764831845f, y1 * 0.08838834764831845f);
          if ((i & 3) == 3) __builtin_amdgcn_sched_barrier(0); }
#pragma unroll
      for (int i = 0; i < 16; ++i) { const int r = 16 * wid + i; float y0, y1;
          conv_win(xk, i, wk0, wk1, y0, y1); *(unsigned*)(KP + r * 136 + d) = pack2(y0, y1);
          if ((i & 3) == 3) __builtin_amdgcn_sched_barrier(0); }
#pragma unroll
      for (int i = 0; i < 16; ++i) N2[(16 * wid + i) * 65 + dp] = vv[i];
      __builtin_amdgcn_sched_barrier(0); }
    if (tid < 128) snp[tid] = ((const float*)(p.ws + WS_NA))[ua * 128 + tid];
    __syncthreads();
    const int jt = wid & 3, ch2 = wid >> 2;
    f32x16 acc[1][2]; zero_acc<1, 2>(acc);
    mma_lds<1, 2>(acc, Q + 32 * jt * 136, 136, KP + 64 * ch2 * 136, 136, 128, lane);
    transpose_pairs<128>(N2, 65, VT, 136, tid);
    __syncthreads();
#pragma unroll
    for (int i = 0; i < 4; ++i) { const int idx = i * 512 + tid, e = idx >> 4, d8 = (idx & 15) * 8; *(u32x4*)(STs + e * 136 + d8) = stv[i]; }
#pragma unroll
    for (int nt = 0; nt < 2; ++nt) { const int r = 64 * ch2 + 32 * nt + r31; const float gr = sg[r], ir = sig[r];
#pragma unroll
        for (int i = 0; i < 16; ++i) { const int j = 32 * jt + crow(i, hh); const float val = (r <= j) ? acc[0][nt][i] * fexp_(sg[j] - gr + ir) : 0.f; KP[j * 136 + r] = f2bf(val); } }
    __syncthreads();
    f32x16 apv[1][2], aqs[1][2]; zero_acc<1, 2>(apv); zero_acc<1, 2>(aqs);
    mma_lds<1, 2>(apv, KP + 32 * jt * 136, 136, VT + 64 * ch2 * 136, 136, 128, lane);
    mma_lds<1, 2>(aqs, Q + 32 * jt * 136, 136, STs + 64 * ch2 * 136, 136, 128, lane);
    { const int j = tid >> 2, qd = tid & 3; float s1 = 0.f, s2 = 0.f;
#pragma unroll
      for (int i = 0; i < 4; ++i) { const u32x4 pv = *(const u32x4*)(KP + j * 136 + 32 * qd + 8 * i), qv = *(const u32x4*)(Q + j * 136 + 32 * qd + 8 * i);
          const f32x4 n0 = *(const f32x4*)(snp + 32 * qd + 8 * i), n1 = *(const f32x4*)(snp + 32 * qd + 8 * i + 4);
          s1 += bflo(pv.x) + bfhi(pv.x) + bflo(pv.y) + bfhi(pv.y) + bflo(pv.z) + bfhi(pv.z) + bflo(pv.w) + bfhi(pv.w);
          s2 += bflo(qv.x) * n0[0] + bfhi(qv.x) * n0[1] + bflo(qv.y) * n0[2] + bfhi(qv.y) * n0[3] + bflo(qv.z) * n1[0] + bfhi(qv.z) * n1[1] + bflo(qv.w) * n1[2] + bfhi(qv.w) * n1[3]; }
      s1 += __shfl_xor(s1, 1); s1 += __shfl_xor(s1, 2); s2 += __shfl_xor(s2, 1); s2 += __shfl_xor(s2, 2);
      if (qd == 0) sden[j] = s1 + fexp_(sg[j]) * s2; }
    __syncthreads();
#pragma unroll
    for (int nt = 0; nt < 2; ++nt) { const int e = 64 * ch2 + 32 * nt + r31;
#pragma unroll
        for (int i = 0; i < 16; ++i) { const int j = 32 * jt + crow(i, hh); const float num = apv[0][nt][i] + fexp_(sg[j]) * aqs[0][nt][i]; Hs[j * 132 + e] = num * __builtin_amdgcn_rcpf(fmaxf(fabsf(sden[j]), 1.0f)); } }
    __syncthreads();
    { bf16_t* YA = (bf16_t*)(p.ws + WS_YA); const int e = 2 * lane; const float g0 = p.mnorm_g[l * 512 + h * 128 + e], g1 = p.mnorm_g[l * 512 + h * 128 + e + 1];
#pragma unroll
      for (int jj = 0; jj < 16; ++jj) { const int j = wid * 16 + jj; const f32x2 v = *(const f32x2*)(Hs + j * 132 + e); const float ss = wave_sum(v[0] * v[0] + v[1] * v[1]); const float rs = rsqrtf(ss * (1.0f / 128.0f) + EPS);
          const size_t tok = (size_t)(tok0 + j);
          *(unsigned*)(YA + tok * 512 + h * 128 + e) = pack2(v[0] * rs * g0 * sigmoidf_(bflo(fov[jj])) * siluf_(bflo(fzv[jj])), v[1] * rs * g1 * sigmoidf_(bfhi(fov[jj])) * siluf_(bfhi(fzv[jj]))); } }
    __syncthreads();
}
struct HgIn { unsigned fv[8], qv[8], vv[8], zv[8]; float lb0, lb1; };
template <bool WITH_Q> DI void hgrn_issue(const Params& p, int l, int ud, HgIn& in) {
    const int tid = opaque_tid(), wid = tid >> 6; const int bh = ud >> 5, c = ud & 31, b = bh >> 2, h = bh & 3, tok0 = b * SEQ + c * 64, d = 2 * (tid & 63);
    const bf16_t* U = (const bf16_t*)(p.ws + WS_U); const float* LB = (const float*)(p.ws + WS_LB);
    in.lb0 = LB[l * 512 + h * 128 + d]; in.lb1 = LB[l * 512 + h * 128 + d + 1];
#pragma unroll
    for (int i = 0; i < 8; ++i) { const size_t tk = (size_t)(tok0 + 8 * wid); const int cb = h * 128 + d; in.fv[i] = *(const unsigned*)(U + uoff(tk, U_FD + cb) + i * 256); in.qv[i] = 0u; in.zv[i] = 0u; if (WITH_Q) { in.qv[i] = *(const unsigned*)(U + uoff(tk, U_QD + cb) + i * 256); in.zv[i] = *(const unsigned*)(U + uoff(tk, U_ZD + cb) + i * 256); } in.vv[i] = *(const unsigned*)(U + uoff(tk, U_ID + cb) + i * 256); }
}
DI void hgrn_local_unit(const Params& p, int l, int ud, const HgIn& in, unsigned char* sm) {
    const int tid = opaque_tid(), wid = tid >> 6, lane = tid & 63;
    const int bh = ud >> 5, c = ud & 31, b = bh >> 2, h = bh & 3, tok0 = b * SEQ + c * 64;
    float* bS = (float*)sm; float* kS = (float*)(sm + 33024);
    bf16_t* KwT = (bf16_t*)(sm + 66048); bf16_t* VT = (bf16_t*)(sm + 84480); unsigned* N2 = (unsigned*)(sm + 102912);
    const bf16_t* U = (const bf16_t*)(p.ws + WS_U); const float* LB = (const float*)(p.ws + WS_LB);
    { const int dp = tid & 63, d = 2 * dp; const float lb0 = in.lb0, lb1 = in.lb1;
#pragma unroll
      for (int i = 0; i < 8; ++i) { const int r = 8 * wid + i; const float f0 = bflo(in.fv[i]), f1 = bfhi(in.fv[i]);
          bS[r * 129 + d] = __builtin_amdgcn_logf(lb0 + (1.0f - lb0) * sigmoidf_(f0)); bS[r * 129 + d + 1] = __builtin_amdgcn_logf(lb1 + (1.0f - lb1) * sigmoidf_(f1));
          kS[r * 129 + d] = (1.0f - lb0) * sigmoidf_(-f0); kS[r * 129 + d + 1] = (1.0f - lb1) * sigmoidf_(-f1);
          N2[r * 65 + dp] = in.vv[i]; } }
    __syncthreads();
    float* tot = (float*)(sm + 119552);
    { const int dd = tid & 127, J = tid >> 7; float s = 0.f;
#pragma unroll
      for (int rr = 0; rr < 16; ++rr) { s += bS[(16 * J + rr) * 129 + dd]; bS[(16 * J + rr) * 129 + dd] = s; }
      tot[J * 128 + dd] = s; }
    transpose_pairs<64>(N2, 65, VT, 72, tid);
    __syncthreads();
#pragma unroll
    for (int i = 0; i < 16; ++i) { const int idx = i * 512 + tid, r = idx & 63, d = idx >> 6, J = r >> 4;
        const float t0 = tot[d], t1 = tot[128 + d], t2 = tot[256 + d], t3 = tot[384 + d];
        const float rest = J == 0 ? t0 + t1 + t2 + t3 : (J == 1 ? t1 + t2 + t3 : (J == 2 ? t2 + t3 : t3));
        KwT[d * 72 + r] = f2bf(kS[r * 129 + d] * __builtin_amdgcn_exp2f(rest - bS[r * 129 + d])); }
    if (tid < 128) ((float*)(p.ws + WS_DECD))[ud * 128 + tid] = __builtin_amdgcn_exp2f(tot[tid] + tot[128 + tid] + tot[256 + tid] + tot[384 + tid]);
    __syncthreads();
    f32x16 acc[1][2]; zero_acc<1, 2>(acc);
    const int dt = wid & 3, eh = wid >> 2;
    mma_lds<1, 2>(acc, KwT + 32 * dt * 72, 72, VT + 64 * eh * 72, 72, 64, lane);
    bf16_t* ST = (bf16_t*)(p.ws + WS_STD) + (size_t)ud * 16384;
    { const int r31 = lane & 31, hh = lane >> 5;
#pragma unroll
      for (int nt = 0; nt < 2; ++nt) { const int e = 64 * eh + 32 * nt + r31;
#pragma unroll
          for (int q4 = 0; q4 < 4; ++q4) { const int d0 = 32 * dt + 8 * q4 + 4 * hh; f32x4 v = {acc[0][nt][4 * q4], acc[0][nt][4 * q4 + 1], acc[0][nt][4 * q4 + 2], acc[0][nt][4 * q4 + 3]};
              u32x2 w; w.x = pack2(v[0], v[1]); w.y = pack2(v[2], v[3]); *(u32x2*)(ST + e * 128 + d0) = w; } } }
    __syncthreads();
}
DI void hgrn_scan(const Params& p) {
    const int gt = blockIdx.x * 512 + opaque_tid(), nth = gridDim.x * 512; const float* DEC = (const float*)(p.ws + WS_DECD);
    for (int it = gt; it < 32 * 4096; it += nth) { const int bh = it >> 12, v = it & 4095, d4 = (v & 31) * 4; f32x4 S = {0.f, 0.f, 0.f, 0.f};
#pragma unroll 1
        for (int half = 0; half < 2; ++half) { u32x2* base = (u32x2*)((bf16_t*)(p.ws + WS_STD) + (size_t)(bh * 32 + half * 16) * 16384) + v; const float* db = DEC + (bh * 32 + half * 16) * 128 + d4;
            u32x2 tmp[16]; f32x4 dec[16];
#pragma unroll
            for (int c = 0; c < 16; ++c) { tmp[c] = base[(size_t)c * 4096]; dec[c] = *(const f32x4*)(db + c * 128); }
#pragma unroll
            for (int c = 0; c < 16; ++c) { u32x2 w; w.x = pack2(S[0], S[1]); w.y = pack2(S[2], S[3]); base[(size_t)c * 4096] = w;
                const f32x4 t = {bflo(tmp[c].x), bfhi(tmp[c].x), bflo(tmp[c].y), bfhi(tmp[c].y)}; S = S * dec[c] + t; } } }
}
DI void hgrn_out_unit(const Params& p, int l, int ud, const HgIn& in, unsigned char* sm) {
    const int tid = opaque_tid(), wid = tid >> 6, lane = tid & 63, r31 = lane & 31, hh = lane >> 5;
    const int bh = ud >> 5, c = ud & 31, b = bh >> 2, h = bh & 3, tok0 = b * SEQ + c * 64;
    float* bS = (float*)sm; bf16_t* STs = (bf16_t*)sm; float* tot = (float*)(sm + 32768);
    bf16_t* Qh = (bf16_t*)(sm + 34816); bf16_t* Qb = (bf16_t*)(sm + 52224); bf16_t* KK = (bf16_t*)(sm + 69632); float* Hs = (float*)(sm + 69632);
    bf16_t* VT = (bf16_t*)(sm + 113152); bf16_t* aS = (bf16_t*)(sm + 131584); unsigned* N2 = (unsigned*)(sm + 69632);
    const bf16_t* U = (const bf16_t*)(p.ws + WS_U); const float* LB = (const float*)(p.ws + WS_LB);
    const int dp = tid & 63, d = 2 * dp, R = wid >> 1;
    float q0[8], q1[8], k0[8], k1[8];
    { const float lb0 = in.lb0, lb1 = in.lb1;
#pragma unroll
      for (int i = 0; i < 8; ++i) { const int r = 8 * wid + i; const float f0 = bflo(in.fv[i]), f1 = bfhi(in.fv[i]);
          bS[r * 128 + d] = __builtin_amdgcn_logf(lb0 + (1.0f - lb0) * sigmoidf_(f0)); bS[r * 128 + d + 1] = __builtin_amdgcn_logf(lb1 + (1.0f - lb1) * sigmoidf_(f1));
          k0[i] = (1.0f - lb0) * sigmoidf_(-f0); k1[i] = (1.0f - lb1) * sigmoidf_(-f1);
          q0[i] = siluf_(bflo(in.qv[i])) * 0.08838834764831845f; q1[i] = siluf_(bfhi(in.qv[i])) * 0.08838834764831845f;
          N2[r * 65 + dp] = in.vv[i]; } }
    __syncthreads();
    transpose_pairs<64>(N2, 65, VT, 72, tid);
    { const int dd = tid & 127, J = tid >> 7; float s = 0.f;
#pragma unroll
      for (int rr = 0; rr < 16; ++rr) { s += bS[(16 * J + rr) * 128 + dd]; bS[(16 * J + rr) * 128 + dd] = s; }
      tot[J * 128 + dd] = s; }
    __syncthreads();
    { const f32x2 t0 = *(const f32x2*)(tot + d), t1 = *(const f32x2*)(tot + 128 + d), t2 = *(const f32x2*)(tot + 256 + d);
      float offa[4], offb[4]; offa[0] = 0.f; offb[0] = 0.f; offa[1] = t0[0]; offb[1] = t0[1]; offa[2] = t0[0] + t1[0]; offb[2] = t0[1] + t1[1]; offa[3] = offa[2] + t2[0]; offb[3] = offb[2] + t2[1];
      const float oRa = R == 0 ? offa[0] : (R == 1 ? offa[1] : (R == 2 ? offa[2] : offa[3])), oRb = R == 0 ? offb[0] : (R == 1 ? offb[1] : (R == 2 ? offb[2] : offb[3]));
#pragma unroll
      for (int i = 0; i < 8; ++i) { const int r = 8 * wid + i; const f32x2 lc = *(const f32x2*)(bS + r * 128 + d);
          *(unsigned*)(Qh + r * 136 + d) = pack2(q0[i] * __builtin_amdgcn_exp2f(lc[0]), q1[i] * __builtin_amdgcn_exp2f(lc[1]));
          *(unsigned*)(Qb + r * 136 + d) = pack2(q0[i] * __builtin_amdgcn_exp2f(lc[0] + oRa), q1[i] * __builtin_amdgcn_exp2f(lc[1] + oRb));
#pragma unroll
          for (int J = 0; J < 4; ++J) if (J >= R) { const int rowoff = 8 * J * (J + 1);
              *(unsigned*)(KK + (rowoff + r) * 136 + d) = pack2(k0[i] * __builtin_amdgcn_exp2f(fminf(offa[J] - oRa - lc[0], 100.f)), k1[i] * __builtin_amdgcn_exp2f(fminf(offb[J] - oRb - lc[1], 100.f))); } } }
    __syncthreads();
    { const bf16_t* ST = (const bf16_t*)(p.ws + WS_STD) + (size_t)ud * 16384;
#pragma unroll
      for (int i = 0; i < 4; ++i) { const int idx = i * 512 + tid, e = idx >> 4, d8 = (idx & 15) * 8; *(u32x4*)(STs + e * 136 + d8) = *(const u32x4*)(ST + e * 128 + d8); } }
    { const int c15 = lane & 15, q4 = lane >> 4;
#pragma unroll
      for (int sl = 0; sl < 2; ++sl) { const int slot = 2 * wid + sl, J = slot >> 2, Rt = slot & 3; f32x4 acc = {0.f, 0.f, 0.f, 0.f};
          if (Rt <= J) { const int rowoff = 8 * J * (J + 1);
#pragma unroll
              for (int ks = 0; ks < 4; ++ks) { const bf16x8 af = *(const bf16x8*)(Qh + (16 * J + c15) * 136 + 32 * ks + 8 * q4), bfr = *(const bf16x8*)(KK + (rowoff + 16 * Rt + c15) * 136 + 32 * ks + 8 * q4);
                  acc = __builtin_amdgcn_mfma_f32_16x16x32_bf16(af, bfr, acc, 0, 0, 0); } }
#pragma unroll
          for (int i = 0; i < 4; ++i) { const int jj = 16 * J + 4 * q4 + i, rr = 16 * Rt + c15; aS[jj * 72 + rr] = f2bf((Rt <= J && rr <= jj) ? acc[i] : 0.f); } } }
    __syncthreads();
    const int jt = wid & 1, et = wid >> 1;
    f32x16 acc[1][1]; zero_acc<1, 1>(acc);
    mma_lds<1, 1>(acc, aS + 32 * jt * 72, 72, VT + 32 * et * 72, 72, 64, lane);
    mma_lds<1, 1>(acc, Qb + 32 * jt * 136, 136, STs + 32 * et * 136, 136, 128, lane);
#pragma unroll
    for (int i = 0; i < 16; ++i) Hs[(32 * jt + crow(i, hh)) * 132 + 32 * et + r31] = acc[0][0][i];
    __syncthreads();
    { bf16_t* YD = (bf16_t*)(p.ws + WS_YD); const int e = 2 * lane; const float g0 = p.hnorm_g[l * 512 + h * 128 + e], g1 = p.hnorm_g[l * 512 + h * 128 + e + 1];
#pragma unroll
      for (int jj = 0; jj < 8; ++jj) { const int j = wid * 8 + jj; const f32x2 v = *(const f32x2*)(Hs + j * 132 + e); const float ss = wave_sum(v[0] * v[0] + v[1] * v[1]); const float rs = rsqrtf(ss * (1.0f / 128.0f) + EPS);
          const size_t tok = (size_t)(tok0 + j);
          *(unsigned*)(YD + tok * 512 + h * 128 + e) = pack2(v[0] * rs * g0 * siluf_(bflo(in.zv[jj])), v[1] * rs * g1 * siluf_(bfhi(in.zv[jj]))); } }
    __syncthreads();
}
DI void lru_local_unit(const Params& p, int l, int ub, unsigned char* sm) {
    const int tid = opaque_tid(), wid = tid >> 6, lane = tid & 63, c15 = lane & 15, q = lane >> 4;
    const int b = ub >> 5, c = ub & 31, tseq0 = c * 64, tok0 = b * SEQ + tseq0;
    float* xcf = (float*)sm; bf16_t* xcb = (bf16_t*)(sm + 32768); float* aS = (float*)(sm + 49408); float* uS = (float*)(sm + 82176);
    const bf16_t* U = (const bf16_t*)(p.ws + WS_U);
    unsigned* LHA = (unsigned*)(p.ws + WS_LRUH);
    bf16x8 waf[4][2], wxf[4][2];
    { const float* wa = p.wa + ((size_t)l * 8 + wid) * 4096; const float* wx = p.wx + ((size_t)l * 8 + wid) * 4096;
#pragma unroll
      for (int nt = 0; nt < 4; ++nt)
#pragma unroll
          for (int ks = 0; ks < 2; ++ks) { u32x4 ta, tx;
#pragma unroll
              for (int jp = 0; jp < 4; ++jp) { const int d = 32 * ks + 8 * q + 2 * jp, e = 16 * nt + c15;
                  ta[jp] = pack2(wa[d * 64 + e], wa[(d + 1) * 64 + e]); tx[jp] = pack2(wx[d * 64 + e], wx[(d + 1) * 64 + e]); }
              waf[nt][ks] = __builtin_bit_cast(bf16x8, ta); wxf[nt][ks] = __builtin_bit_cast(bf16x8, tx); } }
    float gba[4], gbx[4], gsp[4];
#pragma unroll
    for (int nt = 0; nt < 4; ++nt) { const int ch = wid * 64 + 16 * nt + c15; gba[nt] = p.ba[l * 512 + ch]; gbx[nt] = p.bx[l * 512 + ch]; gsp[nt] = 8.0f * log1pf(expf(-p.lam[l * 512 + ch])); }
    const int ch = tid; float cw0 = p.lconv_w[l * 2048 + ch], cw1 = p.lconv_w[l * 2048 + 512 + ch], cw2 = p.lconv_w[l * 2048 + 1024 + ch], cw3 = p.lconv_w[l * 2048 + 1536 + ch], cb = p.lconv_b[l * 512 + ch];
    float x0 = 0.f, x1 = 0.f, x2 = 0.f;
    if (tseq0 > 0) { x0 = bf2f(U[uoff((size_t)(tok0 - 3), U_XB + ch)]); x1 = bf2f(U[uoff((size_t)(tok0 - 2), U_XB + ch)]); x2 = bf2f(U[uoff((size_t)(tok0 - 1), U_XB + ch)]); }
    float hst = 0.f, Ac = 1.f;
    float xr[16];
#pragma unroll
    for (int tt = 0; tt < 16; ++tt) xr[tt] = bf2f(U[uoff((size_t)tok0, U_XB + ch) + tt * 256]);
    for (int sc = 0; sc < 4; ++sc) {
#pragma unroll
        for (int tt = 0; tt < 16; ++tt) { const float x3 = xr[tt]; const float xc = cb + cw0 * x0 + cw1 * x1 + cw2 * x2 + cw3 * x3;
            xcf[tt * 512 + ch] = xc; xcb[tt * 520 + ch] = f2bf(xc); x0 = x1; x1 = x2; x2 = x3; }
        if (sc < 3) {
#pragma unroll
            for (int tt = 0; tt < 16; ++tt) xr[tt] = bf2f(U[uoff((size_t)(tok0 + (sc + 1) * 16), U_XB + ch) + tt * 256]); }
        __syncthreads();
        { f32x4 accA[4], accX[4];
#pragma unroll
          for (int nt = 0; nt < 4; ++nt) { accA[nt] = (f32x4){0.f, 0.f, 0.f, 0.f}; accX[nt] = (f32x4){0.f, 0.f, 0.f, 0.f}; }
#pragma unroll
          for (int ks = 0; ks < 2; ++ks) { const bf16x8 af = *(const bf16x8*)(xcb + c15 * 520 + wid * 64 + 32 * ks + 8 * q);
#pragma unroll
              for (int nt = 0; nt < 4; ++nt) { accA[nt] = __builtin_amdgcn_mfma_f32_16x16x32_bf16(af, waf[nt][ks], accA[nt], 0, 0, 0); accX[nt] = __builtin_amdgcn_mfma_f32_16x16x32_bf16(af, wxf[nt][ks], accX[nt], 0, 0, 0); } }
#pragma unroll
          for (int nt = 0; nt < 4; ++nt) { const int che = wid * 64 + 16 * nt + c15;
#pragma unroll
              for (int i = 0; i < 4; ++i) { const int t = 4 * q + i; const float rg = sigmoidf_(accA[nt][i] + gba[nt]), ig = sigmoidf_(accX[nt][i] + gbx[nt]);
                  const float la = -rg * gsp[nt]; const float a = fexp_(la); const float mult = __builtin_amdgcn_sqrtf(fmaxf(fmaf(-a, a, 1.0f), 0.f));
                  aS[t * 512 + che] = a; uS[t * 512 + che] = mult * ig * xcf[t * 512 + che]; } } }
        __syncthreads();
#pragma unroll 4
        for (int tt = 0; tt < 16; ++tt) { const float a = aS[tt * 512 + ch], u = uS[tt * 512 + ch]; hst = a * hst + u; Ac *= a; const size_t o = (size_t)(tok0 + sc * 16 + tt) * 512 + ch; LHA[o] = pack2(hst, Ac); }
    }
    __syncthreads();
}
DI void lru_scan(const Params& p) {
    const int gt = blockIdx.x * 512 + opaque_tid(), nth = gridDim.x * 512; const unsigned* LHA = (const unsigned*)(p.ws + WS_LRUH); float* CB = (float*)(p.ws + WS_CARB);
    for (int it = gt; it < 8 * 512; it += nth) { const int b = it >> 9, ch = it & 511; unsigned ha[32];
#pragma unroll
        for (int c = 0; c < 32; ++c) ha[c] = LHA[(size_t)(b * SEQ + c * 64 + 63) * 512 + ch];
        float H = 0.f;
#pragma unroll
        for (int c = 0; c < 32; ++c) { CB[(b * 32 + c) * 512 + ch] = H; H = bfhi(ha[c]) * H + bflo(ha[c]); } }
}
DI void lru_out(const Params& p) {
    const int gt = blockIdx.x * 512 + opaque_tid(), nth = gridDim.x * 512; const unsigned* LHA = (const unsigned*)(p.ws + WS_LRUH); const float* CB = (const float*)(p.ws + WS_CARB);
    const bf16_t* U = (const bf16_t*)(p.ws + WS_U); bf16_t* YB = (bf16_t*)(p.ws + WS_YB);
    for (int it0 = gt; it0 < T * 128; it0 += 8 * nth) {
        u32x4 ha[8]; f32x4 cr[8]; u32x2 zv[8];
#pragma unroll
        for (int k = 0; k < 8; ++k) { const int it = it0 + k * nth; if (it < T * 128) { const int tok = it >> 7, c4 = (it & 127) * 4; const size_t o = (size_t)tok * 512 + c4;
            ha[k] = *(const u32x4*)(LHA + o); cr[k] = *(const f32x4*)(CB + (size_t)(tok >> 6) * 512 + c4); zv[k] = *(const u32x2*)(U + uoff((size_t)tok, U_ZB + c4)); } }
#pragma unroll
        for (int k = 0; k < 8; ++k) { const int it = it0 + k * nth; if (it < T * 128) { const int tok = it >> 7, c4 = (it & 127) * 4; const size_t o = (size_t)tok * 512 + c4;
            const float h0 = bflo(ha[k].x) + bfhi(ha[k].x) * cr[k][0], h1 = bflo(ha[k].y) + bfhi(ha[k].y) * cr[k][1], h2 = bflo(ha[k].z) + bfhi(ha[k].z) * cr[k][2], h3 = bflo(ha[k].w) + bfhi(ha[k].w) * cr[k][3];
            u32x2 w; w.x = pack2(h0 * siluf_(bflo(zv[k].x)), h1 * siluf_(bfhi(zv[k].x))); w.y = pack2(h2 * siluf_(bflo(zv[k].y)), h3 * siluf_(bfhi(zv[k].y))); *(u32x2*)(YB + o) = w; } } }
}
#define MFMA32(a, b, c) __builtin_amdgcn_mfma_f32_32x32x16_bf16((a), (b), (c), 0, 0, 0)
DI bf16x8 pack_p(const f32x16& x, int s) {
    u32x4 w; w.x = pack2(x[8 * s], x[8 * s + 1]); w.y = pack2(x[8 * s + 2], x[8 * s + 3]); w.z = pack2(x[8 * s + 4], x[8 * s + 5]); w.w = pack2(x[8 * s + 6], x[8 * s + 7]);
    return __builtin_bit_cast(bf16x8, w);
}
DI bf16x8 vt_frag(const bf16_t* VT, int e, int key0, int hh) {
    const s16x4 lo = *(const s16x4*)(VT + e * 260 + key0 + 4 * hh), hi = *(const s16x4*)(VT + e * 260 + key0 + 8 + 4 * hh);
    return __builtin_shufflevector(lo, hi, 0, 1, 2, 3, 4, 5, 6, 7);
}
DI void swa_unit(const Params& p, int l, int uc, unsigned char* sm) {
    const int tid = opaque_tid(), wid = tid >> 6, lane = tid & 63, r31 = lane & 31, hh = lane >> 5;
    const int b = uc >> 5, nb = (uc >> 1) & 15, kv = uc & 1;
    bf16_t* Ks = (bf16_t*)sm; bf16_t* VT = (bf16_t*)(sm + 36864); int* posk = (int*)(sm + 70656); unsigned* N2 = (unsigned*)(sm + 71680);
    const bf16_t* U = (const bf16_t*)(p.ws + WS_U); bf16_t* YC = (bf16_t*)(p.ws + WS_YC);
#pragma unroll
    for (int i = 0; i < 4; ++i) { const int idx = i * 512 + tid, s = idx >> 3, c8 = idx & 7, tseq = nb * 128 - 128 + s; u32x4 v = {0u, 0u, 0u, 0u};
        if (tseq >= 0) v = *(const u32x4*)(U + uoff((size_t)(b * SEQ + tseq), U_KC + kv * 64 + c8 * 8));
        *(u32x4*)(Ks + s * 72 + c8 * 8) = v; }
    { unsigned vv[16];
#pragma unroll
      for (int i = 0; i < 16; ++i) { const int idx = i * 512 + tid, s = idx >> 5, ep = idx & 31; int tseq = nb * 128 - 128 + s; tseq = tseq < 0 ? 0 : tseq;
          vv[i] = *(const unsigned*)(U + uoff((size_t)(b * SEQ + tseq), U_VC + kv * 64 + 2 * ep)); }
#pragma unroll
      for (int i = 0; i < 16; ++i) { const int idx = i * 512 + tid, s = idx >> 5, ep = idx & 31; N2[s * 33 + ep] = (nb * 128 - 128 + s >= 0) ? vv[i] : 0u; } }
    if (tid < 256) { const int tseq = nb * 128 - 128 + tid; posk[tid] = tseq >= 0 ? p.pos[b * SEQ + tseq] : 0; }
    const int g = wid >> 1, th = wid & 1, head = kv * 4 + g; const float slope = exp2f(-(float)(head + 1)), sink = p.sinks[l * 8 + head];
    bf16x8 qn[4];
#pragma unroll
    for (int ks = 0; ks < 4; ++ks) qn[ks] = *(const bf16x8*)(U + uoff((size_t)(b * SEQ + nb * 128 + 64 * th + r31), U_QC + head * 64 + 16 * ks + 8 * hh));
    __syncthreads();
    { const int s = tid & 255, eq = tid >> 8;
#pragma unroll
      for (int i = 0; i < 16; ++i) { const int ep = eq * 16 + i; const unsigned w = N2[s * 33 + ep]; VT[(2 * ep) * 260 + s] = (bf16_t)(w & 0xffffu); VT[(2 * ep + 1) * 260 + s] = (bf16_t)(w >> 16); } }
    __syncthreads();
#pragma unroll 1
    for (int pass = 0; pass < 2; ++pass) {
        const int t0 = 64 * th + 32 * pass, t = t0 + r31; const size_t tok = (size_t)(b * SEQ + nb * 128 + t);
        bf16x8 qf[4];
#pragma unroll
        for (int ks = 0; ks < 4; ++ks) { qf[ks] = qn[ks]; qn[ks] = *(const bf16x8*)(U + uoff(tok + 32 * (1 - pass), U_QC + head * 64 + 16 * ks + 8 * hh)); }
        u32x2 zpre[2][4];
#pragma unroll
        for (int et = 0; et < 2; ++et)
#pragma unroll
            for (int q4 = 0; q4 < 4; ++q4) zpre[et][q4] = *(const u32x2*)(U + uoff(tok, U_ZC + head * 64 + 32 * et + 8 * q4 + 4 * hh));
        f32x16 acc[5];
#pragma unroll
        for (int mt = 0; mt < 5; ++mt) {
#pragma unroll
            for (int i = 0; i < 16; ++i) acc[mt][i] = 0.f;
#pragma unroll
            for (int ks = 0; ks < 4; ++ks) { const bf16x8 kf = *(const bf16x8*)(Ks + (t0 + 32 * mt + r31) * 72 + 16 * ks + 8 * hh); acc[mt] = MFMA32(kf, qf[ks], acc[mt]); } }
        const int pq = posk[128 + t]; float m = -INFINITY;
#pragma unroll
        for (int mt = 0; mt < 5; ++mt)
#pragma unroll
            for (int g4 = 0; g4 < 4; ++g4) { const int cr0 = 8 * g4 + 4 * hh, sb = t0 + 32 * mt + cr0; const u32x4 pk = *(const u32x4*)(posk + sb);
#pragma unroll
                for (int k = 0; k < 4; ++k) { const int i = 4 * g4 + k; bool valid = (nb > 0) || (sb + k >= 128);
                    if (mt == 0) valid = valid && (cr0 + k > r31);
                    if (mt == 4) valid = valid && (cr0 + k <= r31);
                    const float dist = fabsf((float)(pq - (int)pk[k])); const float sc = valid ? acc[mt][i] * 0.125f - slope * dist : -INFINITY; acc[mt][i] = sc; m = fmaxf(m, sc); } }
        m = fmaxf(m, __shfl_xor(m, 32)); m = fmaxf(m, sink);
        float sum = 0.f;
#pragma unroll
        for (int mt = 0; mt < 5; ++mt)
#pragma unroll
            for (int i = 0; i < 16; ++i) { const float pv = fexp_(acc[mt][i] - m); acc[mt][i] = pv; sum += pv; }
        sum += __shfl_xor(sum, 32); sum += fexp_(sink - m); const float inv = __builtin_amdgcn_rcpf(sum);
        f32x16 o[2];
#pragma unroll
        for (int i = 0; i < 16; ++i) { o[0][i] = 0.f; o[1][i] = 0.f; }
#pragma unroll
        for (int mt = 0; mt < 5; ++mt) {
#pragma unroll
            for (int i = 0; i < 16; ++i) acc[mt][i] *= inv;
#pragma unroll
            for (int s2 = 0; s2 < 2; ++s2) { const bf16x8 pf = pack_p(acc[mt], s2);
#pragma unroll
                for (int et = 0; et < 2; ++et) o[et] = MFMA32(vt_frag(VT, 32 * et + r31, t0 + 32 * mt + 16 * s2, hh), pf, o[et]); } }
#pragma unroll
        for (int et = 0; et < 2; ++et)
#pragma unroll
            for (int q4 = 0; q4 < 4; ++q4) { const int e0 = 32 * et + 8 * q4 + 4 * hh; const u32x2 zv = zpre[et][q4];
                u32x2 w; w.x = pack2(o[et][4 * q4] * siluf_(bflo(zv.x)), o[et][4 * q4 + 1] * siluf_(bfhi(zv.x))); w.y = pack2(o[et][4 * q4 + 2] * siluf_(bflo(zv.y)), o[et][4 * q4 + 3] * siluf_(bfhi(zv.y)));
                *(u32x2*)(YC + tok * 512 + head * 64 + e0) = w; }
    }
    __syncthreads();
}
DI void xattn_unit(const Params& p, int l, int ue, unsigned char* sm) {
    const int tid = opaque_tid(), wid = tid >> 6, lane = tid & 63, r31 = lane & 31, hh = lane >> 5;
    const int b = ue >> 5, hd = (ue >> 3) & 3, qt = ue & 7;
    bf16_t* Ks = (bf16_t*)sm; bf16_t* VT = (bf16_t*)(sm + 36864); unsigned* N2 = (unsigned*)(sm + 71680);
    const bf16_t* U = (const bf16_t*)(p.ws + WS_U); const bf16_t* KVM = (const bf16_t*)(p.ws + WS_KVM); bf16_t* YE = (bf16_t*)(p.ws + WS_YE);
#pragma unroll
    for (int i = 0; i < 4; ++i) { const int idx = i * 512 + tid, s = idx >> 3, c8 = idx & 7;
        *(u32x4*)(Ks + s * 72 + c8 * 8) = *(const u32x4*)(KVM + (size_t)(b * 256 + s) * 2048 + l * 512 + hd * 64 + c8 * 8); }
    { unsigned vv[16];
#pragma unroll
      for (int i = 0; i < 16; ++i) { const int idx = i * 512 + tid, s = idx >> 5, ep = idx & 31; vv[i] = *(const unsigned*)(KVM + (size_t)(b * 256 + s) * 2048 + l * 512 + 256 + hd * 64 + 2 * ep); }
#pragma unroll
      for (int i = 0; i < 16; ++i) { const int idx = i * 512 + tid, s = idx >> 5, ep = idx & 31; N2[s * 33 + ep] = vv[i]; } }
    const int t = qt * 256 + 32 * wid + r31; const size_t tok = (size_t)(b * SEQ + t);
    bf16x8 qf[4];
#pragma unroll
    for (int ks = 0; ks < 4; ++ks) qf[ks] = *(const bf16x8*)(U + uoff(tok, U_QE + hd * 64 + 16 * ks + 8 * hh));
    u32x2 zpre[2][4];
#pragma unroll
    for (int et = 0; et < 2; ++et)
#pragma unroll
        for (int q4 = 0; q4 < 4; ++q4) zpre[et][q4] = *(const u32x2*)(U + uoff(tok, U_ZE + hd * 64 + 32 * et + 8 * q4 + 4 * hh));
    __syncthreads();
    { const int s = tid & 255, eq = tid >> 8;
#pragma unroll
      for (int i = 0; i < 16; ++i) { const int ep = eq * 16 + i; const unsigned w = N2[s * 33 + ep]; VT[(2 * ep) * 260 + s] = (bf16_t)(w & 0xffffu); VT[(2 * ep + 1) * 260 + s] = (bf16_t)(w >> 16); } }
    __syncthreads();
    float m = -INFINITY;
#pragma unroll 1
    for (int half = 0; half < 2; ++half) { f32x16 acc[4];
#pragma unroll
        for (int mt = 0; mt < 4; ++mt) {
#pragma unroll
            for (int i = 0; i < 16; ++i) acc[mt][i] = 0.f;
#pragma unroll
            for (int ks = 0; ks < 4; ++ks) { const bf16x8 kf = *(const bf16x8*)(Ks + (128 * half + 32 * mt + r31) * 72 + 16 * ks + 8 * hh); acc[mt] = MFMA32(kf, qf[ks], acc[mt]); }
#pragma unroll
            for (int i = 0; i < 16; ++i) m = fmaxf(m, acc[mt][i]); } }
    m = fmaxf(m, __shfl_xor(m, 32)) * 0.125f;
    float sum = 0.f; f32x16 o[2];
#pragma unroll
    for (int i = 0; i < 16; ++i) { o[0][i] = 0.f; o[1][i] = 0.f; }
#pragma unroll 1
    for (int half = 0; half < 2; ++half) { f32x16 acc[4];
#pragma unroll
        for (int mt = 0; mt < 4; ++mt) {
#pragma unroll
            for (int i = 0; i < 16; ++i) acc[mt][i] = 0.f;
#pragma unroll
            for (int ks = 0; ks < 4; ++ks) { const bf16x8 kf = *(const bf16x8*)(Ks + (128 * half + 32 * mt + r31) * 72 + 16 * ks + 8 * hh); acc[mt] = MFMA32(kf, qf[ks], acc[mt]); }
#pragma unroll
            for (int i = 0; i < 16; ++i) { const float pv = fexp_(acc[mt][i] * 0.125f - m); acc[mt][i] = pv; sum += pv; }
#pragma unroll
            for (int s2 = 0; s2 < 2; ++s2) { const bf16x8 pf = pack_p(acc[mt], s2);
#pragma unroll
                for (int et = 0; et < 2; ++et) o[et] = MFMA32(vt_frag(VT, 32 * et + r31, 128 * half + 32 * mt + 16 * s2, hh), pf, o[et]); } } }
    sum += __shfl_xor(sum, 32); const float inv = __builtin_amdgcn_rcpf(sum);
#pragma unroll
    for (int et = 0; et < 2; ++et)
#pragma unroll
        for (int q4 = 0; q4 < 4; ++q4) { const int e0 = 32 * et + 8 * q4 + 4 * hh; const u32x2 zv = zpre[et][q4];
            u32x2 w; w.x = pack2(o[et][4 * q4] * inv * siluf_(bflo(zv.x)), o[et][4 * q4 + 1] * inv * siluf_(bfhi(zv.x))); w.y = pack2(o[et][4 * q4 + 2] * inv * siluf_(bflo(zv.y)), o[et][4 * q4 + 3] * inv * siluf_(bfhi(zv.y)));
            *(u32x2*)(YE + tok * 256 + hd * 64 + e0) = w; }
    __syncthreads();
}
#define XB_TMO      128
#define XB_XCNT(j)  (256  + 64 * (j))
#define XB_XSUB(j)  (1280 + 64 * (j))
#define XB_XGEN(j)  (2304 + 64 * (j))
#define XB_TOP      3328
#define XB_TOPGEN   3392
#define XCD_BAR_WORDS 3456
#define XB_SPIN_CAP (1u << 18)
#define LAS __attribute__((address_space(3)))
__device__ __forceinline__ unsigned xb_ld(unsigned* p)              { return __hip_atomic_load(p, __ATOMIC_RELAXED, __HIP_MEMORY_SCOPE_AGENT); }
__device__ __forceinline__ unsigned xb_add(unsigned* p, unsigned v) { return __hip_atomic_fetch_add(p, v, __ATOMIC_RELAXED, __HIP_MEMORY_SCOPE_AGENT); }
__device__ __forceinline__ unsigned xb_xcc_id() { return (unsigned)__builtin_amdgcn_s_getreg((3 << 11) | 20) & 0xFu; }
#define XB_SPIN(cond, bar) do { unsigned _sp = 0; while (cond) { __builtin_amdgcn_s_sleep(1); \
    if ((++_sp & 255u) == 0u) { if (xb_ld(&(bar)[XB_TMO])) break; if (_sp > XB_SPIN_CAP) { atomicAdd(&(bar)[XB_TMO], 1u); break; } } } } while (0)

struct XcdBarrier {
    unsigned* bar; unsigned x;
    volatile LAS unsigned* st;
};

__device__ __forceinline__ XcdBarrier xcd_barrier_post(unsigned* bar, volatile LAS unsigned* st) {
    XcdBarrier b; b.bar = bar; b.x = xb_xcc_id(); b.st = st;
    if (threadIdx.x == 0) (void)xb_add(&bar[XB_XCNT(b.x)], 1u);
    return b;
}
__device__ __forceinline__ void xcd_barrier_complete(unsigned* bar, unsigned x, unsigned& nloc, unsigned& nx) {
    const unsigned G = gridDim.x * gridDim.y * gridDim.z;
    unsigned sum, cnt, mine, sp = 0u;
    for (;;) {
        sum = 0u; cnt = 0u; mine = 0u;
#pragma unroll
        for (unsigned j = 0; j < 16; ++j) { const unsigned c = xb_ld(&bar[XB_XCNT(j)]); sum += c; cnt += (c > 0u) ? 1u : 0u; mine = (j == x) ? c : mine; }
        if (sum == G) break;
        __builtin_amdgcn_s_sleep(1);
        if ((++sp & 255u) == 0u) { if (xb_ld(&bar[XB_TMO])) break; if (sp > XB_SPIN_CAP) { atomicAdd(&bar[XB_TMO], 1u); break; } }
    }
    nloc = mine > 0u ? mine : 1u; nx = cnt > 0u ? cnt : 1u;
}

__device__ __forceinline__ void xcd_barrier(const XcdBarrier& b) {
    asm volatile("s_waitcnt vmcnt(0)" ::: "memory");
    __syncthreads();
    if (threadIdx.x == 0) {
        unsigned* bar = b.bar;
        __builtin_amdgcn_s_waitcnt(0);
        unsigned nloc = b.st[0], nx = b.st[1];
        if (nloc == 0u) { xcd_barrier_complete(bar, b.x, nloc, nx); b.st[0] = nloc; b.st[1] = nx; }
        const unsigned old = xb_add(&bar[XB_XSUB(b.x)], 1u);
        const unsigned gen = old / nloc;
        if (old + 1u == (gen + 1u) * nloc) {
            __builtin_amdgcn_fence(__ATOMIC_RELEASE, "agent");
            asm volatile("s_waitcnt vmcnt(0)" ::: "memory");
            const unsigned og = xb_add(&bar[XB_TOP], 1u);
            const unsigned tg = og / nx;
            if (og + 1u == (tg + 1u) * nx) xb_add(&bar[XB_TOPGEN], 1u);
            else XB_SPIN(xb_ld(&bar[XB_TOPGEN]) == tg, bar);
            __builtin_amdgcn_fence(__ATOMIC_ACQUIRE, "agent");
            xb_add(&bar[XB_XGEN(b.x)], 1u);
            asm volatile("s_waitcnt vmcnt(0)" ::: "memory");
        } else {
            XB_SPIN(xb_ld(&bar[XB_XGEN(b.x)]) == gen, bar);
            __builtin_amdgcn_fence(__ATOMIC_ACQUIRE, "agent");
            asm volatile("s_waitcnt vmcnt(0)" ::: "memory");
        }
    }
    __syncthreads();
}

typedef const __attribute__((address_space(4))) unsigned char* kargp_t;
DI Params load_params(kargp_t kp) { asm volatile("" : "+s"(kp)); Params q; __builtin_memcpy(&q, kp, sizeof(Params)); return q; }
__global__ void __launch_bounds__(512, 2) hybrid_fwd(Params p_unused) {
    const kargp_t kp = (kargp_t)__builtin_amdgcn_kernarg_segment_ptr();
#define p (load_params(kp))
#define GSYNC() do { XcdBarrier b_; b_.bar = (unsigned*)(p.ws + WS_BAR); b_.x = xb_xcc_id(); b_.st = xst; xcd_barrier(b_); } while (0)
    extern __shared__ __attribute__((aligned(16))) unsigned char shm[];
    cg::grid_group grid = cg::this_grid();
    PG8_LAS unsigned char* lds = (PG8_LAS unsigned char*)shm;
    const int G = (int)gridDim.x, bid = (int)blockIdx.x;
#define Ub ((bf16_t*)(p.ws + WS_U))
#define Hb ((bf16_t*)(p.ws + WS_H))
    volatile LAS unsigned* xst = (volatile LAS unsigned*)(lds + (LDS_BYTES - 16));
    if (threadIdx.x == 0) { xst[0] = 0u; xst[1] = 0u; }
    __syncthreads();
    (void)xcd_barrier_post((unsigned*)(p.ws + WS_BAR), xst);
    phase_prologue(p, shm);
    convert_win(p, 0, bid, G, shm);
    if (G == 0x7fffffff) grid.sync();
    GSYNC();
    { pg8::StaticOrder S; S.init(2048, 2048, G, bid); pg8::Gemm g{(const bf16_t*)(p.ws + WS_MEMN), (const bf16_t*)(p.ws + WS_WMEM), 2048, 2048, 1024, 0, 0};
      EpiStoreBf16 E{(bf16_t*)(p.ws + WS_KVM), 2048, 0}; pg8::gemm_phase<EpiStoreBf16, pg8::StaticOrder, false>(lds, g, S, E, nullptr); }
#pragma unroll 1
    for (int l = 0; l < 4; ++l) {
        const float* xin = (l == 0) ? p.x : p.out;
        PREP(9)
        phase_norm(p, l, xin, shm);
        GSYNC();
#pragma unroll 1
        for (int rep = 0; rep < 1 + PROBE_DUP_P2; ++rep)
        { pg8::StaticOrder S; S.init(T, NU, G, bid); pg8::Gemm g{Hb, (const bf16_t*)(p.ws + WS_WIN + (size_t)(l & 1) * SZ_WIN1), T, NU, 1024, 0, 0};
          EpiStoreBf16 E{Ub, NU, 1}; pg8::gemm_phase<EpiStoreBf16, pg8::StaticOrder, false>(lds, g, S, E, nullptr); }
        if (PROBE_DUP_P2 == 0 && l < 3) { const int nrem = 3136 % G; if (bid >= nrem) convert_win(p, l + 1, bid - nrem, G - nrem, shm); }
        GSYNC();
#pragma unroll 1
        for (int rep = 0; rep < 1 + PROBE_DUP_P3; ++rep) {
        PREP(1)
        for (int u = bid; u < 256; u += G) swa_unit(p, l, u, shm);
        PREP(2)
        for (int u = bid; u < 256; u += G) xattn_unit(p, l, u, shm);
        PREP(3)
        for (int u = bid; u < 256; u += G) lru_local_unit(p, l, u, shm);
        if (G == 256 && PROBE_UNIT == 0 && PROBE_DUP_P3 == 0) { HgIn ia, ib; hgrn_issue<false>(p, l, bid, ia); hgrn_issue<false>(p, l, bid + 256, ib);
            for (int u = bid; u < 512; u += G) mlstm_local_unit(p, l, u, shm);
            hgrn_local_unit(p, l, bid, ia, shm);
            hgrn_issue<false>(p, l, bid + 512, ia); hgrn_local_unit(p, l, bid + 256, ib, shm); hgrn_issue<false>(p, l, bid + 768, ib); hgrn_local_unit(p, l, bid + 512, ia, shm); hgrn_local_unit(p, l, bid + 768, ib, shm); }
        else {
        PREP(4)
        for (int u = bid; u < 512; u += G) mlstm_local_unit(p, l, u, shm);
        PREP(5)
        if (G == 256) { HgIn ia, ib; hgrn_issue<false>(p, l, bid, ia); hgrn_issue<false>(p, l, bid + 256, ib); hgrn_local_unit(p, l, bid, ia, shm);
            hgrn_issue<false>(p, l, bid + 512, ia); hgrn_local_unit(p, l, bid + 256, ib, shm); hgrn_issue<false>(p, l, bid + 768, ib); hgrn_local_unit(p, l, bid + 512, ia, shm); hgrn_local_unit(p, l, bid + 768, ib, shm); }
        else for (int u = bid; u < 1024; u += G) { HgIn ia; hgrn_issue<false>(p, l, u, ia); hgrn_local_unit(p, l, u, ia, shm); }
        }
        }
#pragma unroll 1
        for (int i = 0; i < PROBE_SYNCS; ++i) GSYNC();
        GSYNC();
        mlstm_scan(p); hgrn_scan(p); lru_scan(p);
        GSYNC();
#pragma unroll 1
        for (int rep = 0; rep < 1 + PROBE_DUP_P5; ++rep) {
        if (G == 256 && PROBE_UNIT == 0 && PROBE_DUP_P5 == 0) { HgIn ia, ib; hgrn_issue<true>(p, l, bid, ia);
            for (int u = bid; u < 512; u += G) mlstm_out_unit(p, l, u, shm);
            hgrn_issue<true>(p, l, bid + 256, ib); hgrn_out_unit(p, l, bid, ia, shm);
            hgrn_issue<true>(p, l, bid + 512, ia); hgrn_out_unit(p, l, bid + 256, ib, shm); hgrn_issue<true>(p, l, bid + 768, ib); hgrn_out_unit(p, l, bid + 512, ia, shm); hgrn_out_unit(p, l, bid + 768, ib, shm); }
        else {
        PREP(6)
        for (int u = bid; u < 512; u += G) mlstm_out_unit(p, l, u, shm);
        PREP(7)
        if (G == 256) { HgIn ia, ib; hgrn_issue<true>(p, l, bid, ia); hgrn_issue<true>(p, l, bid + 256, ib); hgrn_out_unit(p, l, bid, ia, shm);
            hgrn_issue<true>(p, l, bid + 512, ia); hgrn_out_unit(p, l, bid + 256, ib, shm); hgrn_issue<true>(p, l, bid + 768, ib); hgrn_out_unit(p, l, bid + 512, ia, shm); hgrn_out_unit(p, l, bid + 768, ib, shm); }
        else for (int u = bid; u < 1024; u += G) { HgIn ia; hgrn_issue<true>(p, l, u, ia); hgrn_out_unit(p, l, u, ia, shm); }
        }
        PREP(8)
        lru_out(p);
        }
        GSYNC();
#pragma unroll 1
        for (int rep = 0; rep < 1 + PROBE_DUP_P6; ++rep) {
            bf16_t* Pb = (bf16_t*)(p.ws + WS_YF);
            { GroupOrder S{G, bid}; pg8::Gemm g{(const bf16_t*)(p.ws + WS_YS), (const bf16_t*)(p.ws + WS_WBR) + (size_t)l * 2304 * 1024, T, 1024, 512, (size_t)T * 512 * 2, (size_t)512 * 1024 * 2};
              EpiGateAcc E{Ub, Pb, Hb, 0}; pg8::gemm_phase<EpiGateAcc, GroupOrder, false>(lds, g, S, E, nullptr); }
            { pg8::StaticOrder S; S.init(T, 1024, G, bid); pg8::Gemm g{(const bf16_t*)(p.ws + WS_YE), (const bf16_t*)(p.ws + WS_WBR) + (size_t)l * 2304 * 1024 + (size_t)4 * 512 * 1024, T, 1024, 256, 0, 0};
              EpiGateAcc E{Ub, Pb, Hb, 4}; pg8::gemm_phase<EpiGateAcc, pg8::StaticOrder, false>(lds, g, S, E, nullptr); }
        }
        GSYNC();
        { pg8::StaticOrder S; S.init(T, 1024, G, bid); pg8::Gemm g{Hb, (const bf16_t*)(p.ws + WS_WOUT) + (size_t)l * 1024 * 1024, T, 1024, 1024, 0, 0};
          EpiRes E{xin, p.out}; pg8::gemm_phase<EpiRes, pg8::StaticOrder, false>(lds, g, S, E, nullptr); }
        GSYNC();
    }
    phase_final_norm(p);
}
#undef p
#undef GSYNC
#undef Ub
#undef Hb

extern "C" void kernel_launch(void* const* d_in, const int* in_sizes, int n_in, void* d_out, int out_size, void* d_ws, size_t ws_size, hipStream_t stream) {
    static int grid_blocks = 0;
    if (grid_blocks == 0) {
        if (n_in != 23 || ws_size < WS_END) { fprintf(stderr, "kernel_launch: unexpected n_in %d or ws_size %zu (< %zu)\n", n_in, ws_size, (size_t)WS_END); grid_blocks = -1; return; }
        int dev = 0, cus = 0, per_cu = 0;
        hipGetDevice(&dev); hipDeviceGetAttribute(&cus, hipDeviceAttributeMultiprocessorCount, dev);
        if (hipFuncSetAttribute((const void*)hybrid_fwd, hipFuncAttributeMaxDynamicSharedMemorySize, LDS_BYTES) != hipSuccess) { fprintf(stderr, "kernel_launch: hipFuncSetAttribute failed\n"); grid_blocks = -1; return; }
        if (hipOccupancyMaxActiveBlocksPerMultiprocessor(&per_cu, (const void*)hybrid_fwd, 512, LDS_BYTES) != hipSuccess || per_cu < 1) { fprintf(stderr, "kernel_launch: occupancy query failed (%d)\n", per_cu); (void)hipGetLastError(); per_cu = 1; }
        grid_blocks = cus * per_cu;
    }
    if (grid_blocks < 0) return;
    Params p{};
    p.x = (const float*)d_in[0]; p.mem = (const float*)d_in[1]; p.pos = (const int*)d_in[2]; p.norm_g = (const float*)d_in[3]; p.w_in = (const float*)d_in[4];
    p.mconv_w = (const float*)d_in[5]; p.b_if = (const float*)d_in[6]; p.mnorm_g = (const float*)d_in[7]; p.lconv_w = (const float*)d_in[8]; p.lconv_b = (const float*)d_in[9];
    p.wa = (const float*)d_in[10]; p.ba = (const float*)d_in[11]; p.wx = (const float*)d_in[12]; p.bx = (const float*)d_in[13]; p.lam = (const float*)d_in[14];
    p.sinks = (const float*)d_in[15]; p.hlb = (const float*)d_in[16]; p.hnorm_g = (const float*)d_in[17]; p.mem_g = (const float*)d_in[18]; p.w_mem = (const float*)d_in[19];
    p.w_br = (const float*)d_in[20]; p.w_out = (const float*)d_in[21]; p.fin_g = (const float*)d_in[22];
    p.out = (float*)d_out; p.ws = (unsigned char*)d_ws;
    if (hipMemsetAsync((unsigned char*)d_ws + WS_BAR, 0, 16384, stream) != hipSuccess) { fprintf(stderr, "kernel_launch: memset failed\n"); return; }
    void* args[] = {&p};
    hipError_t e = hipLaunchCooperativeKernel((const void*)hybrid_fwd, dim3(grid_blocks), dim3(512), args, LDS_BYTES, stream);
    if (e != hipSuccess) fprintf(stderr, "cooperative launch failed: %s (grid %d)\n", hipGetErrorString(e), grid_blocks);
}
```
